# Optimizing an MI355X kernel written in HIP

```python
import math
import jax, jax.numpy as jnp
from jax import lax
import numpy as np

D_MODEL = 1024
BATCH = 8
SEQ = 4096
DEPTH = 1

GRID_W = 64
MIX_WIDTH = 1024
ATTN_WIDTH = 512
HEAD_DIM = 64
N_Q_HEADS = ATTN_WIDTH // HEAD_DIM
N_KV_HEADS = 2
KV_WIDTH = N_KV_HEADS * HEAD_DIM
AXIS_DIM = HEAD_DIM // 2
ROPE_THETA = 10000.0
Q_BLOCK = 128
HG_WIDTH = 512
HG_EXPAND = 128
HG_HEADS = HG_WIDTH // HG_EXPAND
HG_CHUNK = 64
RMS_EPS = 1e-6
LN_EPS = 1e-5
DEEPNORM_ALPHA = (2 * DEPTH) ** 0.25
DEEPNORM_BETA = (8 * DEPTH) ** -0.25
IN_SIZES = (ATTN_WIDTH, KV_WIDTH, KV_WIDTH, ATTN_WIDTH,
            HG_WIDTH, HG_WIDTH, HG_WIDTH, HG_WIDTH, HG_WIDTH)
IN_WIDTH = sum(IN_SIZES)

kernel_name = "hymba_attn_hgrn2_deepnorm_encoder"


def rms_norm(x, w):
    xf = x.astype(jnp.float32)
    y = xf * lax.rsqrt(jnp.mean(xf * xf, axis=-1, keepdims=True) + RMS_EPS)
    return y * w.astype(jnp.float32)


def layer_norm(x, w, b):
    xf = x.astype(jnp.float32)
    mu = jnp.mean(xf, axis=-1, keepdims=True)
    xc = xf - mu
    var = jnp.mean(xc * xc, axis=-1, keepdims=True)
    return xc * lax.rsqrt(var + LN_EPS) * w.astype(jnp.float32) + b.astype(jnp.float32)


def axial_rope_tables(seq_len):
    rows = seq_len // GRID_W
    row = jnp.repeat(jnp.arange(rows, dtype=jnp.int32), GRID_W).astype(jnp.float32)
    col = jnp.tile(jnp.arange(GRID_W, dtype=jnp.int32), rows).astype(jnp.float32)
    inv = ROPE_THETA ** (-jnp.arange(0, AXIS_DIM, 2, dtype=jnp.float32) / AXIS_DIM)
    ang_r = row[:, None] * inv[None, :]
    ang_c = col[:, None] * inv[None, :]
    return jnp.cos(ang_r), jnp.sin(ang_r), jnp.cos(ang_c), jnp.sin(ang_c)


def _rotate(x, cos, sin):
    x1, x2 = jnp.split(x, 2, axis=-1)
    c = cos[:, None, :]
    s = sin[:, None, :]
    return jnp.concatenate([x1 * c - x2 * s, x2 * c + x1 * s], axis=-1)


def axial_rope(x, tabs):
    cos_r, sin_r, cos_c, sin_c = tabs
    x_row, x_col = jnp.split(x, 2, axis=-1)
    return jnp.concatenate([_rotate(x_row, cos_r, sin_r), _rotate(x_col, cos_c, sin_c)], axis=-1)


def block_attention(q, k, v):
    B, S = q.shape[0], q.shape[1]
    nb = S // Q_BLOCK
    G = N_Q_HEADS // N_KV_HEADS
    qb = q.reshape(B, nb, Q_BLOCK, N_KV_HEADS, G, HEAD_DIM).transpose(1, 0, 2, 3, 4, 5)
    scale = HEAD_DIM ** -0.5

    def one_block(qblk):
        s = jnp.einsum('bqhgd,bkhd->bhgqk', qblk, k).astype(jnp.float32) * scale
        p = jax.nn.softmax(s, axis=-1).astype(v.dtype)
        return jnp.einsum('bhgqk,bkhd->bqhgd', p, v)

    o = lax.map(one_block, qb)
    return o.transpose(1, 0, 2, 3, 4, 5).reshape(B, S, N_Q_HEADS * HEAD_DIM)


def hgrn2_chunk_scan(q, logf, i):
    B, T, H, K = q.shape
    V = i.shape[-1]
    N = T // HG_CHUNK
    q = q.reshape(B, N, HG_CHUNK, H, K)
    logf = logf.reshape(B, N, HG_CHUNK, H, K)
    i = i.reshape(B, N, HG_CHUNK, H, V)
    k = -jnp.expm1(logf)
    b = jnp.cumsum(logf, axis=2)
    b_last = b[:, :, -1:]
    b_mid = b[:, :, HG_CHUNK // 2:HG_CHUNK // 2 + 1]
    qm = q * jnp.exp(b - b_mid)
    km = k * jnp.exp(b_mid - b)
    A = jnp.einsum('bnthk,bnshk->bnhts', qm, km)
    tril = jnp.tril(jnp.ones((HG_CHUNK, HG_CHUNK), dtype=bool))
    A = jnp.where(tril, A, 0.0)
    o_intra = jnp.einsum('bnhts,bnshv->bnthv', A, i)
    U = jnp.einsum('bnshk,bnshv->bnhkv', k * jnp.exp(b_last - b), i)
    decay = jnp.exp(b_last[:, :, 0])

    def step(S, inp):
        d, u = inp
        return d[..., None] * S + u, S

    S0 = jnp.zeros((B, H, K, V), jnp.float32)
    _, S_prev = lax.scan(step, S0, (decay.swapaxes(0, 1), U.swapaxes(0, 1)))
    o_inter = jnp.einsum('bnthk,nbhkv->bnthv', q * jnp.exp(b), S_prev)
    return (o_intra + o_inter).reshape(B, T, H, V)


def hgrn2_bidirectional(q, i, z_fwd, z_bwd, lb):
    B, S = q.shape[0], q.shape[1]
    heads = lambda a: a.astype(jnp.float32).reshape(B, S, HG_HEADS, HG_EXPAND)
    qh = heads(jax.nn.silu(q.astype(jnp.float32))) * (HG_EXPAND ** -0.5)
    ih = heads(i)
    lbh = lb.reshape(2, HG_HEADS, HG_EXPAND)
    logf_f = jnp.log(lbh[0] + (1.0 - lbh[0]) * jax.nn.sigmoid(heads(z_fwd)))
    logf_b = jnp.log(lbh[1] + (1.0 - lbh[1]) * jax.nn.sigmoid(heads(z_bwd)))
    o_f = hgrn2_chunk_scan(qh, logf_f, ih)
    o_b = hgrn2_chunk_scan(qh[:, ::-1], logf_b[:, ::-1], ih[:, ::-1])[:, ::-1]
    return o_f + o_b


def setup_inputs(seed: int = 0) -> dict:
    key = jax.random.key(seed)
    ks = jax.random.split(key, 12)
    f32 = jnp.float32
    x = jax.random.normal(ks[0], (BATCH, SEQ, D_MODEL), f32)
    col_scale = jnp.concatenate([
        jnp.full((s,), DEEPNORM_BETA if idx in (2, 5) else 1.0, f32)
        for idx, s in enumerate(IN_SIZES)])
    w_in = jax.random.normal(ks[1], (DEPTH, D_MODEL, IN_WIDTH), f32) * (D_MODEL ** -0.5) * col_scale
    q_norm_w = 1.0 + 0.02 * jax.random.normal(ks[2], (DEPTH, HEAD_DIM), f32)
    k_norm_w = 1.0 + 0.02 * jax.random.normal(ks[3], (DEPTH, HEAD_DIM), f32)
    attn_norm_w = 1.0 + 0.02 * jax.random.normal(ks[4], (DEPTH, ATTN_WIDTH), f32)
    hg_lb_logits = 0.1 * jax.random.normal(ks[5], (2, DEPTH + 1, HG_WIDTH), f32)
    hg_norm_w = 1.0 + 0.02 * jax.random.normal(ks[6], (DEPTH, HG_EXPAND), f32)
    w_out = jax.random.normal(ks[7], (DEPTH, MIX_WIDTH, D_MODEL), f32) * (MIX_WIDTH ** -0.5) * DEEPNORM_BETA
    ln_w = 1.0 + 0.02 * jax.random.normal(ks[8], (DEPTH, D_MODEL), f32)
    ln_b = 0.02 * jax.random.normal(ks[9], (DEPTH, D_MODEL), f32)
    return {"x": x, "w_in": w_in, "q_norm_w": q_norm_w, "k_norm_w": k_norm_w,
            "attn_norm_w": attn_norm_w, "hg_lb_logits": hg_lb_logits, "hg_norm_w": hg_norm_w,
            "w_out": w_out, "ln_w": ln_w, "ln_b": ln_b}


def reference(x, w_in, q_norm_w, k_norm_w, attn_norm_w, hg_lb_logits, hg_norm_w, w_out, ln_w, ln_b):
    B, S = x.shape[0], x.shape[1]
    dt = x.dtype
    tabs = axial_rope_tables(S)
    lb_all = jnp.cumsum(jax.nn.softmax(hg_lb_logits.astype(jnp.float32), axis=1), axis=1)
    splits = [int(v) for v in np.cumsum(IN_SIZES)[:-1]]
    for l in range(DEPTH):
        proj = jnp.einsum('bsd,de->bse', x, w_in[l])
        aq, ak, av, ag, hq, hi, hff, hfb, hg = jnp.split(proj, splits, axis=-1)
        q = rms_norm(aq.reshape(B, S, N_Q_HEADS, HEAD_DIM), q_norm_w[l])
        k = rms_norm(ak.reshape(B, S, N_KV_HEADS, HEAD_DIM), k_norm_w[l])
        q = axial_rope(q, tabs).astype(dt)
        k = axial_rope(k, tabs).astype(dt)
        v = av.reshape(B, S, N_KV_HEADS, HEAD_DIM)
        attn = block_attention(q, k, v)
        attn_branch = rms_norm(attn, attn_norm_w[l]) * jax.nn.silu(ag.astype(jnp.float32))
        o = hgrn2_bidirectional(hq, hi, hff, hfb, lb_all[:, l, :])
        o = rms_norm(o, hg_norm_w[l]).reshape(B, S, HG_WIDTH)
        hg_branch = o * jax.nn.silu(hg.astype(jnp.float32))
        mix = jnp.concatenate([attn_branch, hg_branch], axis=-1).astype(dt)
        y = jnp.einsum('bse,ed->bsd', mix, w_out[l])
        x = layer_norm(DEEPNORM_ALPHA * x + y, ln_w[l], ln_b[l]).astype(dt)
    return x
```

```cpp
#include <hip/hip_runtime.h>
#include <hip/hip_cooperative_groups.h>
#include <stdint.h>
#include <stdio.h>

namespace cg = cooperative_groups;

typedef __attribute__((ext_vector_type(8))) short bf16x8;
typedef __attribute__((ext_vector_type(4))) short s16x4;
typedef __attribute__((ext_vector_type(16))) float f32x16;
typedef unsigned short u16;
typedef __attribute__((ext_vector_type(4))) unsigned u32x4;

#define DI __device__ __forceinline__
#define MFMA32(a, b, c) __builtin_amdgcn_mfma_f32_32x32x16_bf16((a), (b), (c), 0, 0, 0)

constexpr int MTOK = 32768;
constexpr int SEQ = 4096;
constexpr int DM = 1024;
constexpr int INW = 3840;
constexpr float Q_PRESCALE = 0.125f * 1.4426950408889634f;
constexpr float HQ_SCALE = 0.08838834764831845f;
constexpr float DN_ALPHA = 1.189207115002721f;

struct Params {
  const float* x; const float* w_in; const float* q_norm_w; const float* k_norm_w;
  const float* attn_norm_w; const float* lb_logits; const float* hg_norm_w; const float* w_out;
  const float* ln_w; const float* ln_b;
  float* out;
  u16* xb;
  u16* winT;
  u16* woutT;
  float2* rope;
  float* lbv;
  u16* q;
  u16* k;
  u16* vT;
  u16* ga;
  u16* hq;
  u16* hi;
  float* lff;
  float* lfb;
  u16* gh;
  u16* attn;
  u16* of;
  u16* ob;
};

DI u16 f2bf(float x) { uint32_t u = __float_as_uint(x); u += 0x7fffu + ((u >> 16) & 1u); return (u16)(u >> 16); }
DI float bf2f(u16 v) { return __uint_as_float(((uint32_t)v) << 16); }
DI uint32_t pack2(float a, float b) { return (uint32_t)f2bf(a) | ((uint32_t)f2bf(b) << 16); }
DI int crow(int i, int h) { return (i & 3) + 8 * (i >> 2) + 4 * h; }
DI float silu_f(float v) { return v / (1.f + __expf(-v)); }

__device__ void phase0(const Params& p, char* smem, int bid, int nblk) {
  const int tid = threadIdx.x;
  {
    const size_t nvec = (size_t)MTOK * DM / 8;
    for (size_t i = (size_t)bid * 256 + tid; i < nvec; i += (size_t)nblk * 256) {
      const float4 a = ((const float4*)p.x)[2 * i], b = ((const float4*)p.x)[2 * i + 1];
      uint4 o; o.x = pack2(a.x, a.y); o.y = pack2(a.z, a.w); o.z = pack2(b.x, b.y); o.w = pack2(b.z, b.w);
      ((uint4*)p.xb)[i] = o;
    }
  }
  {
    float* t = (float*)smem;
    const int ntile_in = 16 * 60, ntile_all = ntile_in + 16 * 16;
    for (int tile = bid; tile < ntile_all; tile += nblk) {
      const float* src; u16* dst; int N, kt, nt;
      if (tile < ntile_in) { src = p.w_in; dst = p.winT; N = INW; kt = tile / 60; nt = tile % 60; }
      else { int tt = tile - ntile_in; src = p.w_out; dst = p.woutT; N = DM; kt = tt / 16; nt = tt % 16; }
      __syncthreads();
#pragma unroll
      for (int j = 0; j < 4; ++j) {
        const int kk = (tid >> 4) + 16 * j, nn = (tid & 15) * 4;
        const float4 v = *(const float4*)(src + (size_t)(kt * 64 + kk) * N + nt * 64 + nn);
        t[kk * 65 + nn] = v.x; t[kk * 65 + nn + 1] = v.y; t[kk * 65 + nn + 2] = v.z; t[kk * 65 + nn + 3] = v.w;
      }
      __syncthreads();
      const int n = tid >> 2, kc = (tid & 3) * 16;
      uint32_t o[8];
#pragma unroll
      for (int j = 0; j < 8; ++j) o[j] = pack2(t[(kc + 2 * j) * 65 + n], t[(kc + 2 * j + 1) * 65 + n]);
      uint4* d = (uint4*)(dst + (size_t)(nt * 64 + n) * 1024 + kt * 64 + kc);
      d[0] = make_uint4(o[0], o[1], o[2], o[3]);
      d[1] = make_uint4(o[4], o[5], o[6], o[7]);
    }
  }
  for (int i = bid * 256 + tid; i < 2048; i += nblk * 256) {
    if (i < 1024) {
      const int pos = i >> 4, j = i & 15;
      const float inv = powf(10000.f, -(float)(2 * j) / 32.f);
      const float ang = (float)pos * inv;
      p.rope[i] = make_float2(cosf(ang), sinf(ang));
    } else {
      const int ii = i - 1024, dir = ii >> 9, wcol = ii & 511;
      const float l0 = p.lb_logits[(dir * 2 + 0) * 512 + wcol], l1 = p.lb_logits[(dir * 2 + 1) * 512 + wcol];
      const float mx = fmaxf(l0, l1);
      const float e0 = expf(l0 - mx), e1 = expf(l1 - mx);
      p.lbv[ii] = e0 / (e0 + e1);
    }
  }
}

constexpr int GP = 72;
constexpr int GEMM_LDS = 2 * 2 * 128 * GP * 2;

DI void gemm_mainloop(const u16* __restrict__ A, const u16* __restrict__ B, int n0, int m0, char* smem, f32x16 (&acc)[2][2]) {
  const int tid = threadIdx.x, lane = tid & 63, w = tid >> 6;
  const int wn = w & 1, wm = w >> 1;
  const int lc = tid & 7, lr = tid >> 3;
  u16* sm = (u16*)smem;
  const u16* gA = A + (size_t)(n0 + lr) * 1024 + lc * 8;
  const u16* gB = B + (size_t)(m0 + lr) * 1024 + lc * 8;
#pragma unroll
  for (int a = 0; a < 2; ++a)
#pragma unroll
    for (int b = 0; b < 2; ++b)
#pragma unroll
      for (int i = 0; i < 16; ++i) acc[a][b][i] = 0.f;
  u32x4 ra[4], rb[4];
#pragma unroll
  for (int j = 0; j < 4; ++j) { ra[j] = *(const u32x4*)(gA + (size_t)j * 32 * 1024); rb[j] = *(const u32x4*)(gB + (size_t)j * 32 * 1024); }
  __syncthreads();
#pragma unroll
  for (int j = 0; j < 4; ++j) {
    *(u32x4*)(sm + (0 * 128 + lr + 32 * j) * GP + lc * 8) = ra[j];
    *(u32x4*)(sm + (1 * 128 + lr + 32 * j) * GP + lc * 8) = rb[j];
  }
  __syncthreads();
  const int fr = lane & 31, fh = lane >> 5;
  for (int kt = 0; kt < 16; ++kt) {
    const int st = kt & 1;
    if (kt + 1 < 16) {
#pragma unroll
      for (int j = 0; j < 4; ++j) {
        ra[j] = *(const u32x4*)(gA + (size_t)j * 32 * 1024 + (kt + 1) * 64);
        rb[j] = *(const u32x4*)(gB + (size_t)j * 32 * 1024 + (kt + 1) * 64);
      }
    }
    const u16* sa = sm + ((st * 2 + 0) * 128) * GP;
    const u16* sb = sm + ((st * 2 + 1) * 128) * GP;
#pragma unroll
    for (int ks = 0; ks < 4; ++ks) {
      bf16x8 af[2], bfr[2];
#pragma unroll
      for (int a = 0; a < 2; ++a) af[a] = *(const bf16x8*)(sa + (wn * 64 + a * 32 + fr) * GP + ks * 16 + fh * 8);
#pragma unroll
      for (int b = 0; b < 2; ++b) bfr[b] = *(const bf16x8*)(sb + (wm * 64 + b * 32 + fr) * GP + ks * 16 + fh * 8);
#pragma unroll
      for (int a = 0; a < 2; ++a)
#pragma unroll
        for (int b = 0; b < 2; ++b) acc[a][b] = MFMA32(af[a], bfr[b], acc[a][b]);
    }
    if (kt + 1 < 16) {
      const int ns = st ^ 1;
#pragma unroll
      for (int j = 0; j < 4; ++j) {
        *(u32x4*)(sm + ((ns * 2 + 0) * 128 + lr + 32 * j) * GP + lc * 8) = ra[j];
        *(u32x4*)(sm + ((ns * 2 + 1) * 128 + lr + 32 * j) * GP + lc * 8) = rb[j];
      }
    }
    __syncthreads();
  }
}

__device__ void phase1(const Params& p, char* smem, int bid, int nblk) {
  const int lane = threadIdx.x & 63, w = threadIdx.x >> 6;
  const int wn = w & 1, wm = w >> 1;
  const int r = lane & 31, h = lane >> 5;
  const int ntiles = (MTOK / 128) * 30;
  for (int tile = bid; tile < ntiles; tile += nblk) {
    const int mt = tile / 30, nt = tile % 30;
    f32x16 acc[2][2];
    gemm_mainloop(p.winT, p.xb, nt * 128, mt * 128, smem, acc);
    const int mbase = mt * 128 + wm * 64;
    if (nt <= 4) {
      const bool isq = nt < 4;
      const int head = isq ? nt * 2 + wn : wn;
      const float* nw = isq ? p.q_norm_w : p.k_norm_w;
      const float sc = isq ? Q_PRESCALE : 1.0f;
#pragma unroll
      for (int b = 0; b < 2; ++b) {
        const int m = mbase + b * 32 + r;
        const int bi = m >> 12, s = m & 4095;
        const int rp = s >> 6, cp = s & 63;
        float ss = 0.f;
#pragma unroll
        for (int a = 0; a < 2; ++a)
#pragma unroll
          for (int i = 0; i < 16; ++i) ss += acc[a][b][i] * acc[a][b][i];
        ss += __shfl_xor(ss, 32);
        const float rstd = rsqrtf(ss * (1.f / 64.f) + 1e-6f);
        u16* dst0 = isq ? p.q + ((size_t)(bi * 8 + head) * SEQ + s) * 64 : p.k + ((size_t)(bi * 2 + head) * SEQ + s) * 64;
#pragma unroll
        for (int a = 0; a < 2; ++a) {
          const int pos = a == 0 ? rp : cp;
          float y[16], o[16];
#pragma unroll
          for (int i = 0; i < 16; ++i) y[i] = acc[a][b][i] * rstd * nw[a * 32 + crow(i, h)];
#pragma unroll
          for (int i = 0; i < 8; ++i) {
            const float2 cs = p.rope[pos * 16 + crow(i, h)];
            o[i] = (y[i] * cs.x - y[i + 8] * cs.y) * sc;
            o[i + 8] = (y[i + 8] * cs.x + y[i] * cs.y) * sc;
          }
#pragma unroll
          for (int g = 0; g < 4; ++g) {
            uint2 v; v.x = pack2(o[4 * g], o[4 * g + 1]); v.y = pack2(o[4 * g + 2], o[4 * g + 3]);
            *(uint2*)(dst0 + a * 32 + 8 * g + 4 * h) = v;
          }
        }
      }
    } else if (nt == 5) {
#pragma unroll
      for (int b = 0; b < 2; ++b) {
        const int m = mbase + b * 32 + r;
        const int bi = m >> 12, s = m & 4095;
        u16* dst0 = p.vT + ((size_t)(bi * 2 + wn) * 64) * SEQ + s;
#pragma unroll
        for (int a = 0; a < 2; ++a)
#pragma unroll
          for (int i = 0; i < 16; ++i) dst0[(size_t)(a * 32 + crow(i, h)) * SEQ] = f2bf(acc[a][b][i]);
      }
    } else {
      const int gi = (nt - 6) >> 2;
      const int cb = ((nt - 6) & 3) * 128 + wn * 64;
#pragma unroll
      for (int b = 0; b < 2; ++b) {
        const size_t m = mbase + b * 32 + r;
#pragma unroll
        for (int a = 0; a < 2; ++a)
#pragma unroll
          for (int g = 0; g < 4; ++g) {
            const int c = cb + a * 32 + 8 * g + 4 * h;
            float v[4];
#pragma unroll
            for (int e = 0; e < 4; ++e) v[e] = acc[a][b][4 * g + e];
            if (gi == 3 || gi == 4) {
              const float4 lb = *(const float4*)(p.lbv + (gi - 3) * 512 + c);
              float4 o;
              o.x = logf(lb.x + (1.f - lb.x) / (1.f + expf(-v[0])));
              o.y = logf(lb.y + (1.f - lb.y) / (1.f + expf(-v[1])));
              o.z = logf(lb.z + (1.f - lb.z) / (1.f + expf(-v[2])));
              o.w = logf(lb.w + (1.f - lb.w) / (1.f + expf(-v[3])));
              *(float4*)((gi == 3 ? p.lff : p.lfb) + m * 512 + c) = o;
            } else {
              u16* dst = gi == 0 ? p.ga : gi == 1 ? p.hq : gi == 2 ? p.hi : p.gh;
              if (gi == 0 || gi == 5) {
#pragma unroll
                for (int e = 0; e < 4; ++e) v[e] = silu_f(v[e]);
              } else if (gi == 1) {
#pragma unroll
                for (int e = 0; e < 4; ++e) v[e] = silu_f(v[e]) * HQ_SCALE;
              }
              uint2 o; o.x = pack2(v[0], v[1]); o.y = pack2(v[2], v[3]);
              *(uint2*)(dst + m * 512 + c) = o;
            }
          }
      }
    }
  }
}

__global__ __launch_bounds__(256) void naive_attn(Params p) {
  const int gid = blockIdx.x * 256 + threadIdx.x;
  const int s = gid & 4095, bh = gid >> 12, head = bh & 7, bi = bh >> 3, kvh = head >> 2;
  float qv[64], acc[64];
  const u16* qp = p.q + ((size_t)(bi * 8 + head) * SEQ + s) * 64;
#pragma unroll
  for (int d = 0; d < 64; ++d) { qv[d] = bf2f(qp[d]); acc[d] = 0.f; }
  float mx = -INFINITY, l = 0.f;
  const u16* kp = p.k + (size_t)(bi * 2 + kvh) * SEQ * 64;
  const u16* vp = p.vT + (size_t)(bi * 2 + kvh) * 64 * SEQ;
  for (int key = 0; key < SEQ; ++key) {
    float sc = 0.f;
#pragma unroll
    for (int d = 0; d < 64; ++d) sc += qv[d] * bf2f(kp[(size_t)key * 64 + d]);
    const float mn = fmaxf(mx, sc);
    const float al = exp2f(mx - mn), pp = exp2f(sc - mn);
    l = l * al + pp;
#pragma unroll
    for (int d = 0; d < 64; ++d) acc[d] = acc[d] * al + pp * bf2f(vp[(size_t)d * SEQ + key]);
    mx = mn;
  }
  const float il = 1.f / l;
  u16* op = p.attn + ((size_t)bi * SEQ + s) * 512 + head * 64;
#pragma unroll
  for (int d = 0; d < 64; ++d) op[d] = f2bf(acc[d] * il);
}

__global__ __launch_bounds__(1024) void naive_hgrn(Params p) {
  __shared__ float red[8][128];
  const int dir = blockIdx.x & 1, hh = (blockIdx.x >> 1) & 3, bi = blockIdx.x >> 3;
  const int v = threadIdx.x & 127, kq = threadIdx.x >> 7;
  float S[16];
#pragma unroll
  for (int i = 0; i < 16; ++i) S[i] = 0.f;
  const float* lf = dir ? p.lfb : p.lff;
  u16* o = dir ? p.ob : p.of;
  for (int step = 0; step < SEQ; ++step) {
    const int s = dir ? SEQ - 1 - step : step;
    const size_t base = ((size_t)bi * SEQ + s) * 512 + hh * 128;
    const float iv = bf2f(p.hi[base + v]);
    float part = 0.f;
#pragma unroll
    for (int kk = 0; kk < 16; ++kk) {
      const int k = kq * 16 + kk;
      const float lg = lf[base + k];
      const float f = expf(lg), g = -expm1f(lg);
      const float qk = bf2f(p.hq[base + k]);
      S[kk] = f * S[kk] + g * iv;
      part += S[kk] * qk;
    }
    red[kq][v] = part;
    __syncthreads();
    if (kq == 0) {
      float t = 0.f;
#pragma unroll
      for (int j = 0; j < 8; ++j) t += red[j][v];
      o[base + v] = f2bf(t);
    }
    __syncthreads();
  }
}

DI void load8(const u16* ptr, float (&v)[8]) {
  const uint4 u = *(const uint4*)ptr;
  v[0] = __uint_as_float(u.x << 16); v[1] = __uint_as_float(u.x & 0xffff0000u);
  v[2] = __uint_as_float(u.y << 16); v[3] = __uint_as_float(u.y & 0xffff0000u);
  v[4] = __uint_as_float(u.z << 16); v[5] = __uint_as_float(u.z & 0xffff0000u);
  v[6] = __uint_as_float(u.w << 16); v[7] = __uint_as_float(u.w & 0xffff0000u);
}
__device__ void phase_mix(const Params& p, int bid, int nblk) {
  const int lane = threadIdx.x & 63, w = threadIdx.x >> 6;
  u16* mix = p.xb;
  for (int m = bid * 4 + w; m < MTOK; m += nblk * 4) {
    const size_t rb = (size_t)m * 512 + lane * 8;
    float a[8], g[8], f1[8], f2[8];
    load8(p.attn + rb, a); load8(p.ga + rb, g);
    float ss = 0.f;
#pragma unroll
    for (int e = 0; e < 8; ++e) ss += a[e] * a[e];
#pragma unroll
    for (int o = 32; o >= 1; o >>= 1) ss += __shfl_xor(ss, o);
    float rstd = rsqrtf(ss * (1.f / 512.f) + 1e-6f);
    float r[8];
#pragma unroll
    for (int e = 0; e < 8; ++e) r[e] = a[e] * rstd * p.attn_norm_w[lane * 8 + e] * g[e];
    uint4 o1; o1.x = pack2(r[0], r[1]); o1.y = pack2(r[2], r[3]); o1.z = pack2(r[4], r[5]); o1.w = pack2(r[6], r[7]);
    *(uint4*)(mix + (size_t)m * 1024 + lane * 8) = o1;
    load8(p.of + rb, f1); load8(p.ob + rb, f2); load8(p.gh + rb, g);
    ss = 0.f;
#pragma unroll
    for (int e = 0; e < 8; ++e) { a[e] = f1[e] + f2[e]; ss += a[e] * a[e]; }
#pragma unroll
    for (int o = 8; o >= 1; o >>= 1) ss += __shfl_xor(ss, o);
    rstd = rsqrtf(ss * (1.f / 128.f) + 1e-6f);
#pragma unroll
    for (int e = 0; e < 8; ++e) r[e] = a[e] * rstd * p.hg_norm_w[(lane & 15) * 8 + e] * g[e];
    o1.x = pack2(r[0], r[1]); o1.y = pack2(r[2], r[3]); o1.z = pack2(r[4], r[5]); o1.w = pack2(r[6], r[7]);
    *(uint4*)(mix + (size_t)m * 1024 + 512 + lane * 8) = o1;
  }
}

__device__ void phase3(const Params& p, char* smem, int bid, int nblk) {
  const int lane = threadIdx.x & 63, w = threadIdx.x >> 6;
  const int wn = w & 1, wm = w >> 1;
  const int r = lane & 31, h = lane >> 5;
  const int ntiles = (MTOK / 128) * 8;
  for (int tile = bid; tile < ntiles; tile += nblk) {
    const int mt = tile >> 3, nt = tile & 7;
    f32x16 acc[2][2];
    gemm_mainloop(p.woutT, p.xb, nt * 128, mt * 128, smem, acc);
#pragma unroll
    for (int b = 0; b < 2; ++b) {
      const size_t m = mt * 128 + wm * 64 + b * 32 + r;
#pragma unroll
      for (int a = 0; a < 2; ++a)
#pragma unroll
        for (int g = 0; g < 4; ++g) {
          const int n = nt * 128 + wn * 64 + a * 32 + 8 * g + 4 * h;
          const float4 xv = *(const float4*)(p.x + m * 1024 + n);
          float4 o;
          o.x = DN_ALPHA * xv.x + acc[a][b][4 * g + 0];
          o.y = DN_ALPHA * xv.y + acc[a][b][4 * g + 1];
          o.z = DN_ALPHA * xv.z + acc[a][b][4 * g + 2];
          o.w = DN_ALPHA * xv.w + acc[a][b][4 * g + 3];
          *(float4*)(p.out + m * 1024 + n) = o;
        }
    }
  }
}

__device__ void phase4(const Params& p, int bid, int nblk) {
  const int lane = threadIdx.x & 63, w = threadIdx.x >> 6;
  for (int m = bid * 4 + w; m < MTOK; m += nblk * 4) {
    float4* row = (float4*)(p.out + (size_t)m * 1024);
    float4 v[4];
    float s = 0.f;
#pragma unroll
    for (int j = 0; j < 4; ++j) { v[j] = row[lane + 64 * j]; s += v[j].x + v[j].y + v[j].z + v[j].w; }
#pragma unroll
    for (int o = 32; o >= 1; o >>= 1) s += __shfl_xor(s, o);
    const float mu = s * (1.f / 1024.f);
    float q = 0.f;
#pragma unroll
    for (int j = 0; j < 4; ++j) {
      v[j].x -= mu; v[j].y -= mu; v[j].z -= mu; v[j].w -= mu;
      q += v[j].x * v[j].x + v[j].y * v[j].y + v[j].z * v[j].z + v[j].w * v[j].w;
    }
#pragma unroll
    for (int o = 32; o >= 1; o >>= 1) q += __shfl_xor(q, o);
    const float rstd = rsqrtf(q * (1.f / 1024.f) + 1e-5f);
#pragma unroll
    for (int j = 0; j < 4; ++j) {
      const float4 wv = ((const float4*)p.ln_w)[lane + 64 * j], bv = ((const float4*)p.ln_b)[lane + 64 * j];
      float4 o;
      o.x = v[j].x * rstd * wv.x + bv.x; o.y = v[j].y * rstd * wv.y + bv.y;
      o.z = v[j].z * rstd * wv.z + bv.z; o.w = v[j].w * rstd * wv.w + bv.w;
      row[lane + 64 * j] = o;
    }
  }
}

__global__ __launch_bounds__(256) void k_phase0(Params p) { __shared__ __attribute__((aligned(16))) char smem[64 * 65 * 4]; phase0(p, smem, blockIdx.x, gridDim.x); }
__global__ __launch_bounds__(256) void k_phase1(Params p) { __shared__ __attribute__((aligned(16))) char smem[GEMM_LDS]; phase1(p, smem, blockIdx.x, gridDim.x); }
__global__ __launch_bounds__(256) void k_mix(Params p) { phase_mix(p, blockIdx.x, gridDim.x); }
__global__ __launch_bounds__(256) void k_phase3(Params p) { __shared__ __attribute__((aligned(16))) char smem[GEMM_LDS]; phase3(p, smem, blockIdx.x, gridDim.x); }
__global__ __launch_bounds__(256) void k_phase4(Params p) { phase4(p, blockIdx.x, gridDim.x); }

extern "C" void kernel_launch(void* const* d_in, const int* in_sizes, int n_in, void* d_out, int out_size, void* d_ws, size_t ws_size,
                              hipStream_t stream) {
  Params p{};
  p.x = (const float*)d_in[0]; p.w_in = (const float*)d_in[1]; p.q_norm_w = (const float*)d_in[2]; p.k_norm_w = (const float*)d_in[3];
  p.attn_norm_w = (const float*)d_in[4]; p.lb_logits = (const float*)d_in[5]; p.hg_norm_w = (const float*)d_in[6];
  p.w_out = (const float*)d_in[7]; p.ln_w = (const float*)d_in[8]; p.ln_b = (const float*)d_in[9];
  p.out = (float*)d_out;
  char* ws = (char*)d_ws;
  size_t off = 0;
  auto take = [&](size_t bytes) { char* r = ws + off; off += (bytes + 255) & ~(size_t)255; return r; };
  p.xb = (u16*)take((size_t)MTOK * 1024 * 2);
  p.winT = (u16*)take((size_t)INW * 1024 * 2);
  p.woutT = (u16*)take((size_t)1024 * 1024 * 2);
  p.rope = (float2*)take(1024 * 8);
  p.lbv = (float*)take(1024 * 4);
  p.q = (u16*)take((size_t)MTOK * 512 * 2);
  p.k = (u16*)take((size_t)MTOK * 128 * 2);
  p.vT = (u16*)take((size_t)MTOK * 128 * 2);
  p.ga = (u16*)take((size_t)MTOK * 512 * 2);
  p.hq = (u16*)take((size_t)MTOK * 512 * 2);
  p.hi = (u16*)take((size_t)MTOK * 512 * 2);
  p.lff = (float*)take((size_t)MTOK * 512 * 4);
  p.lfb = (float*)take((size_t)MTOK * 512 * 4);
  p.gh = (u16*)take((size_t)MTOK * 512 * 2);
  p.attn = (u16*)take((size_t)MTOK * 512 * 2);
  p.of = (u16*)take((size_t)MTOK * 512 * 2);
  p.ob = (u16*)take((size_t)MTOK * 512 * 2);
  if (off > ws_size) { fprintf(stderr, "workspace too small: need %zu have %zu\n", off, ws_size); return; }
  k_phase0<<<1024, 256, 0, stream>>>(p);
  k_phase1<<<512, 256, 0, stream>>>(p);
  naive_attn<<<MTOK * 8 / 256, 256, 0, stream>>>(p);
  naive_hgrn<<<64, 1024, 0, stream>>>(p);
  k_mix<<<2048, 256, 0, stream>>>(p);
  k_phase3<<<512, 256, 0, stream>>>(p);
  k_phase4<<<2048, 256, 0, stream>>>(p);
}
```

```cpp
#include <hip/hip_runtime.h>
#include <hip/hip_cooperative_groups.h>
#include <stdint.h>
#include <stdio.h>

namespace cg = cooperative_groups;

#ifndef ONE_LAUNCH
#define ONE_LAUNCH 1
#endif

typedef __attribute__((ext_vector_type(8))) short bf16x8;
typedef __attribute__((ext_vector_type(4))) short s16x4;
typedef __attribute__((ext_vector_type(16))) float f32x16;
typedef unsigned short u16;
typedef __attribute__((ext_vector_type(4))) unsigned u32x4;
typedef __attribute__((ext_vector_type(2))) unsigned u32x2;

#define DI __device__ __forceinline__
#define MFMA32(a, b, c) __builtin_amdgcn_mfma_f32_32x32x16_bf16((a), (b), (c), 0, 0, 0)

constexpr int MTOK = 32768;
constexpr int SEQ = 4096;
constexpr int DM = 1024;
constexpr int INW = 3840;
constexpr float Q_PRESCALE = 0.125f * 1.4426950408889634f;
constexpr float HQ_SCALE = 0.08838834764831845f;
constexpr float DN_ALPHA = 1.189207115002721f;

struct Params {
  const float* x; const float* w_in; const float* q_norm_w; const float* k_norm_w;
  const float* attn_norm_w; const float* lb_logits; const float* hg_norm_w; const float* w_out;
  const float* ln_w; const float* ln_b;
  float* out;
  u16* xb;
  u16* winT;
  u16* woutT;
  float2* rope;
  float* lbv;
  u16* q;
  u16* k;
  u16* vT;
  u16* ga;
  u16* hq;
  u16* hi;
  float* lff;
  float* lfb;
  u16* gh;
  u16* attn;
  u16* of;
  u16* ob;
  int* ctr;
};

DI u16 f2bf(float x) { uint32_t u = __float_as_uint(x); u += 0x7fffu + ((u >> 16) & 1u); return (u16)(u >> 16); }
DI float bf2f(u16 v) { return __uint_as_float(((uint32_t)v) << 16); }
typedef __attribute__((ext_vector_type(2))) float f32x2_t;
typedef __attribute__((ext_vector_type(2))) __bf16 bf16x2_t;
DI uint32_t pack2(float a, float b) { f32x2_t v = {a, b}; bf16x2_t r = __builtin_convertvector(v, bf16x2_t); return __builtin_bit_cast(uint32_t, r); }
DI int crow(int i, int h) { return (i & 3) + 8 * (i >> 2) + 4 * h; }
DI float silu_f(float v) { return v / (1.f + __expf(-v)); }

__device__ void phase0(const Params& p, char* smem, int bid, int nblk) {
  const int tid = threadIdx.x;
  {
    const size_t nvec = (size_t)MTOK * DM / 8;
    for (size_t i = (size_t)bid * 256 + tid; i < nvec; i += (size_t)nblk * 256) {
      const float4 a = ((const float4*)p.x)[2 * i], b = ((const float4*)p.x)[2 * i + 1];
      uint4 o; o.x = pack2(a.x, a.y); o.y = pack2(a.z, a.w); o.z = pack2(b.x, b.y); o.w = pack2(b.z, b.w);
      ((uint4*)p.xb)[i] = o;
    }
  }
  {
    float* t = (float*)smem;
    const int ntile_in = 16 * 60, ntile_all = ntile_in + 16 * 16;
    for (int tile = bid; tile < ntile_all; tile += nblk) {
      const float* src; u16* dst; int N, kt, nt;
      if (tile < ntile_in) { src = p.w_in; dst = p.winT; N = INW; kt = tile / 60; nt = tile % 60; }
      else { int tt = tile - ntile_in; src = p.w_out; dst = p.woutT; N = DM; kt = tt / 16; nt = tt % 16; }
      __syncthreads();
#pragma unroll
      for (int j = 0; j < 4; ++j) {
        const int kk = (tid >> 4) + 16 * j, nn = (tid & 15) * 4;
        const float4 v = *(const float4*)(src + (size_t)(kt * 64 + kk) * N + nt * 64 + nn);
        t[kk * 65 + nn] = v.x; t[kk * 65 + nn + 1] = v.y; t[kk * 65 + nn + 2] = v.z; t[kk * 65 + nn + 3] = v.w;
      }
      __syncthreads();
      const int n = tid >> 2, kc = (tid & 3) * 16;
      uint32_t o[8];
#pragma unroll
      for (int j = 0; j < 8; ++j) o[j] = pack2(t[(kc + 2 * j) * 65 + n], t[(kc + 2 * j + 1) * 65 + n]);
      uint4* d = (uint4*)(dst + (size_t)(nt * 64 + n) * 1024 + kt * 64 + kc);
      d[0] = make_uint4(o[0], o[1], o[2], o[3]);
      d[1] = make_uint4(o[4], o[5], o[6], o[7]);
    }
  }
  for (int i = bid * 256 + tid; i < 2048; i += nblk * 256) {
    if (i < 1024) {
      const int pos = i >> 4, j = i & 15;
      const float inv = powf(10000.f, -(float)(2 * j) / 32.f);
      const float ang = (float)pos * inv;
      p.rope[i] = make_float2(cosf(ang), sinf(ang));
    } else {
      const int ii = i - 1024, dir = ii >> 9, wcol = ii & 511;
      const float l0 = p.lb_logits[(dir * 2 + 0) * 512 + wcol], l1 = p.lb_logits[(dir * 2 + 1) * 512 + wcol];
      const float mx = fmaxf(l0, l1);
      const float e0 = expf(l0 - mx), e1 = expf(l1 - mx);
      p.lbv[ii] = e0 / (e0 + e1);
    }
  }
}

constexpr int GP = 72;
constexpr int GEMM_LDS = 2 * 2 * 128 * GP * 2;

DI void gemm_mainloop(const u16* __restrict__ A, const u16* __restrict__ B, int n0, int m0, char* smem, f32x16 (&acc)[2][2]) {
  const int tid = threadIdx.x, lane = tid & 63, w = tid >> 6;
  const int wn = w & 1, wm = w >> 1;
  const int lc = tid & 7, lr = tid >> 3;
  u16* sm = (u16*)smem;
  const u16* gA = A + (size_t)(n0 + lr) * 1024 + lc * 8;
  const u16* gB = B + (size_t)(m0 + lr) * 1024 + lc * 8;
#pragma unroll
  for (int a = 0; a < 2; ++a)
#pragma unroll
    for (int b = 0; b < 2; ++b)
#pragma unroll
      for (int i = 0; i < 16; ++i) acc[a][b][i] = 0.f;
  u32x4 ra[4], rb[4];
#pragma unroll
  for (int j = 0; j < 4; ++j) { ra[j] = *(const u32x4*)(gA + (size_t)j * 32 * 1024); rb[j] = *(const u32x4*)(gB + (size_t)j * 32 * 1024); }
  __syncthreads();
#pragma unroll
  for (int j = 0; j < 4; ++j) {
    *(u32x4*)(sm + (0 * 128 + lr + 32 * j) * GP + lc * 8) = ra[j];
    *(u32x4*)(sm + (1 * 128 + lr + 32 * j) * GP + lc * 8) = rb[j];
  }
  __syncthreads();
  const int fr = lane & 31, fh = lane >> 5;
  for (int kt = 0; kt < 16; ++kt) {
    const int st = kt & 1;
    if (kt + 1 < 16) {
#pragma unroll
      for (int j = 0; j < 4; ++j) {
        ra[j] = *(const u32x4*)(gA + (size_t)j * 32 * 1024 + (kt + 1) * 64);
        rb[j] = *(const u32x4*)(gB + (size_t)j * 32 * 1024 + (kt + 1) * 64);
      }
    }
    const u16* sa = sm + ((st * 2 + 0) * 128) * GP;
    const u16* sb = sm + ((st * 2 + 1) * 128) * GP;
#pragma unroll
    for (int ks = 0; ks < 4; ++ks) {
      bf16x8 af[2], bfr[2];
#pragma unroll
      for (int a = 0; a < 2; ++a) af[a] = *(const bf16x8*)(sa + (wn * 64 + a * 32 + fr) * GP + ks * 16 + fh * 8);
#pragma unroll
      for (int b = 0; b < 2; ++b) bfr[b] = *(const bf16x8*)(sb + (wm * 64 + b * 32 + fr) * GP + ks * 16 + fh * 8);
#pragma unroll
      for (int a = 0; a < 2; ++a)
#pragma unroll
        for (int b = 0; b < 2; ++b) acc[a][b] = MFMA32(af[a], bfr[b], acc[a][b]);
    }
    if (kt + 1 < 16) {
      const int ns = st ^ 1;
#pragma unroll
      for (int j = 0; j < 4; ++j) {
        *(u32x4*)(sm + ((ns * 2 + 0) * 128 + lr + 32 * j) * GP + lc * 8) = ra[j];
        *(u32x4*)(sm + ((ns * 2 + 1) * 128 + lr + 32 * j) * GP + lc * 8) = rb[j];
      }
    }
    __syncthreads();
  }
}

__device__ void phase1(const Params& p, char* smem, int bid, int nblk) {
  const int lane = threadIdx.x & 63, w = threadIdx.x >> 6;
  const int wn = w & 1, wm = w >> 1;
  const int r = lane & 31, h = lane >> 5;
  const int ntiles = (MTOK / 128) * 30;
  for (int tile = bid; tile < ntiles; tile += nblk) {
    const int mt = tile / 30, nt = tile % 30;
    f32x16 acc[2][2];
    gemm_mainloop(p.winT, p.xb, nt * 128, mt * 128, smem, acc);
    const int mbase = mt * 128 + wm * 64;
    if (nt <= 4) {
      const bool isq = nt < 4;
      const int head = isq ? nt * 2 + wn : wn;
      const float* nw = isq ? p.q_norm_w : p.k_norm_w;
      const float sc = isq ? Q_PRESCALE : 1.0f;
#pragma unroll
      for (int b = 0; b < 2; ++b) {
        const int m = mbase + b * 32 + r;
        const int bi = m >> 12, s = m & 4095;
        const int rp = s >> 6, cp = s & 63;
        float ss = 0.f;
#pragma unroll
        for (int a = 0; a < 2; ++a)
#pragma unroll
          for (int i = 0; i < 16; ++i) ss += acc[a][b][i] * acc[a][b][i];
        ss += __shfl_xor(ss, 32);
        const float rstd = rsqrtf(ss * (1.f / 64.f) + 1e-6f);
        u16* dst0 = isq ? p.q + ((size_t)(bi * 8 + head) * SEQ + s) * 64 : p.k + ((size_t)(bi * 2 + head) * SEQ + s) * 64;
#pragma unroll
        for (int a = 0; a < 2; ++a) {
          const int pos = a == 0 ? rp : cp;
          float y[16], o[16];
#pragma unroll
          for (int i = 0; i < 16; ++i) y[i] = acc[a][b][i] * rstd * nw[a * 32 + crow(i, h)];
#pragma unroll
          for (int i = 0; i < 8; ++i) {
            const float2 cs = p.rope[pos * 16 + crow(i, h)];
            o[i] = (y[i] * cs.x - y[i + 8] * cs.y) * sc;
            o[i + 8] = (y[i + 8] * cs.x + y[i] * cs.y) * sc;
          }
#pragma unroll
          for (int g = 0; g < 4; ++g) {
            uint2 v; v.x = pack2(o[4 * g], o[4 * g + 1]); v.y = pack2(o[4 * g + 2], o[4 * g + 3]);
            *(uint2*)(dst0 + a * 32 + 8 * g + 4 * h) = v;
          }
        }
      }
    } else if (nt == 5) {
#pragma unroll
      for (int b = 0; b < 2; ++b) {
        const int m = mbase + b * 32 + r;
        const int bi = m >> 12, s = m & 4095;
        u16* dst0 = p.vT + ((size_t)(bi * 2 + wn) * 64) * SEQ + s;
#pragma unroll
        for (int a = 0; a < 2; ++a)
#pragma unroll
          for (int i = 0; i < 16; ++i) dst0[(size_t)(a * 32 + crow(i, h)) * SEQ] = f2bf(acc[a][b][i]);
      }
    } else {
      const int gi = (nt - 6) >> 2;
      const int cb = ((nt - 6) & 3) * 128 + wn * 64;
#pragma unroll
      for (int b = 0; b < 2; ++b) {
        const size_t m = mbase + b * 32 + r;
#pragma unroll
        for (int a = 0; a < 2; ++a)
#pragma unroll
          for (int g = 0; g < 4; ++g) {
            const int c = cb + a * 32 + 8 * g + 4 * h;
            float v[4];
#pragma unroll
            for (int e = 0; e < 4; ++e) v[e] = acc[a][b][4 * g + e];
            if (gi == 3 || gi == 4) {
              const float4 lb = *(const float4*)(p.lbv + (gi - 3) * 512 + c);
              float4 o;
              o.x = logf(lb.x + (1.f - lb.x) / (1.f + expf(-v[0])));
              o.y = logf(lb.y + (1.f - lb.y) / (1.f + expf(-v[1])));
              o.z = logf(lb.z + (1.f - lb.z) / (1.f + expf(-v[2])));
              o.w = logf(lb.w + (1.f - lb.w) / (1.f + expf(-v[3])));
              *(float4*)((gi == 3 ? p.lff : p.lfb) + m * 512 + c) = o;
            } else {
              u16* dst = gi == 0 ? p.ga : gi == 1 ? p.hq : gi == 2 ? p.hi : p.gh;
              if (gi == 0 || gi == 5) {
#pragma unroll
                for (int e = 0; e < 4; ++e) v[e] = silu_f(v[e]);
              } else if (gi == 1) {
#pragma unroll
                for (int e = 0; e < 4; ++e) v[e] = silu_f(v[e]) * HQ_SCALE;
              }
              uint2 o; o.x = pack2(v[0], v[1]); o.y = pack2(v[2], v[3]);
              *(uint2*)(dst + m * 512 + c) = o;
            }
          }
      }
    }
  }
}


constexpr int AP = 72;
constexpr int ATT_LDS = 2 * 2 * 64 * AP * 2;
DI float fast_exp2(float x) { return __builtin_amdgcn_exp2f(x); }

__device__ void attn_item(const Params& p, char* smem, int item) {
  const int tid = threadIdx.x, lane = tid & 63, w = tid >> 6, r = lane & 31, h = lane >> 5;
  const int qb = item & 31, head = (item >> 5) & 7, bi = item >> 8;
  const int kvh = head >> 2;
  const int q0 = qb * 128 + w * 32;
  u16* sm = (u16*)smem;
  bf16x8 qf[4];
  {
    const u16* qp = p.q + ((size_t)(bi * 8 + head) * SEQ + q0 + r) * 64 + h * 8;
#pragma unroll
    for (int ks = 0; ks < 4; ++ks) qf[ks] = *(const bf16x8*)(qp + ks * 16);
  }
  const int lc = tid & 7, lr = tid >> 3;
  const u16* kg = p.k + (size_t)(bi * 2 + kvh) * SEQ * 64 + (size_t)lr * 64 + lc * 8;
  const u16* vg = p.vT + (size_t)(bi * 2 + kvh) * 64 * SEQ + (size_t)lr * SEQ + lc * 8;
  const int kw = lr * AP + lc * 8;
  const int vw = lr * AP + (lc >> 1) * 16 + (lc & 1) * 4;
  u32x4 rk[2], rv[2];
#pragma unroll
  for (int j = 0; j < 2; ++j) { rk[j] = *(const u32x4*)(kg + (size_t)j * 32 * 64); rv[j] = *(const u32x4*)(vg + (size_t)j * 32 * SEQ); }
  __syncthreads();
#pragma unroll
  for (int j = 0; j < 2; ++j) {
    *(u32x4*)(sm + kw + j * 32 * AP) = rk[j];
    u16* vd = sm + 64 * AP + vw + j * 32 * AP;
    *(u32x2*)(vd) = rv[j].xy; *(u32x2*)(vd + 8) = rv[j].zw;
  }
  __syncthreads();
  f32x16 o[2];
#pragma unroll
  for (int dt = 0; dt < 2; ++dt)
#pragma unroll
    for (int i = 0; i < 16; ++i) o[dt][i] = 0.f;
  float mrun = -INFINITY, lsum = 0.f;
  for (int t = 0; t < 64; ++t) {
    const int st = t & 1;
    if (t + 1 < 64) {
#pragma unroll
      for (int j = 0; j < 2; ++j) {
        rk[j] = *(const u32x4*)(kg + (size_t)((t + 1) * 64 + j * 32) * 64);
        rv[j] = *(const u32x4*)(vg + (size_t)j * 32 * SEQ + (t + 1) * 64);
      }
    }
    const u16* sK = sm + (st * 2 + 0) * 64 * AP;
    const u16* sV = sm + (st * 2 + 1) * 64 * AP;
    f32x16 sc[2];
#pragma unroll
    for (int kt2 = 0; kt2 < 2; ++kt2) {
#pragma unroll
      for (int i = 0; i < 16; ++i) sc[kt2][i] = 0.f;
#pragma unroll
      for (int ks = 0; ks < 4; ++ks) {
        const bf16x8 kf = *(const bf16x8*)(sK + (kt2 * 32 + r) * AP + ks * 16 + h * 8);
        sc[kt2] = MFMA32(kf, qf[ks], sc[kt2]);
      }
    }
    float mx = sc[0][0];
#pragma unroll
    for (int i = 1; i < 16; ++i) mx = fmaxf(mx, sc[0][i]);
#pragma unroll
    for (int i = 0; i < 16; ++i) mx = fmaxf(mx, sc[1][i]);
    mx = fmaxf(mx, __shfl_xor(mx, 32));
    if (__any(mx > mrun)) {
      const float mn = fmaxf(mrun, mx);
      const float al = fast_exp2(mrun - mn);
      lsum *= al;
#pragma unroll
      for (int dt = 0; dt < 2; ++dt)
#pragma unroll
        for (int i = 0; i < 16; ++i) o[dt][i] *= al;
      mrun = mn;
    }
#pragma unroll
    for (int kt2 = 0; kt2 < 2; ++kt2)
#pragma unroll
      for (int i = 0; i < 16; ++i) { const float e = fast_exp2(sc[kt2][i] - mrun); sc[kt2][i] = e; lsum += e; }
#pragma unroll
    for (int s2 = 0; s2 < 4; ++s2) {
      u32x4 pk;
      pk.x = pack2(sc[s2 >> 1][8 * (s2 & 1) + 0], sc[s2 >> 1][8 * (s2 & 1) + 1]);
      pk.y = pack2(sc[s2 >> 1][8 * (s2 & 1) + 2], sc[s2 >> 1][8 * (s2 & 1) + 3]);
      pk.z = pack2(sc[s2 >> 1][8 * (s2 & 1) + 4], sc[s2 >> 1][8 * (s2 & 1) + 5]);
      pk.w = pack2(sc[s2 >> 1][8 * (s2 & 1) + 6], sc[s2 >> 1][8 * (s2 & 1) + 7]);
      const bf16x8 pf = __builtin_bit_cast(bf16x8, pk);
#pragma unroll
      for (int dt = 0; dt < 2; ++dt) {
        const bf16x8 vf = *(const bf16x8*)(sV + (dt * 32 + r) * AP + s2 * 16 + h * 8);
        o[dt] = MFMA32(vf, pf, o[dt]);
      }
    }
    if (t + 1 < 64) {
      const int ns = st ^ 1;
#pragma unroll
      for (int j = 0; j < 2; ++j) {
        *(u32x4*)(sm + (ns * 2 + 0) * 64 * AP + kw + j * 32 * AP) = rk[j];
        u16* vd = sm + (ns * 2 + 1) * 64 * AP + vw + j * 32 * AP;
        *(u32x2*)(vd) = rv[j].xy; *(u32x2*)(vd + 8) = rv[j].zw;
      }
    }
    __syncthreads();
  }
  lsum += __shfl_xor(lsum, 32);
  const float il = 1.f / lsum;
  u16* op = p.attn + ((size_t)bi * SEQ + q0 + r) * 512 + head * 64 + 4 * h;
#pragma unroll
  for (int dt = 0; dt < 2; ++dt)
#pragma unroll
    for (int g = 0; g < 4; ++g) {
      u32x2 v; v.x = pack2(o[dt][4 * g] * il, o[dt][4 * g + 1] * il); v.y = pack2(o[dt][4 * g + 2] * il, o[dt][4 * g + 3] * il);
      *(u32x2*)(op + dt * 32 + 8 * g) = v;
    }
}


constexpr int HQP = 136;
constexpr int HSP = 72;
constexpr int H_QM = 0;
constexpr int H_KM = H_QM + 64 * HQP * 2;
constexpr int H_KUT = H_KM + 64 * HQP * 2;
constexpr int H_IT = H_KUT + 128 * HSP * 2;
constexpr int H_F32 = H_IT + 128 * HSP * 2;
constexpr int HG_LDS = H_F32 + 7 * 128 * 4;

__device__ void hgrn_item(const Params& p, char* smem, int item) {
  const int tid = threadIdx.x, lane = tid & 63, w = __builtin_amdgcn_readfirstlane(tid >> 6), r = lane & 31, h = lane >> 5;
  const int dir = item & 1, hh = (item >> 1) & 3, bi = item >> 3;
  u16* QM = (u16*)(smem + H_QM);
  u16* KM = (u16*)(smem + H_KM);
  u16* AM = (u16*)(smem + H_KM);
  u16* KUT = (u16*)(smem + H_KUT);
  u16* IT = (u16*)(smem + H_IT);
  float* tot = (float*)(smem + H_F32);
  float* first2 = tot + 512;
  float* emid = tot + 640;
  float* dec = tot + 768;
  const float* lf = dir ? p.lfb : p.lff;
  u16* og = dir ? p.ob : p.of;
  const int kp = lane;
  const int k16 = (2 * kp) & 15, grp = k16 >> 2;
  const int pk0 = ((2 * kp) & ~15) | ((grp == 1 ? 2 : grp == 2 ? 1 : grp) << 2) | ((2 * kp) & 3);
  const int tp = tid & 31, vc = (tid >> 5) * 16;
  f32x16 S[4];
#pragma unroll
  for (int a = 0; a < 4; ++a)
#pragma unroll
    for (int i = 0; i < 16; ++i) S[a][i] = 0.f;
  const size_t colb = (size_t)hh * 128;
  __syncthreads();
  for (int c = 0; c < 64; ++c) {
    const int s0 = dir ? SEQ - 64 * (c + 1) : 64 * c;
    const size_t tb = (size_t)bi * SEQ + s0;
    float2 lgv[16]; uint32_t qv[16];
#pragma unroll
    for (int e = 0; e < 16; ++e) {
      const int tau = 16 * w + e;
      const size_t tok = tb + (dir ? 63 - tau : tau);
      lgv[e] = *(const float2*)((const char*)(lf + tok * 512 + colb) + (unsigned)(kp * 8));
      qv[e] = *(const uint32_t*)((const char*)(p.hq + tok * 512 + colb) + (unsigned)(kp * 4));
    }
    {
      const size_t tok0 = tb + (dir ? 63 - 2 * tp : 2 * tp), tok1 = tb + (dir ? 62 - 2 * tp : 2 * tp + 1);
      const u32x4 a0 = *(const u32x4*)(p.hi + tok0 * 512 + colb + vc), a1 = *(const u32x4*)(p.hi + tok0 * 512 + colb + vc + 8);
      const u32x4 b0 = *(const u32x4*)(p.hi + tok1 * 512 + colb + vc), b1 = *(const u32x4*)(p.hi + tok1 * 512 + colb + vc + 8);
      uint32_t* d = (uint32_t*)(IT + vc * HSP + 2 * tp);
#pragma unroll
      for (int j = 0; j < 4; ++j) {
        d[(2 * j) * (HSP / 2)] = (a0[j] & 0xffffu) | (b0[j] << 16);
        d[(2 * j + 1) * (HSP / 2)] = (a0[j] >> 16) | (b0[j] & 0xffff0000u);
        d[(8 + 2 * j) * (HSP / 2)] = (a1[j] & 0xffffu) | (b1[j] << 16);
        d[(8 + 2 * j + 1) * (HSP / 2)] = (a1[j] >> 16) | (b1[j] & 0xffff0000u);
      }
    }
    {
      float2 run = make_float2(0.f, 0.f);
#pragma unroll
      for (int e = 0; e < 16; ++e) { run.x += lgv[e].x; run.y += lgv[e].y; }
      *(float2*)(tot + w * 128 + 2 * kp) = run;
      if (w == 2) *(float2*)(first2 + 2 * kp) = lgv[0];
    }
    __syncthreads();
    {
      const float2 t0 = *(const float2*)(tot + 2 * kp), t1 = *(const float2*)(tot + 128 + 2 * kp);
      const float2 t2 = *(const float2*)(tot + 256 + 2 * kp), t3 = *(const float2*)(tot + 384 + 2 * kp);
      const float2 f2 = *(const float2*)(first2 + 2 * kp);
      float2 pre = make_float2(0.f, 0.f);
      if (w > 0) { pre.x += t0.x; pre.y += t0.y; }
      if (w > 1) { pre.x += t1.x; pre.y += t1.y; }
      if (w > 2) { pre.x += t2.x; pre.y += t2.y; }
      const float2 bmid = make_float2(t0.x + t1.x + f2.x, t0.y + t1.y + f2.y);
      const float2 blast = make_float2(t0.x + t1.x + t2.x + t3.x, t0.y + t1.y + t2.y + t3.y);
      const float ccx = __expf(blast.x - bmid.x), ccy = __expf(blast.y - bmid.y);
      uint32_t kux[8], kuy[8];
      float pkx = 0.f, pky = 0.f;
      float2 run = make_float2(pre.x - bmid.x, pre.y - bmid.y);
#pragma unroll
      for (int e = 0; e < 16; ++e) {
        run.x += lgv[e].x; run.y += lgv[e].y;
        const float rx = run.x, ry = run.y;
        const float e1x = __expf(rx), e1y = __expf(ry), e2x = __expf(-rx), e2y = __expf(-ry);
        const float gx = 1.f - __expf(lgv[e].x), gy = 1.f - __expf(lgv[e].y);
        const float qx = __uint_as_float(qv[e] << 16), qy = __uint_as_float(qv[e] & 0xffff0000u);
        const float kmx = gx * e2x, kmy = gy * e2y;
        const int t = 16 * w + e;
        *(uint32_t*)(QM + t * HQP + pk0) = pack2(qx * e1x, qy * e1y);
        *(uint32_t*)(KM + t * HQP + pk0) = pack2(kmx, kmy);
        if (e & 1) { kux[e >> 1] = pack2(pkx, kmx * ccx); kuy[e >> 1] = pack2(pky, kmy * ccy); }
        else { pkx = kmx * ccx; pky = kmy * ccy; }
      }
      u32x4* d0 = (u32x4*)(KUT + (2 * kp) * HSP + 16 * w);
      u32x4* d1 = (u32x4*)(KUT + (2 * kp + 1) * HSP + 16 * w);
      u32x4 v;
      v.x = kux[0]; v.y = kux[1]; v.z = kux[2]; v.w = kux[3]; d0[0] = v;
      v.x = kux[4]; v.y = kux[5]; v.z = kux[6]; v.w = kux[7]; d0[1] = v;
      v.x = kuy[0]; v.y = kuy[1]; v.z = kuy[2]; v.w = kuy[3]; d1[0] = v;
      v.x = kuy[4]; v.y = kuy[5]; v.z = kuy[6]; v.w = kuy[7]; d1[1] = v;
      if (w == 0) {
        *(float2*)(emid + 2 * kp) = make_float2(__expf(bmid.x), __expf(bmid.y));
        *(float2*)(dec + 2 * kp) = make_float2(__expf(blast.x), __expf(blast.y));
      }
    }
    __syncthreads();
    {
      const int ti = w >> 1, si = w & 1;
      f32x16 d;
#pragma unroll
      for (int i = 0; i < 16; ++i) d[i] = 0.f;
      if (w != 1) {
#pragma unroll
        for (int ks = 0; ks < 8; ++ks) {
          const bf16x8 af = *(const bf16x8*)(KM + (si * 32 + r) * HQP + ks * 16 + h * 8);
          const bf16x8 bf = *(const bf16x8*)(QM + (ti * 32 + r) * HQP + ks * 16 + h * 8);
          d = MFMA32(af, bf, d);
        }
      }
      __syncthreads();
      const int t = ti * 32 + r;
#pragma unroll
      for (int g = 0; g < 4; ++g) {
        const int sb = si * 32 + 8 * g + 4 * h;
        u32x2 v;
        v.x = pack2(sb + 0 <= t ? d[4 * g + 0] : 0.f, sb + 1 <= t ? d[4 * g + 1] : 0.f);
        v.y = pack2(sb + 2 <= t ? d[4 * g + 2] : 0.f, sb + 3 <= t ? d[4 * g + 3] : 0.f);
        *(u32x2*)(AM + t * HSP + sb) = v;
      }
    }
    __syncthreads();
    bf16x8 ifr[4];
#pragma unroll
    for (int s4 = 0; s4 < 4; ++s4) ifr[s4] = *(const bf16x8*)(IT + (w * 32 + r) * HSP + 16 * s4 + 8 * h);
    {
      bf16x8 sp[8];
#pragma unroll
      for (int ks = 0; ks < 8; ++ks) {
        const int kt4 = ks >> 1, hf = ks & 1;
        const float4 ea = *(const float4*)(emid + kt4 * 32 + 16 * hf + 4 * h);
        const float4 eb = *(const float4*)(emid + kt4 * 32 + 16 * hf + 8 + 4 * h);
        u32x4 pk;
        pk.x = pack2(S[kt4][8 * hf + 0] * ea.x, S[kt4][8 * hf + 1] * ea.y);
        pk.y = pack2(S[kt4][8 * hf + 2] * ea.z, S[kt4][8 * hf + 3] * ea.w);
        pk.z = pack2(S[kt4][8 * hf + 4] * eb.x, S[kt4][8 * hf + 5] * eb.y);
        pk.w = pack2(S[kt4][8 * hf + 6] * eb.z, S[kt4][8 * hf + 7] * eb.w);
        sp[ks] = __builtin_bit_cast(bf16x8, pk);
      }
#pragma unroll
      for (int ti = 0; ti < 2; ++ti) {
        f32x16 oa;
#pragma unroll
        for (int i = 0; i < 16; ++i) oa[i] = 0.f;
#pragma unroll
        for (int s4 = 0; s4 < (ti == 0 ? 2 : 4); ++s4) {
          const bf16x8 am = *(const bf16x8*)(AM + (ti * 32 + r) * HSP + 16 * s4 + 8 * h);
          oa = MFMA32(am, ifr[s4], oa);
        }
#pragma unroll
        for (int ks = 0; ks < 8; ++ks) {
          const bf16x8 qf = *(const bf16x8*)(QM + (ti * 32 + r) * HQP + ks * 16 + 8 * h);
          oa = MFMA32(qf, sp[ks], oa);
        }
#pragma unroll
        for (int i = 0; i < 16; ++i) {
          const int tau = ti * 32 + crow(i, h);
          const size_t tok = tb + (dir ? 63 - tau : tau);
          og[tok * 512 + colb + w * 32 + r] = f2bf(oa[i]);
        }
      }
    }
#pragma unroll
    for (int kt4 = 0; kt4 < 4; ++kt4) {
#pragma unroll
      for (int g = 0; g < 4; ++g) {
        const float4 dd = *(const float4*)(dec + kt4 * 32 + 8 * g + 4 * h);
        S[kt4][4 * g + 0] *= dd.x; S[kt4][4 * g + 1] *= dd.y; S[kt4][4 * g + 2] *= dd.z; S[kt4][4 * g + 3] *= dd.w;
      }
#pragma unroll
      for (int s4 = 0; s4 < 4; ++s4) {
        const bf16x8 kf = *(const bf16x8*)(KUT + (kt4 * 32 + r) * HSP + 16 * s4 + 8 * h);
        S[kt4] = MFMA32(kf, ifr[s4], S[kt4]);
      }
    }
    __syncthreads();
  }
}

__global__ __launch_bounds__(256) void naive_attn(Params p) {
  const int gid = blockIdx.x * 256 + threadIdx.x;
  const int s = gid & 4095, bh = gid >> 12, head = bh & 7, bi = bh >> 3, kvh = head >> 2;
  float qv[64], acc[64];
  const u16* qp = p.q + ((size_t)(bi * 8 + head) * SEQ + s) * 64;
#pragma unroll
  for (int d = 0; d < 64; ++d) { qv[d] = bf2f(qp[d]); acc[d] = 0.f; }
  float mx = -INFINITY, l = 0.f;
  const u16* kp = p.k + (size_t)(bi * 2 + kvh) * SEQ * 64;
  const u16* vp = p.vT + (size_t)(bi * 2 + kvh) * 64 * SEQ;
  for (int key = 0; key < SEQ; ++key) {
    float sc = 0.f;
#pragma unroll
    for (int d = 0; d < 64; ++d) sc += qv[d] * bf2f(kp[(size_t)key * 64 + d]);
    const float mn = fmaxf(mx, sc);
    const float al = exp2f(mx - mn), pp = exp2f(sc - mn);
    l = l * al + pp;
#pragma unroll
    for (int d = 0; d < 64; ++d) acc[d] = acc[d] * al + pp * bf2f(vp[(size_t)d * SEQ + key]);
    mx = mn;
  }
  const float il = 1.f / l;
  u16* op = p.attn + ((size_t)bi * SEQ + s) * 512 + head * 64;
#pragma unroll
  for (int d = 0; d < 64; ++d) op[d] = f2bf(acc[d] * il);
}

__global__ __launch_bounds__(1024) void naive_hgrn(Params p) {
  __shared__ float red[8][128];
  const int dir = blockIdx.x & 1, hh = (blockIdx.x >> 1) & 3, bi = blockIdx.x >> 3;
  const int v = threadIdx.x & 127, kq = threadIdx.x >> 7;
  float S[16];
#pragma unroll
  for (int i = 0; i < 16; ++i) S[i] = 0.f;
  const float* lf = dir ? p.lfb : p.lff;
  u16* o = dir ? p.ob : p.of;
  for (int step = 0; step < SEQ; ++step) {
    const int s = dir ? SEQ - 1 - step : step;
    const size_t base = ((size_t)bi * SEQ + s) * 512 + hh * 128;
    const float iv = bf2f(p.hi[base + v]);
    float part = 0.f;
#pragma unroll
    for (int kk = 0; kk < 16; ++kk) {
      const int k = kq * 16 + kk;
      const float lg = lf[base + k];
      const float f = expf(lg), g = -expm1f(lg);
      const float qk = bf2f(p.hq[base + k]);
      S[kk] = f * S[kk] + g * iv;
      part += S[kk] * qk;
    }
    red[kq][v] = part;
    __syncthreads();
    if (kq == 0) {
      float t = 0.f;
#pragma unroll
      for (int j = 0; j < 8; ++j) t += red[j][v];
      o[base + v] = f2bf(t);
    }
    __syncthreads();
  }
}

DI void load8(const u16* ptr, float (&v)[8]) {
  const uint4 u = *(const uint4*)ptr;
  v[0] = __uint_as_float(u.x << 16); v[1] = __uint_as_float(u.x & 0xffff0000u);
  v[2] = __uint_as_float(u.y << 16); v[3] = __uint_as_float(u.y & 0xffff0000u);
  v[4] = __uint_as_float(u.z << 16); v[5] = __uint_as_float(u.z & 0xffff0000u);
  v[6] = __uint_as_float(u.w << 16); v[7] = __uint_as_float(u.w & 0xffff0000u);
}
__device__ void phase_mix(const Params& p, int bid, int nblk) {
  const int lane = threadIdx.x & 63, w = threadIdx.x >> 6;
  u16* mix = p.xb;
  for (int m = bid * 4 + w; m < MTOK; m += nblk * 4) {
    const size_t rb = (size_t)m * 512 + lane * 8;
    float a[8], g[8], f1[8], f2[8];
    load8(p.attn + rb, a); load8(p.ga + rb, g);
    float ss = 0.f;
#pragma unroll
    for (int e = 0; e < 8; ++e) ss += a[e] * a[e];
#pragma unroll
    for (int o = 32; o >= 1; o >>= 1) ss += __shfl_xor(ss, o);
    float rstd = rsqrtf(ss * (1.f / 512.f) + 1e-6f);
    float r[8];
#pragma unroll
    for (int e = 0; e < 8; ++e) r[e] = a[e] * rstd * p.attn_norm_w[lane * 8 + e] * g[e];
    uint4 o1; o1.x = pack2(r[0], r[1]); o1.y = pack2(r[2], r[3]); o1.z = pack2(r[4], r[5]); o1.w = pack2(r[6], r[7]);
    *(uint4*)(mix + (size_t)m * 1024 + lane * 8) = o1;
    load8(p.of + rb, f1); load8(p.ob + rb, f2); load8(p.gh + rb, g);
    ss = 0.f;
#pragma unroll
    for (int e = 0; e < 8; ++e) { a[e] = f1[e] + f2[e]; ss += a[e] * a[e]; }
#pragma unroll
    for (int o = 8; o >= 1; o >>= 1) ss += __shfl_xor(ss, o);
    rstd = rsqrtf(ss * (1.f / 128.f) + 1e-6f);
#pragma unroll
    for (int e = 0; e < 8; ++e) r[e] = a[e] * rstd * p.hg_norm_w[(lane & 15) * 8 + e] * g[e];
    o1.x = pack2(r[0], r[1]); o1.y = pack2(r[2], r[3]); o1.z = pack2(r[4], r[5]); o1.w = pack2(r[6], r[7]);
    *(uint4*)(mix + (size_t)m * 1024 + 512 + lane * 8) = o1;
  }
}

__device__ void phase3(const Params& p, char* smem, int bid, int nblk) {
  const int lane = threadIdx.x & 63, w = threadIdx.x >> 6;
  const int wn = w & 1, wm = w >> 1;
  const int r = lane & 31, h = lane >> 5;
  const int ntiles = (MTOK / 128) * 8;
  for (int tile = bid; tile < ntiles; tile += nblk) {
    const int mt = tile >> 3, nt = tile & 7;
    f32x16 acc[2][2];
    gemm_mainloop(p.woutT, p.xb, nt * 128, mt * 128, smem, acc);
#pragma unroll
    for (int b = 0; b < 2; ++b) {
      const size_t m = mt * 128 + wm * 64 + b * 32 + r;
#pragma unroll
      for (int a = 0; a < 2; ++a)
#pragma unroll
        for (int g = 0; g < 4; ++g) {
          const int n = nt * 128 + wn * 64 + a * 32 + 8 * g + 4 * h;
          const float4 xv = *(const float4*)(p.x + m * 1024 + n);
          float4 o;
          o.x = DN_ALPHA * xv.x + acc[a][b][4 * g + 0];
          o.y = DN_ALPHA * xv.y + acc[a][b][4 * g + 1];
          o.z = DN_ALPHA * xv.z + acc[a][b][4 * g + 2];
          o.w = DN_ALPHA * xv.w + acc[a][b][4 * g + 3];
          *(float4*)(p.out + m * 1024 + n) = o;
        }
    }
  }
}

__device__ void phase4(const Params& p, int bid, int nblk) {
  const int lane = threadIdx.x & 63, w = threadIdx.x >> 6;
  for (int m = bid * 4 + w; m < MTOK; m += nblk * 4) {
    float4* row = (float4*)(p.out + (size_t)m * 1024);
    float4 v[4];
    float s = 0.f;
#pragma unroll
    for (int j = 0; j < 4; ++j) { v[j] = row[lane + 64 * j]; s += v[j].x + v[j].y + v[j].z + v[j].w; }
#pragma unroll
    for (int o = 32; o >= 1; o >>= 1) s += __shfl_xor(s, o);
    const float mu = s * (1.f / 1024.f);
    float q = 0.f;
#pragma unroll
    for (int j = 0; j < 4; ++j) {
      v[j].x -= mu; v[j].y -= mu; v[j].z -= mu; v[j].w -= mu;
      q += v[j].x * v[j].x + v[j].y * v[j].y + v[j].z * v[j].z + v[j].w * v[j].w;
    }
#pragma unroll
    for (int o = 32; o >= 1; o >>= 1) q += __shfl_xor(q, o);
    const float rstd = rsqrtf(q * (1.f / 1024.f) + 1e-5f);
#pragma unroll
    for (int j = 0; j < 4; ++j) {
      const float4 wv = ((const float4*)p.ln_w)[lane + 64 * j], bv = ((const float4*)p.ln_b)[lane + 64 * j];
      float4 o;
      o.x = v[j].x * rstd * wv.x + bv.x; o.y = v[j].y * rstd * wv.y + bv.y;
      o.z = v[j].z * rstd * wv.z + bv.z; o.w = v[j].w * rstd * wv.w + bv.w;
      row[lane + 64 * j] = o;
    }
  }
}


constexpr int MEGA_LDS = HG_LDS > GEMM_LDS ? HG_LDS : GEMM_LDS;
__global__ void __launch_bounds__(256, 2) mega_kernel(Params p) {
  __shared__ __attribute__((aligned(16))) char smem[MEGA_LDS];
  __shared__ int s_item;
  cg::grid_group grid = cg::this_grid();
  const int bid = blockIdx.x, nblk = gridDim.x;
  if (bid == 0 && threadIdx.x == 0) *p.ctr = 0;
  phase0(p, smem, bid, nblk);
  grid.sync();
  phase1(p, smem, bid, nblk);
  grid.sync();
  if (bid < 64) hgrn_item(p, smem, bid);
  for (;;) {
    __syncthreads();
    if (threadIdx.x == 0) s_item = atomicAdd(p.ctr, 1);
    __syncthreads();
    const int it = s_item;
    if (it >= 2048) break;
    attn_item(p, smem, it);
  }
  grid.sync();
  phase_mix(p, bid, nblk);
  grid.sync();
  phase3(p, smem, bid, nblk);
  grid.sync();
  phase4(p, bid, nblk);
}

__global__ __launch_bounds__(256) void k_phase0(Params p) { __shared__ __attribute__((aligned(16))) char smem[64 * 65 * 4]; phase0(p, smem, blockIdx.x, gridDim.x); }
__global__ __launch_bounds__(256) void k_phase1(Params p) { __shared__ __attribute__((aligned(16))) char smem[GEMM_LDS]; phase1(p, smem, blockIdx.x, gridDim.x); }
__global__ __launch_bounds__(256) void k_attn(Params p) { __shared__ __attribute__((aligned(16))) char smem[ATT_LDS]; for (int it = blockIdx.x; it < 2048; it += gridDim.x) attn_item(p, smem, it); }
__global__ __launch_bounds__(256) void k_hgrn(Params p) { __shared__ __attribute__((aligned(16))) char smem[HG_LDS]; for (int it = blockIdx.x; it < 64; it += gridDim.x) hgrn_item(p, smem, it); }
__global__ __launch_bounds__(256) void k_mix(Params p) { phase_mix(p, blockIdx.x, gridDim.x); }
__global__ __launch_bounds__(256) void k_phase3(Params p) { __shared__ __attribute__((aligned(16))) char smem[GEMM_LDS]; phase3(p, smem, blockIdx.x, gridDim.x); }
__global__ __launch_bounds__(256) void k_phase4(Params p) { phase4(p, blockIdx.x, gridDim.x); }

extern "C" void kernel_launch(void* const* d_in, const int* in_sizes, int n_in, void* d_out, int out_size, void* d_ws, size_t ws_size,
                              hipStream_t stream) {
  Params p{};
  p.x = (const float*)d_in[0]; p.w_in = (const float*)d_in[1]; p.q_norm_w = (const float*)d_in[2]; p.k_norm_w = (const float*)d_in[3];
  p.attn_norm_w = (const float*)d_in[4]; p.lb_logits = (const float*)d_in[5]; p.hg_norm_w = (const float*)d_in[6];
  p.w_out = (const float*)d_in[7]; p.ln_w = (const float*)d_in[8]; p.ln_b = (const float*)d_in[9];
  p.out = (float*)d_out;
  char* ws = (char*)d_ws;
  size_t off = 0;
  auto take = [&](size_t bytes) { char* r = ws + off; off += (bytes + 255) & ~(size_t)255; return r; };
  p.xb = (u16*)take((size_t)MTOK * 1024 * 2);
  p.winT = (u16*)take((size_t)INW * 1024 * 2);
  p.woutT = (u16*)take((size_t)1024 * 1024 * 2);
  p.rope = (float2*)take(1024 * 8);
  p.lbv = (float*)take(1024 * 4);
  p.q = (u16*)take((size_t)MTOK * 512 * 2);
  p.k = (u16*)take((size_t)MTOK * 128 * 2);
  p.vT = (u16*)take((size_t)MTOK * 128 * 2);
  p.ga = (u16*)take((size_t)MTOK * 512 * 2);
  p.hq = (u16*)take((size_t)MTOK * 512 * 2);
  p.hi = (u16*)take((size_t)MTOK * 512 * 2);
  p.lff = (float*)take((size_t)MTOK * 512 * 4);
  p.lfb = (float*)take((size_t)MTOK * 512 * 4);
  p.gh = (u16*)take((size_t)MTOK * 512 * 2);
  p.attn = (u16*)take((size_t)MTOK * 512 * 2);
  p.of = (u16*)take((size_t)MTOK * 512 * 2);
  p.ob = (u16*)take((size_t)MTOK * 512 * 2);
  p.ctr = (int*)take(256);
  if (off > ws_size) { fprintf(stderr, "workspace too small: need %zu have %zu\n", off, ws_size); return; }
#if ONE_LAUNCH
  static int grid_blocks = 0;
  if (!grid_blocks) {
    int dev = 0, cus = 0, per_cu = 0;
    hipGetDevice(&dev);
    hipDeviceGetAttribute(&cus, hipDeviceAttributeMultiprocessorCount, dev);
    hipOccupancyMaxActiveBlocksPerMultiprocessor(&per_cu, mega_kernel, 256, 0);
    if (per_cu > 2) per_cu = 2;
    grid_blocks = cus * per_cu;
    if (grid_blocks < 64) fprintf(stderr, "grid too small: %d\n", grid_blocks);
  }
  void* args[] = {&p};
  hipError_t e = hipLaunchCooperativeKernel((void*)mega_kernel, dim3(grid_blocks), dim3(256), args, 0, stream);
  if (e != hipSuccess) fprintf(stderr, "cooperative launch failed: %s (grid %d)\n", hipGetErrorString(e), grid_blocks);
#else
  k_phase0<<<1024, 256, 0, stream>>>(p);
  k_phase1<<<512, 256, 0, stream>>>(p);
  k_attn<<<2048, 256, 0, stream>>>(p);
  k_hgrn<<<64, 256, 0, stream>>>(p);
  k_mix<<<2048, 256, 0, stream>>>(p);
  k_phase3<<<512, 256, 0, stream>>>(p);
  k_phase4<<<2048, 256, 0, stream>>>(p);
#endif
}
```

```cpp
#include <hip/hip_runtime.h>
#include <hip/hip_cooperative_groups.h>
#include <stdint.h>
#include <stdio.h>

namespace cg = cooperative_groups;

#ifndef ONE_LAUNCH
#define ONE_LAUNCH 1
#endif
#ifndef PROBE_P1
#define PROBE_P1 0
#endif
#ifndef PROBE_HG
#define PROBE_HG 0
#endif
#ifndef PROBE_AT
#define PROBE_AT 0
#endif
#ifndef PROBE_P3
#define PROBE_P3 0
#endif

typedef __attribute__((ext_vector_type(8))) short bf16x8;
typedef __attribute__((ext_vector_type(4))) short s16x4;
typedef __attribute__((ext_vector_type(16))) float f32x16;
typedef unsigned short u16;
typedef __attribute__((ext_vector_type(4))) unsigned u32x4;
typedef __attribute__((ext_vector_type(2))) unsigned u32x2;

#define DI __device__ __forceinline__
#define MFMA32(a, b, c) __builtin_amdgcn_mfma_f32_32x32x16_bf16((a), (b), (c), 0, 0, 0)

constexpr int MTOK = 32768;
constexpr int SEQ = 4096;
constexpr int DM = 1024;
constexpr int INW = 3840;
constexpr float Q_PRESCALE = 0.125f * 1.4426950408889634f;
constexpr float HQ_SCALE = 0.08838834764831845f;
constexpr float DN_ALPHA = 1.189207115002721f;

struct Params {
  const float* x; const float* w_in; const float* q_norm_w; const float* k_norm_w;
  const float* attn_norm_w; const float* lb_logits; const float* hg_norm_w; const float* w_out;
  const float* ln_w; const float* ln_b;
  float* out;
  u16* xb;
  u16* winT;
  u16* woutT;
  float2* rope;
  float* lbv;
  u16* q;
  u16* k;
  u16* vT;
  u16* ga;
  u16* hq;
  u16* hi;
  float* lff;
  float* lfb;
  u16* gh;
  u16* attn;
  u16* of;
  u16* ob;
  int* ctr;
  unsigned* bar;
  u16* mix;
  float* z;
};

DI u16 f2bf(float x) { uint32_t u = __float_as_uint(x); u += 0x7fffu + ((u >> 16) & 1u); return (u16)(u >> 16); }
DI float bf2f(u16 v) { return __uint_as_float(((uint32_t)v) << 16); }
typedef __attribute__((ext_vector_type(2))) float f32x2_t;
typedef __attribute__((ext_vector_type(2))) __bf16 bf16x2_t;
DI uint32_t pack2(float a, float b) { f32x2_t v = {a, b}; bf16x2_t r = __builtin_convertvector(v, bf16x2_t); return __builtin_bit_cast(uint32_t, r); }
DI int crow(int i, int h) { return (i & 3) + 8 * (i >> 2) + 4 * h; }
DI float silu_f(float v) { return v * __builtin_amdgcn_rcpf(1.f + __expf(-v)); }

__device__ void phase0(const Params& p, char* smem, int bid, int nblk) {
  const int tid = threadIdx.x;
  {
    const size_t nvec = (size_t)MTOK * DM / 8;
    const size_t T = (size_t)nblk * 256;
    for (size_t i = (size_t)bid * 256 + tid; i < nvec; i += 4 * T) {
      float4 a[4], b[4];
#pragma unroll
      for (int u = 0; u < 4; ++u) {
        const size_t ii = i + u * T;
        if (ii < nvec) { a[u] = ((const float4*)p.x)[2 * ii]; b[u] = ((const float4*)p.x)[2 * ii + 1]; }
      }
#pragma unroll
      for (int u = 0; u < 4; ++u) {
        const size_t ii = i + u * T;
        if (ii < nvec) {
          uint4 o; o.x = pack2(a[u].x, a[u].y); o.y = pack2(a[u].z, a[u].w); o.z = pack2(b[u].x, b[u].y); o.w = pack2(b[u].z, b[u].w);
          ((uint4*)p.xb)[ii] = o;
        }
      }
    }
  }
  {
    float* t = (float*)smem;
    const int ntile_in = 16 * 60, ntile_all = ntile_in + 16 * 16;
    for (int tile = bid; tile < ntile_all; tile += nblk) {
      const float* src; u16* dst; int N, kt, nt;
      if (tile < ntile_in) { src = p.w_in; dst = p.winT; N = INW; kt = tile / 60; nt = tile % 60; }
      else { int tt = tile - ntile_in; src = p.w_out; dst = p.woutT; N = DM; kt = tt / 16; nt = tt % 16; }
      __syncthreads();
#pragma unroll
      for (int j = 0; j < 4; ++j) {
        const int kk = (tid >> 4) + 16 * j, nn = (tid & 15) * 4;
        const float4 v = *(const float4*)(src + (size_t)(kt * 64 + kk) * N + nt * 64 + nn);
        t[kk * 65 + nn] = v.x; t[kk * 65 + nn + 1] = v.y; t[kk * 65 + nn + 2] = v.z; t[kk * 65 + nn + 3] = v.w;
      }
      __syncthreads();
      const int n = tid >> 2, kc = (tid & 3) * 16;
      uint32_t o[8];
#pragma unroll
      for (int j = 0; j < 8; ++j) o[j] = pack2(t[(kc + 2 * j) * 65 + n], t[(kc + 2 * j + 1) * 65 + n]);
      uint4* d = (uint4*)(dst + (size_t)(nt * 64 + n) * 1024 + kt * 64 + kc);
      d[0] = make_uint4(o[0], o[1], o[2], o[3]);
      d[1] = make_uint4(o[4], o[5], o[6], o[7]);
    }
  }
  for (int i = bid * 256 + tid; i < 2048; i += nblk * 256) {
    if (i < 1024) {
      const int pos = i >> 4, j = i & 15;
      const float inv = powf(10000.f, -(float)(2 * j) / 32.f);
      const float ang = (float)pos * inv;
      p.rope[i] = make_float2(cosf(ang), sinf(ang));
    } else {
      const int ii = i - 1024, dir = ii >> 9, wcol = ii & 511;
      const float l0 = p.lb_logits[(dir * 2 + 0) * 512 + wcol], l1 = p.lb_logits[(dir * 2 + 1) * 512 + wcol];
      const float mx = fmaxf(l0, l1);
      const float e0 = expf(l0 - mx), e1 = expf(l1 - mx);
      p.lbv[ii] = e0 / (e0 + e1);
    }
  }
}

constexpr int GP = 72;
constexpr int GEMM_LDS = 2 * 2 * 128 * GP * 2;

DI void gemm_mainloop(const u16* __restrict__ A, const u16* __restrict__ B, int n0, int m0, char* smem, f32x16 (&acc)[2][2]) {
  const int tid = threadIdx.x, lane = tid & 63, w = __builtin_amdgcn_readfirstlane(tid >> 6);
  const int wn = w & 1, wm = w >> 1;
  const int lc = tid & 7, lr = tid >> 3;
  u16* sm = (u16*)smem;
  const u16* gA = A + (size_t)(n0 + lr) * 1024 + lc * 8;
  const u16* gB = B + (size_t)(m0 + lr) * 1024 + lc * 8;
#pragma unroll
  for (int a = 0; a < 2; ++a)
#pragma unroll
    for (int b = 0; b < 2; ++b)
#pragma unroll
      for (int i = 0; i < 16; ++i) acc[a][b][i] = 0.f;
  u32x4 ra0[4], rb0[4], ra1[4], rb1[4];
#pragma unroll
  for (int j = 0; j < 4; ++j) { ra0[j] = *(const u32x4*)(gA + (size_t)j * 32 * 1024); rb0[j] = *(const u32x4*)(gB + (size_t)j * 32 * 1024); }
#pragma unroll
  for (int j = 0; j < 4; ++j) { ra1[j] = *(const u32x4*)(gA + (size_t)j * 32 * 1024 + 64); rb1[j] = *(const u32x4*)(gB + (size_t)j * 32 * 1024 + 64); }
  __syncthreads();
#pragma unroll
  for (int j = 0; j < 4; ++j) {
    *(u32x4*)(sm + (0 * 128 + lr + 32 * j) * GP + lc * 8) = ra0[j];
    *(u32x4*)(sm + (1 * 128 + lr + 32 * j) * GP + lc * 8) = rb0[j];
  }
  __syncthreads();
  const int fr = lane & 31, fh = lane >> 5;
  const u16* fa = sm + (wn * 64 + fr) * GP + fh * 8;
  const u16* fb = sm + (128 + wm * 64 + fr) * GP + fh * 8;
#define GEMM_COMPUTE(ST)                                                                          \
  _Pragma("unroll") for (int ks = 0; ks < 4; ++ks) {                                              \
    bf16x8 af[2], bfr[2];                                                                         \
    _Pragma("unroll") for (int a = 0; a < 2; ++a) af[a] = *(const bf16x8*)(fa + ((ST) * 256 + a * 32) * GP + ks * 16);   \
    _Pragma("unroll") for (int b = 0; b < 2; ++b) bfr[b] = *(const bf16x8*)(fb + ((ST) * 256 + b * 32) * GP + ks * 16);  \
    _Pragma("unroll") for (int a = 0; a < 2; ++a)                                                 \
      _Pragma("unroll") for (int b = 0; b < 2; ++b) acc[a][b] = MFMA32(af[a], bfr[b], acc[a][b]); \
  }
  for (int kt = 0; kt < 16; kt += 2) {
    if (kt + 2 < 16) {
#pragma unroll
      for (int j = 0; j < 4; ++j) {
        ra0[j] = *(const u32x4*)(gA + (size_t)j * 32 * 1024 + (kt + 2) * 64);
        rb0[j] = *(const u32x4*)(gB + (size_t)j * 32 * 1024 + (kt + 2) * 64);
      }
    }
    GEMM_COMPUTE(0)
#pragma unroll
    for (int j = 0; j < 4; ++j) {
      *(u32x4*)(sm + ((2 + 0) * 128 + lr + 32 * j) * GP + lc * 8) = ra1[j];
      *(u32x4*)(sm + ((2 + 1) * 128 + lr + 32 * j) * GP + lc * 8) = rb1[j];
    }
    __syncthreads();
    if (kt + 3 < 16) {
#pragma unroll
      for (int j = 0; j < 4; ++j) {
        ra1[j] = *(const u32x4*)(gA + (size_t)j * 32 * 1024 + (kt + 3) * 64);
        rb1[j] = *(const u32x4*)(gB + (size_t)j * 32 * 1024 + (kt + 3) * 64);
      }
    }
    GEMM_COMPUTE(1)
    if (kt + 2 < 16) {
#pragma unroll
      for (int j = 0; j < 4; ++j) {
        *(u32x4*)(sm + (0 * 128 + lr + 32 * j) * GP + lc * 8) = ra0[j];
        *(u32x4*)(sm + (1 * 128 + lr + 32 * j) * GP + lc * 8) = rb0[j];
      }
    }
    __syncthreads();
  }
#undef GEMM_COMPUTE
}

__device__ void phase1(const Params& p, char* smem, int bid, int nblk) {
  const int lane = threadIdx.x & 63, w = threadIdx.x >> 6;
  const int wn = w & 1, wm = w >> 1;
  const int r = lane & 31, h = lane >> 5;
  const int ntiles = (MTOK / 128) * 30;
  for (int tile = bid; tile < ntiles; tile += nblk) {
    const int mt = tile / 30, nt = tile % 30;
    f32x16 acc[2][2];
    gemm_mainloop(p.winT, p.xb, nt * 128, mt * 128, smem, acc);
    const int mbase = mt * 128 + wm * 64;
    if (nt <= 4) {
      const bool isq = nt < 4;
      const int head = isq ? nt * 2 + wn : wn;
      const float* nw = isq ? p.q_norm_w : p.k_norm_w;
      const float sc = isq ? Q_PRESCALE : 1.0f;
#pragma unroll
      for (int b = 0; b < 2; ++b) {
        const int m = mbase + b * 32 + r;
        const int bi = m >> 12, s = m & 4095;
        const int rp = s >> 6, cp = s & 63;
        float ss = 0.f;
#pragma unroll
        for (int a = 0; a < 2; ++a)
#pragma unroll
          for (int i = 0; i < 16; ++i) ss += acc[a][b][i] * acc[a][b][i];
        ss += __shfl_xor(ss, 32);
        const float rstd = rsqrtf(ss * (1.f / 64.f) + 1e-6f);
        u16* dst0 = isq ? p.q + ((size_t)(bi * 8 + head) * SEQ + s) * 64 : p.k + ((size_t)(bi * 2 + head) * SEQ + s) * 64;
#pragma unroll
        for (int a = 0; a < 2; ++a) {
          const int pos = a == 0 ? rp : cp;
          float y[16], o[16];
#pragma unroll
          for (int i = 0; i < 16; ++i) y[i] = acc[a][b][i] * rstd * nw[a * 32 + crow(i, h)];
#pragma unroll
          for (int i = 0; i < 8; ++i) {
            const float2 cs = p.rope[pos * 16 + crow(i, h)];
            o[i] = (y[i] * cs.x - y[i + 8] * cs.y) * sc;
            o[i + 8] = (y[i + 8] * cs.x + y[i] * cs.y) * sc;
          }
#pragma unroll
          for (int g = 0; g < 4; ++g) {
            uint2 v; v.x = pack2(o[4 * g], o[4 * g + 1]); v.y = pack2(o[4 * g + 2], o[4 * g + 3]);
            *(uint2*)(dst0 + a * 32 + 8 * g + 4 * h) = v;
          }
        }
      }
    } else if (nt == 5) {
#pragma unroll
      for (int b = 0; b < 2; ++b) {
        const int m = mbase + b * 32 + r;
        const int bi = m >> 12, s = m & 4095;
        u16* dst0 = p.vT + ((size_t)(bi * 2 + wn) * 64) * SEQ + s;
#pragma unroll
        for (int a = 0; a < 2; ++a)
#pragma unroll
          for (int i = 0; i < 16; ++i) dst0[(size_t)(a * 32 + crow(i, h)) * SEQ] = f2bf(acc[a][b][i]);
      }
    } else {
      const int gi = (nt - 6) >> 2;
      const int cb = ((nt - 6) & 3) * 128 + wn * 64;
#pragma unroll
      for (int b = 0; b < 2; ++b) {
        const size_t m = mbase + b * 32 + r;
#pragma unroll
        for (int a = 0; a < 2; ++a)
#pragma unroll
          for (int g = 0; g < 4; ++g) {
            const int c = cb + a * 32 + 8 * g + 4 * h;
            float v[4];
#pragma unroll
            for (int e = 0; e < 4; ++e) v[e] = acc[a][b][4 * g + e];
            if (gi == 3 || gi == 4) {
              const float4 lb = *(const float4*)(p.lbv + (gi - 3) * 512 + c);
              float4 o;
              o.x = __logf(lb.x + (1.f - lb.x) * __builtin_amdgcn_rcpf(1.f + __expf(-v[0])));
              o.y = __logf(lb.y + (1.f - lb.y) * __builtin_amdgcn_rcpf(1.f + __expf(-v[1])));
              o.z = __logf(lb.z + (1.f - lb.z) * __builtin_amdgcn_rcpf(1.f + __expf(-v[2])));
              o.w = __logf(lb.w + (1.f - lb.w) * __builtin_amdgcn_rcpf(1.f + __expf(-v[3])));
              *(float4*)((gi == 3 ? p.lff : p.lfb) + m * 512 + c) = o;
            } else {
              u16* dst = gi == 0 ? p.ga : gi == 1 ? p.hq : gi == 2 ? p.hi : p.gh;
              if (gi == 0 || gi == 5) {
#pragma unroll
                for (int e = 0; e < 4; ++e) v[e] = silu_f(v[e]);
              } else if (gi == 1) {
#pragma unroll
                for (int e = 0; e < 4; ++e) v[e] = silu_f(v[e]) * HQ_SCALE;
              }
              uint2 o; o.x = pack2(v[0], v[1]); o.y = pack2(v[2], v[3]);
              *(uint2*)(dst + m * 512 + c) = o;
            }
          }
      }
    }
  }
}


constexpr int AP = 72;
constexpr int ATT_LDS = 2 * 2 * 64 * AP * 2;
DI float fast_exp2(float x) { return __builtin_amdgcn_exp2f(x); }

__device__ void attn_item(const Params& p, char* smem, int item) {
  const int tid = threadIdx.x, lane = tid & 63, w = tid >> 6, r = lane & 31, h = lane >> 5;
  const int qb = item & 31, head = (item >> 5) & 7, bi = item >> 8;
  const int kvh = head >> 2;
  const int q0 = qb * 128 + w * 32;
  u16* sm = (u16*)smem;
  bf16x8 qf[4];
  {
    const u16* qp = p.q + ((size_t)(bi * 8 + head) * SEQ + q0 + r) * 64 + h * 8;
#pragma unroll
    for (int ks = 0; ks < 4; ++ks) qf[ks] = *(const bf16x8*)(qp + ks * 16);
  }
  const int lc = tid & 7, lr = tid >> 3;
  const u16* kg = p.k + (size_t)(bi * 2 + kvh) * SEQ * 64 + (size_t)lr * 64 + lc * 8;
  const u16* vg = p.vT + (size_t)(bi * 2 + kvh) * 64 * SEQ + (size_t)lr * SEQ + lc * 8;
  const int kw = lr * AP + lc * 8;
  const int vw = lr * AP + (lc >> 1) * 16 + (lc & 1) * 4;
  u32x4 rk[2], rv[2];
#pragma unroll
  for (int j = 0; j < 2; ++j) { rk[j] = *(const u32x4*)(kg + (size_t)j * 32 * 64); rv[j] = *(const u32x4*)(vg + (size_t)j * 32 * SEQ); }
  __syncthreads();
#pragma unroll
  for (int j = 0; j < 2; ++j) {
    *(u32x4*)(sm + kw + j * 32 * AP) = rk[j];
    u16* vd = sm + 64 * AP + vw + j * 32 * AP;
    *(u32x2*)(vd) = rv[j].xy; *(u32x2*)(vd + 8) = rv[j].zw;
  }
  __syncthreads();
  f32x16 o[2];
#pragma unroll
  for (int dt = 0; dt < 2; ++dt)
#pragma unroll
    for (int i = 0; i < 16; ++i) o[dt][i] = 0.f;
  float mrun = -INFINITY, lsum = 0.f;
  for (int t = 0; t < 64; ++t) {
    const int st = t & 1;
    if (t + 1 < 64) {
#pragma unroll
      for (int j = 0; j < 2; ++j) {
        rk[j] = *(const u32x4*)(kg + (size_t)((t + 1) * 64 + j * 32) * 64);
        rv[j] = *(const u32x4*)(vg + (size_t)j * 32 * SEQ + (t + 1) * 64);
      }
    }
    const u16* sK = sm + (st * 2 + 0) * 64 * AP;
    const u16* sV = sm + (st * 2 + 1) * 64 * AP;
    f32x16 sc[2];
#pragma unroll
    for (int kt2 = 0; kt2 < 2; ++kt2) {
#pragma unroll
      for (int i = 0; i < 16; ++i) sc[kt2][i] = 0.f;
#pragma unroll
      for (int ks = 0; ks < 4; ++ks) {
        const bf16x8 kf = *(const bf16x8*)(sK + (kt2 * 32 + r) * AP + ks * 16 + h * 8);
        sc[kt2] = MFMA32(kf, qf[ks], sc[kt2]);
      }
    }
    float mx = sc[0][0];
#pragma unroll
    for (int i = 1; i < 16; ++i) mx = fmaxf(mx, sc[0][i]);
#pragma unroll
    for (int i = 0; i < 16; ++i) mx = fmaxf(mx, sc[1][i]);
    mx = fmaxf(mx, __shfl_xor(mx, 32));
    if (__any(mx > mrun)) {
      const float mn = fmaxf(mrun, mx);
      const float al = fast_exp2(mrun - mn);
      lsum *= al;
#pragma unroll
      for (int dt = 0; dt < 2; ++dt)
#pragma unroll
        for (int i = 0; i < 16; ++i) o[dt][i] *= al;
      mrun = mn;
    }
#pragma unroll
    for (int kt2 = 0; kt2 < 2; ++kt2)
#pragma unroll
      for (int i = 0; i < 16; ++i) { const float e = fast_exp2(sc[kt2][i] - mrun); sc[kt2][i] = e; lsum += e; }
#pragma unroll
    for (int s2 = 0; s2 < 4; ++s2) {
      u32x4 pk;
      pk.x = pack2(sc[s2 >> 1][8 * (s2 & 1) + 0], sc[s2 >> 1][8 * (s2 & 1) + 1]);
      pk.y = pack2(sc[s2 >> 1][8 * (s2 & 1) + 2], sc[s2 >> 1][8 * (s2 & 1) + 3]);
      pk.z = pack2(sc[s2 >> 1][8 * (s2 & 1) + 4], sc[s2 >> 1][8 * (s2 & 1) + 5]);
      pk.w = pack2(sc[s2 >> 1][8 * (s2 & 1) + 6], sc[s2 >> 1][8 * (s2 & 1) + 7]);
      const bf16x8 pf = __builtin_bit_cast(bf16x8, pk);
#pragma unroll
      for (int dt = 0; dt < 2; ++dt) {
        const bf16x8 vf = *(const bf16x8*)(sV + (dt * 32 + r) * AP + s2 * 16 + h * 8);
        o[dt] = MFMA32(vf, pf, o[dt]);
      }
    }
    if (t + 1 < 64) {
      const int ns = st ^ 1;
#pragma unroll
      for (int j = 0; j < 2; ++j) {
        *(u32x4*)(sm + (ns * 2 + 0) * 64 * AP + kw + j * 32 * AP) = rk[j];
        u16* vd = sm + (ns * 2 + 1) * 64 * AP + vw + j * 32 * AP;
        *(u32x2*)(vd) = rv[j].xy; *(u32x2*)(vd + 8) = rv[j].zw;
      }
    }
    __syncthreads();
  }
  lsum += __shfl_xor(lsum, 32);
  const float il = 1.f / lsum;
  u16* op = p.attn + ((size_t)bi * SEQ + q0 + r) * 512 + head * 64 + 4 * h;
#pragma unroll
  for (int dt = 0; dt < 2; ++dt)
#pragma unroll
    for (int g = 0; g < 4; ++g) {
      u32x2 v; v.x = pack2(o[dt][4 * g] * il, o[dt][4 * g + 1] * il); v.y = pack2(o[dt][4 * g + 2] * il, o[dt][4 * g + 3] * il);
      *(u32x2*)(op + dt * 32 + 8 * g) = v;
    }
}


constexpr int HQP = 136;
constexpr int HSP = 72;
constexpr int H_QM = 0;
constexpr int H_KM = H_QM + 64 * HQP * 2;
constexpr int H_KUT = H_KM + 64 * HQP * 2;
constexpr int H_IT = H_KUT + 128 * HSP * 2;
constexpr int H_F32 = H_IT + 128 * HSP * 2;
constexpr int HG_LDS = H_F32 + 7 * 128 * 4;

__device__ void hgrn_item(const Params& p, char* smem, int item) {
  const int tid = threadIdx.x, lane = tid & 63, w = __builtin_amdgcn_readfirstlane(tid >> 6), r = lane & 31, h = lane >> 5;
  const int dir = item & 1, hh = (item >> 1) & 3, bi = item >> 3;
  u16* QM = (u16*)(smem + H_QM);
  u16* KM = (u16*)(smem + H_KM);
  u16* AM = (u16*)(smem + H_KM);
  u16* KUT = (u16*)(smem + H_KUT);
  u16* IT = (u16*)(smem + H_IT);
  float* tot = (float*)(smem + H_F32);
  float* first2 = tot + 512;
  float* emid = tot + 640;
  float* dec = tot + 768;
  const float* lf = dir ? p.lfb : p.lff;
  u16* og = dir ? p.ob : p.of;
  const int kp = lane;
  const int k16 = (2 * kp) & 15, grp = k16 >> 2;
  const int pk0 = ((2 * kp) & ~15) | ((grp == 1 ? 2 : grp == 2 ? 1 : grp) << 2) | ((2 * kp) & 3);
  const int tp = tid & 31, vc = (tid >> 5) * 16;
  f32x16 S[4];
#pragma unroll
  for (int a = 0; a < 4; ++a)
#pragma unroll
    for (int i = 0; i < 16; ++i) S[a][i] = 0.f;
  const size_t colb = (size_t)hh * 128;
  __syncthreads();
  for (int c = 0; c < 64; ++c) {
    const int s0 = dir ? SEQ - 64 * (c + 1) : 64 * c;
    const size_t tb = (size_t)bi * SEQ + s0;
    float2 lgv[16]; uint32_t qv[16];
#pragma unroll
    for (int e = 0; e < 16; ++e) {
      const int tau = 16 * w + e;
      const size_t tok = tb + (dir ? 63 - tau : tau);
      lgv[e] = *(const float2*)((const char*)(lf + tok * 512 + colb) + (unsigned)(kp * 8));
      qv[e] = *(const uint32_t*)((const char*)(p.hq + tok * 512 + colb) + (unsigned)(kp * 4));
    }
    {
      const size_t tok0 = tb + (dir ? 63 - 2 * tp : 2 * tp), tok1 = tb + (dir ? 62 - 2 * tp : 2 * tp + 1);
      const u32x4 a0 = *(const u32x4*)(p.hi + tok0 * 512 + colb + vc), a1 = *(const u32x4*)(p.hi + tok0 * 512 + colb + vc + 8);
      const u32x4 b0 = *(const u32x4*)(p.hi + tok1 * 512 + colb + vc), b1 = *(const u32x4*)(p.hi + tok1 * 512 + colb + vc + 8);
      uint32_t* d = (uint32_t*)(IT + vc * HSP + 2 * tp);
#pragma unroll
      for (int j = 0; j < 4; ++j) {
        d[(2 * j) * (HSP / 2)] = (a0[j] & 0xffffu) | (b0[j] << 16);
        d[(2 * j + 1) * (HSP / 2)] = (a0[j] >> 16) | (b0[j] & 0xffff0000u);
        d[(8 + 2 * j) * (HSP / 2)] = (a1[j] & 0xffffu) | (b1[j] << 16);
        d[(8 + 2 * j + 1) * (HSP / 2)] = (a1[j] >> 16) | (b1[j] & 0xffff0000u);
      }
    }
    {
      float2 run = make_float2(0.f, 0.f);
#pragma unroll
      for (int e = 0; e < 16; ++e) { run.x += lgv[e].x; run.y += lgv[e].y; }
      *(float2*)(tot + w * 128 + 2 * kp) = run;
      if (w == 2) *(float2*)(first2 + 2 * kp) = lgv[0];
    }
    __syncthreads();
    {
      const float2 t0 = *(const float2*)(tot + 2 * kp), t1 = *(const float2*)(tot + 128 + 2 * kp);
      const float2 t2 = *(const float2*)(tot + 256 + 2 * kp), t3 = *(const float2*)(tot + 384 + 2 * kp);
      const float2 f2 = *(const float2*)(first2 + 2 * kp);
      float2 pre = make_float2(0.f, 0.f);
      if (w > 0) { pre.x += t0.x; pre.y += t0.y; }
      if (w > 1) { pre.x += t1.x; pre.y += t1.y; }
      if (w > 2) { pre.x += t2.x; pre.y += t2.y; }
      const float2 bmid = make_float2(t0.x + t1.x + f2.x, t0.y + t1.y + f2.y);
      const float2 blast = make_float2(t0.x + t1.x + t2.x + t3.x, t0.y + t1.y + t2.y + t3.y);
      const float ccx = __expf(blast.x - bmid.x), ccy = __expf(blast.y - bmid.y);
      uint32_t kux[8], kuy[8];
      float pkx = 0.f, pky = 0.f;
      float2 run = make_float2(pre.x - bmid.x, pre.y - bmid.y);
#pragma unroll
      for (int e = 0; e < 16; ++e) {
        run.x += lgv[e].x; run.y += lgv[e].y;
        const float rx = run.x, ry = run.y;
        const float e1x = __expf(rx), e1y = __expf(ry), e2x = __expf(-rx), e2y = __expf(-ry);
        const float gx = 1.f - __expf(lgv[e].x), gy = 1.f - __expf(lgv[e].y);
        const float qx = __uint_as_float(qv[e] << 16), qy = __uint_as_float(qv[e] & 0xffff0000u);
        const float kmx = gx * e2x, kmy = gy * e2y;
        const int t = 16 * w + e;
        *(uint32_t*)(QM + t * HQP + pk0) = pack2(qx * e1x, qy * e1y);
        *(uint32_t*)(KM + t * HQP + pk0) = pack2(kmx, kmy);
        if (e & 1) { kux[e >> 1] = pack2(pkx, kmx * ccx); kuy[e >> 1] = pack2(pky, kmy * ccy); }
        else { pkx = kmx * ccx; pky = kmy * ccy; }
      }
      u32x4* d0 = (u32x4*)(KUT + (2 * kp) * HSP + 16 * w);
      u32x4* d1 = (u32x4*)(KUT + (2 * kp + 1) * HSP + 16 * w);
      u32x4 v;
      v.x = kux[0]; v.y = kux[1]; v.z = kux[2]; v.w = kux[3]; d0[0] = v;
      v.x = kux[4]; v.y = kux[5]; v.z = kux[6]; v.w = kux[7]; d0[1] = v;
      v.x = kuy[0]; v.y = kuy[1]; v.z = kuy[2]; v.w = kuy[3]; d1[0] = v;
      v.x = kuy[4]; v.y = kuy[5]; v.z = kuy[6]; v.w = kuy[7]; d1[1] = v;
      if (w == 0) {
        *(float2*)(emid + 2 * kp) = make_float2(__expf(bmid.x), __expf(bmid.y));
        *(float2*)(dec + 2 * kp) = make_float2(__expf(blast.x), __expf(blast.y));
      }
    }
    __syncthreads();
    {
      const int ti = w >> 1, si = w & 1;
      f32x16 d;
#pragma unroll
      for (int i = 0; i < 16; ++i) d[i] = 0.f;
      if (w != 1) {
#pragma unroll
        for (int ks = 0; ks < 8; ++ks) {
          const bf16x8 af = *(const bf16x8*)(KM + (si * 32 + r) * HQP + ks * 16 + h * 8);
          const bf16x8 bf = *(const bf16x8*)(QM + (ti * 32 + r) * HQP + ks * 16 + h * 8);
          d = MFMA32(af, bf, d);
        }
      }
      __syncthreads();
      const int t = ti * 32 + r;
#pragma unroll
      for (int g = 0; g < 4; ++g) {
        const int sb = si * 32 + 8 * g + 4 * h;
        u32x2 v;
        v.x = pack2(sb + 0 <= t ? d[4 * g + 0] : 0.f, sb + 1 <= t ? d[4 * g + 1] : 0.f);
        v.y = pack2(sb + 2 <= t ? d[4 * g + 2] : 0.f, sb + 3 <= t ? d[4 * g + 3] : 0.f);
        *(u32x2*)(AM + t * HSP + sb) = v;
      }
    }
    __syncthreads();
    bf16x8 ifr[4];
#pragma unroll
    for (int s4 = 0; s4 < 4; ++s4) ifr[s4] = *(const bf16x8*)(IT + (w * 32 + r) * HSP + 16 * s4 + 8 * h);
    {
      bf16x8 sp[8];
#pragma unroll
      for (int ks = 0; ks < 8; ++ks) {
        const int kt4 = ks >> 1, hf = ks & 1;
        const float4 ea = *(const float4*)(emid + kt4 * 32 + 16 * hf + 4 * h);
        const float4 eb = *(const float4*)(emid + kt4 * 32 + 16 * hf + 8 + 4 * h);
        u32x4 pk;
        pk.x = pack2(S[kt4][8 * hf + 0] * ea.x, S[kt4][8 * hf + 1] * ea.y);
        pk.y = pack2(S[kt4][8 * hf + 2] * ea.z, S[kt4][8 * hf + 3] * ea.w);
        pk.z = pack2(S[kt4][8 * hf + 4] * eb.x, S[kt4][8 * hf + 5] * eb.y);
        pk.w = pack2(S[kt4][8 * hf + 6] * eb.z, S[kt4][8 * hf + 7] * eb.w);
        sp[ks] = __builtin_bit_cast(bf16x8, pk);
      }
#pragma unroll
      for (int ti = 0; ti < 2; ++ti) {
        f32x16 oa;
#pragma unroll
        for (int i = 0; i < 16; ++i) oa[i] = 0.f;
#pragma unroll
        for (int s4 = 0; s4 < (ti == 0 ? 2 : 4); ++s4) {
          const bf16x8 am = *(const bf16x8*)(AM + (ti * 32 + r) * HSP + 16 * s4 + 8 * h);
          oa = MFMA32(am, ifr[s4], oa);
        }
#pragma unroll
        for (int ks = 0; ks < 8; ++ks) {
          const bf16x8 qf = *(const bf16x8*)(QM + (ti * 32 + r) * HQP + ks * 16 + 8 * h);
          oa = MFMA32(qf, sp[ks], oa);
        }
#pragma unroll
        for (int i = 0; i < 16; ++i) {
          const int tau = ti * 32 + crow(i, h);
          const size_t tok = tb + (dir ? 63 - tau : tau);
          og[tok * 512 + colb + w * 32 + r] = f2bf(oa[i]);
        }
      }
    }
#pragma unroll
    for (int kt4 = 0; kt4 < 4; ++kt4) {
#pragma unroll
      for (int g = 0; g < 4; ++g) {
        const float4 dd = *(const float4*)(dec + kt4 * 32 + 8 * g + 4 * h);
        S[kt4][4 * g + 0] *= dd.x; S[kt4][4 * g + 1] *= dd.y; S[kt4][4 * g + 2] *= dd.z; S[kt4][4 * g + 3] *= dd.w;
      }
#pragma unroll
      for (int s4 = 0; s4 < 4; ++s4) {
        const bf16x8 kf = *(const bf16x8*)(KUT + (kt4 * 32 + r) * HSP + 16 * s4 + 8 * h);
        S[kt4] = MFMA32(kf, ifr[s4], S[kt4]);
      }
    }
    __syncthreads();
  }
}

__global__ __launch_bounds__(256) void naive_attn(Params p) {
  const int gid = blockIdx.x * 256 + threadIdx.x;
  const int s = gid & 4095, bh = gid >> 12, head = bh & 7, bi = bh >> 3, kvh = head >> 2;
  float qv[64], acc[64];
  const u16* qp = p.q + ((size_t)(bi * 8 + head) * SEQ + s) * 64;
#pragma unroll
  for (int d = 0; d < 64; ++d) { qv[d] = bf2f(qp[d]); acc[d] = 0.f; }
  float mx = -INFINITY, l = 0.f;
  const u16* kp = p.k + (size_t)(bi * 2 + kvh) * SEQ * 64;
  const u16* vp = p.vT + (size_t)(bi * 2 + kvh) * 64 * SEQ;
  for (int key = 0; key < SEQ; ++key) {
    float sc = 0.f;
#pragma unroll
    for (int d = 0; d < 64; ++d) sc += qv[d] * bf2f(kp[(size_t)key * 64 + d]);
    const float mn = fmaxf(mx, sc);
    const float al = exp2f(mx - mn), pp = exp2f(sc - mn);
    l = l * al + pp;
#pragma unroll
    for (int d = 0; d < 64; ++d) acc[d] = acc[d] * al + pp * bf2f(vp[(size_t)d * SEQ + key]);
    mx = mn;
  }
  const float il = 1.f / l;
  u16* op = p.attn + ((size_t)bi * SEQ + s) * 512 + head * 64;
#pragma unroll
  for (int d = 0; d < 64; ++d) op[d] = f2bf(acc[d] * il);
}

__global__ __launch_bounds__(1024) void naive_hgrn(Params p) {
  __shared__ float red[8][128];
  const int dir = blockIdx.x & 1, hh = (blockIdx.x >> 1) & 3, bi = blockIdx.x >> 3;
  const int v = threadIdx.x & 127, kq = threadIdx.x >> 7;
  float S[16];
#pragma unroll
  for (int i = 0; i < 16; ++i) S[i] = 0.f;
  const float* lf = dir ? p.lfb : p.lff;
  u16* o = dir ? p.ob : p.of;
  for (int step = 0; step < SEQ; ++step) {
    const int s = dir ? SEQ - 1 - step : step;
    const size_t base = ((size_t)bi * SEQ + s) * 512 + hh * 128;
    const float iv = bf2f(p.hi[base + v]);
    float part = 0.f;
#pragma unroll
    for (int kk = 0; kk < 16; ++kk) {
      const int k = kq * 16 + kk;
      const float lg = lf[base + k];
      const float f = expf(lg), g = -expm1f(lg);
      const float qk = bf2f(p.hq[base + k]);
      S[kk] = f * S[kk] + g * iv;
      part += S[kk] * qk;
    }
    red[kq][v] = part;
    __syncthreads();
    if (kq == 0) {
      float t = 0.f;
#pragma unroll
      for (int j = 0; j < 8; ++j) t += red[j][v];
      o[base + v] = f2bf(t);
    }
    __syncthreads();
  }
}

DI void unpack8(const uint4 u, float (&v)[8]) {
  v[0] = __uint_as_float(u.x << 16); v[1] = __uint_as_float(u.x & 0xffff0000u);
  v[2] = __uint_as_float(u.y << 16); v[3] = __uint_as_float(u.y & 0xffff0000u);
  v[4] = __uint_as_float(u.z << 16); v[5] = __uint_as_float(u.z & 0xffff0000u);
  v[6] = __uint_as_float(u.w << 16); v[7] = __uint_as_float(u.w & 0xffff0000u);
}
__device__ void phase_mix(const Params& p, int bid, int nblk) {
  const int lane = threadIdx.x & 63, w = threadIdx.x >> 6;
  u16* mix = p.mix;
  float wa[8], wh[8];
#pragma unroll
  for (int e = 0; e < 8; ++e) { wa[e] = p.attn_norm_w[lane * 8 + e]; wh[e] = p.hg_norm_w[(lane & 15) * 8 + e]; }
  const int stride = nblk * 4;
  for (int m0 = bid * 4 + w; m0 < MTOK; m0 += 4 * stride) {
    uint4 ua[4], ug[4], u1[4], u2[4], uh[4];
#pragma unroll
    for (int u = 0; u < 4; ++u) {
      const int m = m0 + u * stride;
      if (m < MTOK) {
        const size_t rb = (size_t)m * 512 + lane * 8;
        ua[u] = *(const uint4*)(p.attn + rb); ug[u] = *(const uint4*)(p.ga + rb);
        u1[u] = *(const uint4*)(p.of + rb); u2[u] = *(const uint4*)(p.ob + rb); uh[u] = *(const uint4*)(p.gh + rb);
      }
    }
#pragma unroll
    for (int u = 0; u < 4; ++u) {
      const int m = m0 + u * stride;
      if (m < MTOK) {
        float a[8], g[8], f1[8], f2[8];
        unpack8(ua[u], a); unpack8(ug[u], g);
        float ss = 0.f;
#pragma unroll
        for (int e = 0; e < 8; ++e) ss += a[e] * a[e];
#pragma unroll
        for (int o = 32; o >= 1; o >>= 1) ss += __shfl_xor(ss, o);
        float rstd = rsqrtf(ss * (1.f / 512.f) + 1e-6f);
        float r[8];
#pragma unroll
        for (int e = 0; e < 8; ++e) r[e] = a[e] * rstd * wa[e] * g[e];
        uint4 o1; o1.x = pack2(r[0], r[1]); o1.y = pack2(r[2], r[3]); o1.z = pack2(r[4], r[5]); o1.w = pack2(r[6], r[7]);
        *(uint4*)(mix + (size_t)m * 1024 + lane * 8) = o1;
        unpack8(u1[u], f1); unpack8(u2[u], f2); unpack8(uh[u], g);
        ss = 0.f;
#pragma unroll
        for (int e = 0; e < 8; ++e) { a[e] = f1[e] + f2[e]; ss += a[e] * a[e]; }
#pragma unroll
        for (int o = 8; o >= 1; o >>= 1) ss += __shfl_xor(ss, o);
        rstd = rsqrtf(ss * (1.f / 128.f) + 1e-6f);
#pragma unroll
        for (int e = 0; e < 8; ++e) r[e] = a[e] * rstd * wh[e] * g[e];
        o1.x = pack2(r[0], r[1]); o1.y = pack2(r[2], r[3]); o1.z = pack2(r[4], r[5]); o1.w = pack2(r[6], r[7]);
        *(uint4*)(mix + (size_t)m * 1024 + 512 + lane * 8) = o1;
      }
    }
  }
}

__device__ void phase3(const Params& p, char* smem, int bid, int nblk) {
  const int lane = threadIdx.x & 63, w = threadIdx.x >> 6;
  const int wn = w & 1, wm = w >> 1;
  const int r = lane & 31, h = lane >> 5;
  const int ntiles = (MTOK / 128) * 8;
  for (int tile = bid; tile < ntiles; tile += nblk) {
    const int mt = tile >> 3, nt = tile & 7;
    f32x16 acc[2][2];
    gemm_mainloop(p.woutT, p.mix, nt * 128, mt * 128, smem, acc);
#pragma unroll
    for (int b = 0; b < 2; ++b) {
      const size_t m = mt * 128 + wm * 64 + b * 32 + r;
#pragma unroll
      for (int a = 0; a < 2; ++a)
#pragma unroll
        for (int g = 0; g < 4; ++g) {
          const int n = nt * 128 + wn * 64 + a * 32 + 8 * g + 4 * h;
          const float4 xv = *(const float4*)(p.x + m * 1024 + n);
          float4 o;
          o.x = DN_ALPHA * xv.x + acc[a][b][4 * g + 0];
          o.y = DN_ALPHA * xv.y + acc[a][b][4 * g + 1];
          o.z = DN_ALPHA * xv.z + acc[a][b][4 * g + 2];
          o.w = DN_ALPHA * xv.w + acc[a][b][4 * g + 3];
          *(float4*)(p.z + m * 1024 + n) = o;
        }
    }
  }
}

__device__ void phase4(const Params& p, int bid, int nblk) {
  const int lane = threadIdx.x & 63, w = threadIdx.x >> 6;
  const int stride = nblk * 4;
  for (int m0 = bid * 4 + w; m0 < MTOK; m0 += 4 * stride) {
    float4 v[4][4];
#pragma unroll
    for (int u = 0; u < 4; ++u) {
      const int m = m0 + u * stride;
      if (m < MTOK) {
        const float4* row = (const float4*)(p.z + (size_t)m * 1024);
#pragma unroll
        for (int j = 0; j < 4; ++j) v[u][j] = row[lane + 64 * j];
      }
    }
#pragma unroll
    for (int u = 0; u < 4; ++u) {
      const int m = m0 + u * stride;
      if (m < MTOK) {
        float4* row = (float4*)(p.out + (size_t)m * 1024);
        float s = 0.f;
#pragma unroll
        for (int j = 0; j < 4; ++j) s += v[u][j].x + v[u][j].y + v[u][j].z + v[u][j].w;
#pragma unroll
        for (int o = 32; o >= 1; o >>= 1) s += __shfl_xor(s, o);
        const float mu = s * (1.f / 1024.f);
        float q = 0.f;
#pragma unroll
        for (int j = 0; j < 4; ++j) {
          v[u][j].x -= mu; v[u][j].y -= mu; v[u][j].z -= mu; v[u][j].w -= mu;
          q += v[u][j].x * v[u][j].x + v[u][j].y * v[u][j].y + v[u][j].z * v[u][j].z + v[u][j].w * v[u][j].w;
        }
#pragma unroll
        for (int o = 32; o >= 1; o >>= 1) q += __shfl_xor(q, o);
        const float rstd = rsqrtf(q * (1.f / 1024.f) + 1e-5f);
#pragma unroll
        for (int j = 0; j < 4; ++j) {
          const float4 wv = ((const float4*)p.ln_w)[lane + 64 * j], bv = ((const float4*)p.ln_b)[lane + 64 * j];
          float4 o;
          o.x = v[u][j].x * rstd * wv.x + bv.x; o.y = v[u][j].y * rstd * wv.y + bv.y;
          o.z = v[u][j].z * rstd * wv.z + bv.z; o.w = v[u][j].w * rstd * wv.w + bv.w;
          row[lane + 64 * j] = o;
        }
      }
    }
  }
}


#define XB_TMO      128
#define XB_XCNT(j)  (256  + 64 * (j))
#define XB_XSUB(j)  (1280 + 64 * (j))
#define XB_XGEN(j)  (2304 + 64 * (j))
#define XB_TOP      3328
#define XB_TOPGEN   3392
#define XCD_BAR_WORDS 3456
#define XB_SPIN_CAP (1u << 18)
#define LAS __attribute__((address_space(3)))
DI unsigned xb_ld(unsigned* p) { return __hip_atomic_load(p, __ATOMIC_RELAXED, __HIP_MEMORY_SCOPE_AGENT); }
DI unsigned xb_add(unsigned* p, unsigned v) { return __hip_atomic_fetch_add(p, v, __ATOMIC_RELAXED, __HIP_MEMORY_SCOPE_AGENT); }
DI unsigned xb_xcc_id() { return (unsigned)__builtin_amdgcn_s_getreg((3 << 11) | 20) & 0xFu; }
#define XB_SPIN(cond, bar) do { unsigned _sp = 0; while (cond) { __builtin_amdgcn_s_sleep(1); \
    if ((++_sp & 255u) == 0u) { if (xb_ld(&(bar)[XB_TMO])) break; if (_sp > XB_SPIN_CAP) { atomicAdd(&(bar)[XB_TMO], 1u); break; } } } } while (0)
struct XcdBarrier { unsigned* bar; unsigned x; volatile LAS unsigned* st; };
DI XcdBarrier xcd_barrier_post(unsigned* bar, volatile LAS unsigned* st) {
  XcdBarrier b; b.bar = bar; b.x = xb_xcc_id(); b.st = st;
  if (threadIdx.x == 0) (void)xb_add(&bar[XB_XCNT(b.x)], 1u);
  return b;
}
DI void xcd_barrier_complete(unsigned* bar, unsigned x, unsigned& nloc, unsigned& nx) {
  const unsigned G = gridDim.x * gridDim.y * gridDim.z;
  unsigned sum, cnt, mine, sp = 0u;
  for (;;) {
    sum = 0u; cnt = 0u; mine = 0u;
#pragma unroll
    for (unsigned j = 0; j < 16; ++j) { const unsigned c = xb_ld(&bar[XB_XCNT(j)]); sum += c; cnt += (c > 0u) ? 1u : 0u; mine = (j == x) ? c : mine; }
    if (sum == G) break;
    __builtin_amdgcn_s_sleep(1);
    if ((++sp & 255u) == 0u) { if (xb_ld(&bar[XB_TMO])) break; if (sp > XB_SPIN_CAP) { atomicAdd(&bar[XB_TMO], 1u); break; } }
  }
  nloc = mine > 0u ? mine : 1u; nx = cnt > 0u ? cnt : 1u;
}
DI void xcd_barrier(const XcdBarrier& b) {
  asm volatile("s_waitcnt vmcnt(0)" ::: "memory");
  __syncthreads();
  if (threadIdx.x == 0) {
    unsigned* bar = b.bar;
    __builtin_amdgcn_s_waitcnt(0);
    unsigned nloc = b.st[0], nx = b.st[1];
    if (nloc == 0u) { xcd_barrier_complete(bar, b.x, nloc, nx); b.st[0] = nloc; b.st[1] = nx; }
    const unsigned old = xb_add(&bar[XB_XSUB(b.x)], 1u);
    const unsigned gen = old / nloc;
    if (old + 1u == (gen + 1u) * nloc) {
      __builtin_amdgcn_fence(__ATOMIC_RELEASE, "agent");
      asm volatile("s_waitcnt vmcnt(0)" ::: "memory");
      const unsigned og = xb_add(&bar[XB_TOP], 1u);
      const unsigned tg = og / nx;
      if (og + 1u == (tg + 1u) * nx) xb_add(&bar[XB_TOPGEN], 1u);
      else XB_SPIN(xb_ld(&bar[XB_TOPGEN]) == tg, bar);
      __builtin_amdgcn_fence(__ATOMIC_ACQUIRE, "agent");
      xb_add(&bar[XB_XGEN(b.x)], 1u);
      asm volatile("s_waitcnt vmcnt(0)" ::: "memory");
    } else {
      XB_SPIN(xb_ld(&bar[XB_XGEN(b.x)]) == gen, bar);
      __builtin_amdgcn_fence(__ATOMIC_ACQUIRE, "agent");
      asm volatile("s_waitcnt vmcnt(0)" ::: "memory");
    }
  }
  __syncthreads();
}

constexpr int MEGA_LDS = HG_LDS > GEMM_LDS ? HG_LDS : GEMM_LDS;
__global__ void __launch_bounds__(256, 2) mega_kernel(Params p) {
  __shared__ __attribute__((aligned(16))) char smem[MEGA_LDS];
  __shared__ uint4 xb_words;
  __shared__ int s_item;
  cg::grid_group grid = cg::this_grid();
  const int bid = blockIdx.x, nblk = gridDim.x;
  if (threadIdx.x == 0) xb_words = make_uint4(0u, 0u, 0u, 0u);
  __syncthreads();
  XcdBarrier xb = xcd_barrier_post(p.bar, (volatile LAS unsigned*)&xb_words);
  if (p.out == nullptr) grid.sync();
  phase0(p, smem, bid, nblk);
  xcd_barrier(xb);
  phase1(p, smem, bid, nblk);
  xcd_barrier(xb);
  if (bid < 64) hgrn_item(p, smem, bid);
  for (;;) {
    __syncthreads();
    if (threadIdx.x == 0) s_item = atomicAdd(p.ctr, 1);
    __syncthreads();
    const int it = s_item;
    if (it >= 2048) break;
    attn_item(p, smem, it);
  }
  xcd_barrier(xb);
  phase_mix(p, bid, nblk);
  xcd_barrier(xb);
  phase3(p, smem, bid, nblk);
  xcd_barrier(xb);
  phase4(p, bid, nblk);
}

__global__ __launch_bounds__(256) void k_phase0(Params p) { __shared__ __attribute__((aligned(16))) char smem[64 * 65 * 4]; phase0(p, smem, blockIdx.x, gridDim.x); }
__global__ __launch_bounds__(256) void k_phase1(Params p) { __shared__ __attribute__((aligned(16))) char smem[GEMM_LDS]; phase1(p, smem, blockIdx.x, gridDim.x); }
__global__ __launch_bounds__(256) void k_attn(Params p) { __shared__ __attribute__((aligned(16))) char smem[ATT_LDS]; for (int it = blockIdx.x; it < 2048; it += gridDim.x) attn_item(p, smem, it); }
__global__ __launch_bounds__(256) void k_hgrn(Params p) { __shared__ __attribute__((aligned(16))) char smem[HG_LDS]; for (int it = blockIdx.x; it < 64; it += gridDim.x) hgrn_item(p, smem, it); }
__global__ __launch_bounds__(256) void k_mix(Params p) { phase_mix(p, blockIdx.x, gridDim.x); }
__global__ __launch_bounds__(256) void k_phase3(Params p) { __shared__ __attribute__((aligned(16))) char smem[GEMM_LDS]; phase3(p, smem, blockIdx.x, gridDim.x); }
__global__ __launch_bounds__(256) void k_phase4(Params p) { phase4(p, blockIdx.x, gridDim.x); }

extern "C" void kernel_launch(void* const* d_in, const int* in_sizes, int n_in, void* d_out, int out_size, void* d_ws, size_t ws_size,
                              hipStream_t stream) {
  Params p{};
  p.x = (const float*)d_in[0]; p.w_in = (const float*)d_in[1]; p.q_norm_w = (const float*)d_in[2]; p.k_norm_w = (const float*)d_in[3];
  p.attn_norm_w = (const float*)d_in[4]; p.lb_logits = (const float*)d_in[5]; p.hg_norm_w = (const float*)d_in[6];
  p.w_out = (const float*)d_in[7]; p.ln_w = (const float*)d_in[8]; p.ln_b = (const float*)d_in[9];
  p.out = (float*)d_out;
  char* ws = (char*)d_ws;
  size_t off = 0;
  auto take = [&](size_t bytes) { char* r = ws + off; off += (bytes + 255) & ~(size_t)255; return r; };
  p.xb = (u16*)take((size_t)MTOK * 1024 * 2);
  p.winT = (u16*)take((size_t)INW * 1024 * 2);
  p.woutT = (u16*)take((size_t)1024 * 1024 * 2);
  p.rope = (float2*)take(1024 * 8);
  p.lbv = (float*)take(1024 * 4);
  p.q = (u16*)take((size_t)MTOK * 512 * 2);
  p.k = (u16*)take((size_t)MTOK * 128 * 2);
  p.vT = (u16*)take((size_t)MTOK * 128 * 2);
  p.ga = (u16*)take((size_t)MTOK * 512 * 2);
  p.hq = (u16*)take((size_t)MTOK * 512 * 2);
  p.hi = (u16*)take((size_t)MTOK * 512 * 2);
  p.lff = (float*)take((size_t)MTOK * 512 * 4);
  p.lfb = (float*)take((size_t)MTOK * 512 * 4);
  p.gh = (u16*)take((size_t)MTOK * 512 * 2);
  p.attn = (u16*)take((size_t)MTOK * 512 * 2);
  p.of = (u16*)take((size_t)MTOK * 512 * 2);
  p.ob = (u16*)take((size_t)MTOK * 512 * 2);
  p.ctr = (int*)take(256);
  p.bar = (unsigned*)take(XCD_BAR_WORDS * 4);
  p.mix = p.hq;
  p.z = p.lff;
  if (off > ws_size) { fprintf(stderr, "workspace too small: need %zu have %zu\n", off, ws_size); return; }
#if ONE_LAUNCH
  static int grid_blocks = 0;
  if (!grid_blocks) {
    int dev = 0, cus = 0, per_cu = 0;
    hipGetDevice(&dev);
    hipDeviceGetAttribute(&cus, hipDeviceAttributeMultiprocessorCount, dev);
    hipOccupancyMaxActiveBlocksPerMultiprocessor(&per_cu, mega_kernel, 256, 0);
    if (per_cu > 2) per_cu = 2;
    grid_blocks = cus * per_cu;
    if (grid_blocks < 64) fprintf(stderr, "grid too small: %d\n", grid_blocks);
  }
  hipMemsetAsync(p.ctr, 0, 256 + ((XCD_BAR_WORDS * 4 + 255) & ~255), stream);
  void* args[] = {&p};
  hipError_t e = hipLaunchCooperativeKernel((void*)mega_kernel, dim3(grid_blocks), dim3(256), args, 0, stream);
  if (e != hipSuccess) fprintf(stderr, "cooperative launch failed: %s (grid %d)\n", hipGetErrorString(e), grid_blocks);
#else
  k_phase0<<<1024, 256, 0, stream>>>(p);
  k_phase1<<<512, 256, 0, stream>>>(p);
  k_attn<<<2048, 256, 0, stream>>>(p);
  k_hgrn<<<64, 256, 0, stream>>>(p);
  k_mix<<<2048, 256, 0, stream>>>(p);
  k_phase3<<<512, 256, 0, stream>>>(p);
  k_phase4<<<2048, 256, 0, stream>>>(p);
#endif
}
```

```cpp
#include <hip/hip_runtime.h>
#include <hip/hip_cooperative_groups.h>
#include <stdint.h>
#include <stdio.h>

namespace cg = cooperative_groups;

#ifndef ONE_LAUNCH
#define ONE_LAUNCH 1
#endif
#ifndef PROBE_P1
#define PROBE_P1 0
#endif
#ifndef PROBE_HG
#define PROBE_HG 0
#endif
#ifndef PROBE_AT
#define PROBE_AT 0
#endif
#ifndef PROBE_P3
#define PROBE_P3 0
#endif

typedef __attribute__((ext_vector_type(8))) short bf16x8;
typedef __attribute__((ext_vector_type(4))) short s16x4;
typedef __attribute__((ext_vector_type(16))) float f32x16;
typedef unsigned short u16;
typedef __attribute__((ext_vector_type(4))) unsigned u32x4;
typedef __attribute__((ext_vector_type(2))) unsigned u32x2;

#define DI __device__ __forceinline__
#define MFMA32(a, b, c) __builtin_amdgcn_mfma_f32_32x32x16_bf16((a), (b), (c), 0, 0, 0)

constexpr int MTOK = 32768;
constexpr int SEQ = 4096;
constexpr int DM = 1024;
constexpr int INW = 3840;
constexpr float Q_PRESCALE = 0.125f * 1.4426950408889634f;
constexpr float HQ_SCALE = 0.08838834764831845f;
constexpr float DN_ALPHA = 1.189207115002721f;

struct Params {
  const float* x; const float* w_in; const float* q_norm_w; const float* k_norm_w;
  const float* attn_norm_w; const float* lb_logits; const float* hg_norm_w; const float* w_out;
  const float* ln_w; const float* ln_b;
  float* out;
  u16* xb;
  u16* winT;
  u16* woutT;
  float2* rope;
  float* lbv;
  u16* q;
  u16* k;
  u16* vT;
  u16* ga;
  u16* hq;
  u16* hi;
  u16* lff;
  u16* lfb;
  u16* gh;
  u16* attn;
  u16* of;
  u16* ob;
  int* ctr;
  unsigned* bar;
  u16* mix;
  float* z;
};

DI u16 f2bf(float x) { uint32_t u = __float_as_uint(x); u += 0x7fffu + ((u >> 16) & 1u); return (u16)(u >> 16); }
DI float bf2f(u16 v) { return __uint_as_float(((uint32_t)v) << 16); }
typedef __attribute__((ext_vector_type(2))) float f32x2_t;
typedef __attribute__((ext_vector_type(2))) __bf16 bf16x2_t;
DI uint32_t pack2(float a, float b) { f32x2_t v = {a, b}; bf16x2_t r = __builtin_convertvector(v, bf16x2_t); return __builtin_bit_cast(uint32_t, r); }
typedef __attribute__((ext_vector_type(2))) _Float16 f16x2_t;
DI uint32_t pack2h(float a, float b) { f16x2_t r = {(_Float16)a, (_Float16)b}; return __builtin_bit_cast(uint32_t, r); }
DI float h2f_lo(uint32_t u) { return (float)__builtin_bit_cast(f16x2_t, u)[0]; }
DI float h2f_hi(uint32_t u) { return (float)__builtin_bit_cast(f16x2_t, u)[1]; }
DI int crow(int i, int h) { return (i & 3) + 8 * (i >> 2) + 4 * h; }
DI float silu_f(float v) { return v * __builtin_amdgcn_rcpf(1.f + __expf(-v)); }

__device__ void phase0(const Params& p, char* smem, int bid, int nblk) {
  const int tid = threadIdx.x;
  {
    const size_t nvec = (size_t)MTOK * DM / 8;
    const size_t T = (size_t)nblk * 256;
    for (size_t i = (size_t)bid * 256 + tid; i < nvec; i += 4 * T) {
      float4 a[4], b[4];
#pragma unroll
      for (int u = 0; u < 4; ++u) {
        const size_t ii = i + u * T;
        if (ii < nvec) { a[u] = ((const float4*)p.x)[2 * ii]; b[u] = ((const float4*)p.x)[2 * ii + 1]; }
      }
#pragma unroll
      for (int u = 0; u < 4; ++u) {
        const size_t ii = i + u * T;
        if (ii < nvec) {
          uint4 o; o.x = pack2(a[u].x, a[u].y); o.y = pack2(a[u].z, a[u].w); o.z = pack2(b[u].x, b[u].y); o.w = pack2(b[u].z, b[u].w);
          ((uint4*)p.xb)[ii] = o;
        }
      }
    }
  }
  {
    float* t = (float*)smem;
    const int ntile_in = 16 * 60, ntile_all = ntile_in + 16 * 16;
    for (int tile = bid; tile < ntile_all; tile += nblk) {
      const float* src; u16* dst; int N, kt, nt;
      if (tile < ntile_in) { src = p.w_in; dst = p.winT; N = INW; kt = tile / 60; nt = tile % 60; }
      else { int tt = tile - ntile_in; src = p.w_out; dst = p.woutT; N = DM; kt = tt / 16; nt = tt % 16; }
      __syncthreads();
#pragma unroll
      for (int j = 0; j < 4; ++j) {
        const int kk = (tid >> 4) + 16 * j, nn = (tid & 15) * 4;
        const float4 v = *(const float4*)(src + (size_t)(kt * 64 + kk) * N + nt * 64 + nn);
        t[kk * 65 + nn] = v.x; t[kk * 65 + nn + 1] = v.y; t[kk * 65 + nn + 2] = v.z; t[kk * 65 + nn + 3] = v.w;
      }
      __syncthreads();
      const int n = tid >> 2, kc = (tid & 3) * 16;
      uint32_t o[8];
#pragma unroll
      for (int j = 0; j < 8; ++j) o[j] = pack2(t[(kc + 2 * j) * 65 + n], t[(kc + 2 * j + 1) * 65 + n]);
      uint4* d = (uint4*)(dst + (size_t)(nt * 64 + n) * 1024 + kt * 64 + kc);
      d[0] = make_uint4(o[0], o[1], o[2], o[3]);
      d[1] = make_uint4(o[4], o[5], o[6], o[7]);
    }
  }
  for (int i = bid * 256 + tid; i < 2048; i += nblk * 256) {
    if (i < 1024) {
      const int pos = i >> 4, j = i & 15;
      const float inv = powf(10000.f, -(float)(2 * j) / 32.f);
      const float ang = (float)pos * inv;
      p.rope[i] = make_float2(cosf(ang), sinf(ang));
    } else {
      const int ii = i - 1024, dir = ii >> 9, wcol = ii & 511;
      const float l0 = p.lb_logits[(dir * 2 + 0) * 512 + wcol], l1 = p.lb_logits[(dir * 2 + 1) * 512 + wcol];
      const float mx = fmaxf(l0, l1);
      const float e0 = expf(l0 - mx), e1 = expf(l1 - mx);
      p.lbv[ii] = e0 / (e0 + e1);
    }
  }
}

constexpr int GP = 72;
constexpr int GEMM_LDS = 2 * 2 * 128 * GP * 2;

DI void gemm_mainloop(const u16* __restrict__ A, const u16* __restrict__ B, int n0, int m0, char* smem, f32x16 (&acc)[2][2]) {
  const int tid = threadIdx.x, lane = tid & 63, w = __builtin_amdgcn_readfirstlane(tid >> 6);
  const int wn = w & 1, wm = w >> 1;
  const int lc = tid & 7, lr = tid >> 3;
  u16* sm = (u16*)smem;
  const u16* gA = A + (size_t)(n0 + lr) * 1024 + lc * 8;
  const u16* gB = B + (size_t)(m0 + lr) * 1024 + lc * 8;
#pragma unroll
  for (int a = 0; a < 2; ++a)
#pragma unroll
    for (int b = 0; b < 2; ++b)
#pragma unroll
      for (int i = 0; i < 16; ++i) acc[a][b][i] = 0.f;
  u32x4 ra0[4], rb0[4], ra1[4], rb1[4];
#pragma unroll
  for (int j = 0; j < 4; ++j) { ra0[j] = *(const u32x4*)(gA + (size_t)j * 32 * 1024); rb0[j] = *(const u32x4*)(gB + (size_t)j * 32 * 1024); }
#pragma unroll
  for (int j = 0; j < 4; ++j) { ra1[j] = *(const u32x4*)(gA + (size_t)j * 32 * 1024 + 64); rb1[j] = *(const u32x4*)(gB + (size_t)j * 32 * 1024 + 64); }
  __syncthreads();
#pragma unroll
  for (int j = 0; j < 4; ++j) {
    *(u32x4*)(sm + (0 * 128 + lr + 32 * j) * GP + lc * 8) = ra0[j];
    *(u32x4*)(sm + (1 * 128 + lr + 32 * j) * GP + lc * 8) = rb0[j];
  }
  __syncthreads();
  const int fr = lane & 31, fh = lane >> 5;
  const u16* fa = sm + (wn * 64 + fr) * GP + fh * 8;
  const u16* fb = sm + (128 + wm * 64 + fr) * GP + fh * 8;
#define GEMM_COMPUTE(ST)                                                                          \
  _Pragma("unroll") for (int ks = 0; ks < 4; ++ks) {                                              \
    bf16x8 af[2], bfr[2];                                                                         \
    _Pragma("unroll") for (int a = 0; a < 2; ++a) af[a] = *(const bf16x8*)(fa + ((ST) * 256 + a * 32) * GP + ks * 16);   \
    _Pragma("unroll") for (int b = 0; b < 2; ++b) bfr[b] = *(const bf16x8*)(fb + ((ST) * 256 + b * 32) * GP + ks * 16);  \
    _Pragma("unroll") for (int a = 0; a < 2; ++a)                                                 \
      _Pragma("unroll") for (int b = 0; b < 2; ++b) acc[a][b] = MFMA32(af[a], bfr[b], acc[a][b]); \
  }
  for (int kt = 0; kt < 16; kt += 2) {
    if (kt + 2 < 16) {
#pragma unroll
      for (int j = 0; j < 4; ++j) {
        ra0[j] = *(const u32x4*)(gA + (size_t)j * 32 * 1024 + (kt + 2) * 64);
        rb0[j] = *(const u32x4*)(gB + (size_t)j * 32 * 1024 + (kt + 2) * 64);
      }
    }
    __builtin_amdgcn_sched_barrier(0);
    GEMM_COMPUTE(0)
#pragma unroll
    for (int j = 0; j < 4; ++j) {
      *(u32x4*)(sm + ((2 + 0) * 128 + lr + 32 * j) * GP + lc * 8) = ra1[j];
      *(u32x4*)(sm + ((2 + 1) * 128 + lr + 32 * j) * GP + lc * 8) = rb1[j];
    }
    __syncthreads();
    if (kt + 3 < 16) {
#pragma unroll
      for (int j = 0; j < 4; ++j) {
        ra1[j] = *(const u32x4*)(gA + (size_t)j * 32 * 1024 + (kt + 3) * 64);
        rb1[j] = *(const u32x4*)(gB + (size_t)j * 32 * 1024 + (kt + 3) * 64);
      }
    }
    __builtin_amdgcn_sched_barrier(0);
    GEMM_COMPUTE(1)
    if (kt + 2 < 16) {
#pragma unroll
      for (int j = 0; j < 4; ++j) {
        *(u32x4*)(sm + (0 * 128 + lr + 32 * j) * GP + lc * 8) = ra0[j];
        *(u32x4*)(sm + (1 * 128 + lr + 32 * j) * GP + lc * 8) = rb0[j];
      }
    }
    __syncthreads();
  }
#undef GEMM_COMPUTE
}

struct XMap { int xcc, rank, nloc; };
__device__ void phase1(const Params& p, char* smem, int bid, int nblk, const XMap xm) {
  const int lane = threadIdx.x & 63, w = threadIdx.x >> 6;
  const int wn = w & 1, wm = w >> 1;
  const int r0 = lane & 31, h0 = lane >> 5;
  const int ntiles = xm.xcc >= 0 ? 960 : (MTOK / 128) * 30;
  for (int tile = xm.xcc >= 0 ? xm.rank : bid; tile < ntiles; tile += xm.xcc >= 0 ? xm.nloc : nblk) {
    int mt, nt;
    if (xm.xcc >= 0) {
      int ml;
      if (tile < 768) { const int g = tile >> 8, rem = tile & 255, c = rem >> 6, q = rem & 63; ml = c * 8 + (q >> 3); nt = g * 8 + (q & 7); }
      else { const int t2 = tile - 768, c = t2 / 48, q = t2 % 48; ml = c * 8 + q / 6; nt = 24 + q % 6; }
      mt = xm.xcc * 32 + ml;
    } else { mt = tile / 30; nt = tile % 30; }
    f32x16 acc[2][2];
    gemm_mainloop(p.winT, p.xb, nt * 128, mt * 128, smem, acc);
    int r = r0, h = h0;
    asm volatile("" : "+v"(r), "+v"(h));
    const int mbase = mt * 128 + wm * 64;
    if (nt <= 4) {
      const bool isq = nt < 4;
      const int head = isq ? nt * 2 + wn : wn;
      const float* nw = isq ? p.q_norm_w : p.k_norm_w;
      const float sc = isq ? Q_PRESCALE : 1.0f;
#pragma unroll
      for (int b = 0; b < 2; ++b) {
        const int m = mbase + b * 32 + r;
        const int bi = m >> 12, s = m & 4095;
        const int rp = s >> 6, cp = s & 63;
        float ss = 0.f;
#pragma unroll
        for (int a = 0; a < 2; ++a)
#pragma unroll
          for (int i = 0; i < 16; ++i) ss += acc[a][b][i] * acc[a][b][i];
        ss += __shfl_xor(ss, 32);
        const float rstd = rsqrtf(ss * (1.f / 64.f) + 1e-6f);
        u16* dst0 = isq ? p.q + ((size_t)(bi * 8 + head) * SEQ + s) * 64 : p.k + ((size_t)(bi * 2 + head) * SEQ + s) * 64;
#pragma unroll
        for (int a = 0; a < 2; ++a) {
          const int pos = a == 0 ? rp : cp;
          float y[16], o[16];
#pragma unroll
          for (int i = 0; i < 16; ++i) y[i] = acc[a][b][i] * rstd * nw[a * 32 + crow(i, h)];
#pragma unroll
          for (int i = 0; i < 8; ++i) {
            const float2 cs = p.rope[pos * 16 + crow(i, h)];
            o[i] = (y[i] * cs.x - y[i + 8] * cs.y) * sc;
            o[i + 8] = (y[i + 8] * cs.x + y[i] * cs.y) * sc;
          }
#pragma unroll
          for (int g = 0; g < 4; ++g) {
            uint2 v; v.x = pack2(o[4 * g], o[4 * g + 1]); v.y = pack2(o[4 * g + 2], o[4 * g + 3]);
            *(uint2*)(dst0 + a * 32 + 8 * g + 4 * h) = v;
          }
        }
      }
    } else if (nt == 5) {
#pragma unroll
      for (int b = 0; b < 2; ++b) {
        const int m = mbase + b * 32 + r;
        const int bi = m >> 12, s = m & 4095;
        u16* dst0 = p.vT + ((size_t)(bi * 2 + wn) * 64) * SEQ + s;
#pragma unroll
        for (int a = 0; a < 2; ++a)
#pragma unroll
          for (int i = 0; i < 16; ++i) dst0[(size_t)(a * 32 + crow(i, h)) * SEQ] = f2bf(acc[a][b][i]);
      }
    } else {
      const int gi = (nt - 6) >> 2;
      const int cb = ((nt - 6) & 3) * 128 + wn * 64;
#pragma unroll
      for (int b = 0; b < 2; ++b) {
        const size_t m = mbase + b * 32 + r;
#pragma unroll
        for (int a = 0; a < 2; ++a)
#pragma unroll
          for (int g = 0; g < 4; ++g) {
            const int c = cb + a * 32 + 8 * g + 4 * h;
            float v[4];
#pragma unroll
            for (int e = 0; e < 4; ++e) v[e] = acc[a][b][4 * g + e];
            if (gi == 3 || gi == 4) {
              const float4 lb = *(const float4*)(p.lbv + (gi - 3) * 512 + c);
              float4 o;
              o.x = __logf(lb.x + (1.f - lb.x) * __builtin_amdgcn_rcpf(1.f + __expf(-v[0])));
              o.y = __logf(lb.y + (1.f - lb.y) * __builtin_amdgcn_rcpf(1.f + __expf(-v[1])));
              o.z = __logf(lb.z + (1.f - lb.z) * __builtin_amdgcn_rcpf(1.f + __expf(-v[2])));
              o.w = __logf(lb.w + (1.f - lb.w) * __builtin_amdgcn_rcpf(1.f + __expf(-v[3])));
              uint2 oh; oh.x = pack2h(o.x, o.y); oh.y = pack2h(o.z, o.w);
              *(uint2*)((gi == 3 ? p.lff : p.lfb) + m * 512 + c) = oh;
            } else {
              u16* dst = gi == 0 ? p.ga : gi == 1 ? p.hq : gi == 2 ? p.hi : p.gh;
              if (gi == 0 || gi == 5) {
#pragma unroll
                for (int e = 0; e < 4; ++e) v[e] = silu_f(v[e]);
              } else if (gi == 1) {
#pragma unroll
                for (int e = 0; e < 4; ++e) v[e] = silu_f(v[e]) * HQ_SCALE;
              }
              uint2 o; o.x = pack2(v[0], v[1]); o.y = pack2(v[2], v[3]);
              *(uint2*)(dst + m * 512 + c) = o;
            }
          }
      }
    }
  }
}


constexpr int AP = 72;
constexpr int ATT_LDS = 2 * 2 * 64 * AP * 2;
DI float fast_exp2(float x) { return __builtin_amdgcn_exp2f(x); }

__device__ void attn_item(const Params& p, char* smem, int item) {
  const int tid = threadIdx.x, lane = tid & 63, w = tid >> 6, r = lane & 31, h = lane >> 5;
  const int qb = item & 31, head = (item >> 5) & 7, bi = item >> 8;
  const int kvh = head >> 2;
  const int q0 = qb * 128 + w * 32;
  u16* sm = (u16*)smem;
  bf16x8 qf[4];
  {
    const u16* qp = p.q + ((size_t)(bi * 8 + head) * SEQ + q0 + r) * 64 + h * 8;
#pragma unroll
    for (int ks = 0; ks < 4; ++ks) qf[ks] = *(const bf16x8*)(qp + ks * 16);
  }
  const int lc = tid & 7, lr = tid >> 3;
  const u16* kg = p.k + (size_t)(bi * 2 + kvh) * SEQ * 64 + (size_t)lr * 64 + lc * 8;
  const u16* vg = p.vT + (size_t)(bi * 2 + kvh) * 64 * SEQ + (size_t)lr * SEQ + lc * 8;
  const int kw = lr * AP + lc * 8;
  const int vw = lr * AP + (lc >> 1) * 16 + (lc & 1) * 4;
  u32x4 rk[2], rv[2];
#pragma unroll
  for (int j = 0; j < 2; ++j) { rk[j] = *(const u32x4*)(kg + (size_t)j * 32 * 64); rv[j] = *(const u32x4*)(vg + (size_t)j * 32 * SEQ); }
  __syncthreads();
#pragma unroll
  for (int j = 0; j < 2; ++j) {
    *(u32x4*)(sm + kw + j * 32 * AP) = rk[j];
    u16* vd = sm + 64 * AP + vw + j * 32 * AP;
    *(u32x2*)(vd) = rv[j].xy; *(u32x2*)(vd + 8) = rv[j].zw;
  }
  __syncthreads();
  f32x16 o[2];
#pragma unroll
  for (int dt = 0; dt < 2; ++dt)
#pragma unroll
    for (int i = 0; i < 16; ++i) o[dt][i] = 0.f;
  float mrun = -INFINITY, lsum = 0.f;
  for (int t = 0; t < 64; ++t) {
    const int st = t & 1;
    if (t + 1 < 64) {
#pragma unroll
      for (int j = 0; j < 2; ++j) {
        rk[j] = *(const u32x4*)(kg + (size_t)((t + 1) * 64 + j * 32) * 64);
        rv[j] = *(const u32x4*)(vg + (size_t)j * 32 * SEQ + (t + 1) * 64);
      }
    }
    const u16* sK = sm + (st * 2 + 0) * 64 * AP;
    const u16* sV = sm + (st * 2 + 1) * 64 * AP;
    f32x16 sc[2];
#pragma unroll
    for (int kt2 = 0; kt2 < 2; ++kt2) {
#pragma unroll
      for (int i = 0; i < 16; ++i) sc[kt2][i] = 0.f;
#pragma unroll
      for (int ks = 0; ks < 4; ++ks) {
        const bf16x8 kf = *(const bf16x8*)(sK + (kt2 * 32 + r) * AP + ks * 16 + h * 8);
        sc[kt2] = MFMA32(kf, qf[ks], sc[kt2]);
      }
    }
    float mx = sc[0][0];
#pragma unroll
    for (int i = 1; i < 16; ++i) mx = fmaxf(mx, sc[0][i]);
#pragma unroll
    for (int i = 0; i < 16; ++i) mx = fmaxf(mx, sc[1][i]);
    mx = fmaxf(mx, __shfl_xor(mx, 32));
    if (__any(mx > mrun)) {
      const float mn = fmaxf(mrun, mx);
      const float al = fast_exp2(mrun - mn);
      lsum *= al;
#pragma unroll
      for (int dt = 0; dt < 2; ++dt)
#pragma unroll
        for (int i = 0; i < 16; ++i) o[dt][i] *= al;
      mrun = mn;
    }
#pragma unroll
    for (int kt2 = 0; kt2 < 2; ++kt2)
#pragma unroll
      for (int i = 0; i < 16; ++i) { const float e = fast_exp2(sc[kt2][i] - mrun); sc[kt2][i] = e; lsum += e; }
#pragma unroll
    for (int s2 = 0; s2 < 4; ++s2) {
      u32x4 pk;
      pk.x = pack2(sc[s2 >> 1][8 * (s2 & 1) + 0], sc[s2 >> 1][8 * (s2 & 1) + 1]);
      pk.y = pack2(sc[s2 >> 1][8 * (s2 & 1) + 2], sc[s2 >> 1][8 * (s2 & 1) + 3]);
      pk.z = pack2(sc[s2 >> 1][8 * (s2 & 1) + 4], sc[s2 >> 1][8 * (s2 & 1) + 5]);
      pk.w = pack2(sc[s2 >> 1][8 * (s2 & 1) + 6], sc[s2 >> 1][8 * (s2 & 1) + 7]);
      const bf16x8 pf = __builtin_bit_cast(bf16x8, pk);
#pragma unroll
      for (int dt = 0; dt < 2; ++dt) {
        const bf16x8 vf = *(const bf16x8*)(sV + (dt * 32 + r) * AP + s2 * 16 + h * 8);
        o[dt] = MFMA32(vf, pf, o[dt]);
      }
    }
    if (t + 1 < 64) {
      const int ns = st ^ 1;
#pragma unroll
      for (int j = 0; j < 2; ++j) {
        *(u32x4*)(sm + (ns * 2 + 0) * 64 * AP + kw + j * 32 * AP) = rk[j];
        u16* vd = sm + (ns * 2 + 1) * 64 * AP + vw + j * 32 * AP;
        *(u32x2*)(vd) = rv[j].xy; *(u32x2*)(vd + 8) = rv[j].zw;
      }
    }
    __syncthreads();
  }
  lsum += __shfl_xor(lsum, 32);
  const float il = 1.f / lsum;
  u16* op = p.attn + ((size_t)bi * SEQ + q0 + r) * 512 + head * 64 + 4 * h;
#pragma unroll
  for (int dt = 0; dt < 2; ++dt)
#pragma unroll
    for (int g = 0; g < 4; ++g) {
      u32x2 v; v.x = pack2(o[dt][4 * g] * il, o[dt][4 * g + 1] * il); v.y = pack2(o[dt][4 * g + 2] * il, o[dt][4 * g + 3] * il);
      *(u32x2*)(op + dt * 32 + 8 * g) = v;
    }
}


constexpr int HQP = 136;
constexpr int HSP = 72;
constexpr int H_QM = 0;
constexpr int H_KM = H_QM + 64 * HQP * 2;
constexpr int H_KUT = H_KM + 64 * HQP * 2;
constexpr int H_IT = H_KUT + 128 * HSP * 2;
constexpr int H_F32 = H_IT + 128 * HSP * 2;
constexpr int HG_LDS = H_F32 + 7 * 128 * 4;

__device__ void hgrn_item(const Params& p, char* smem, int item) {
  const int tid = threadIdx.x, lane = tid & 63, w = __builtin_amdgcn_readfirstlane(tid >> 6), r = lane & 31, h = lane >> 5;
  const int dir = item & 1, hh = (item >> 1) & 3, bi = item >> 3;
  u16* QM = (u16*)(smem + H_QM);
  u16* KM = (u16*)(smem + H_KM);
  u16* AM = (u16*)(smem + H_KM);
  u16* KUT = (u16*)(smem + H_KUT);
  u16* IT = (u16*)(smem + H_IT);
  float* tot = (float*)(smem + H_F32);
  float* first2 = tot + 512;
  float* emid = tot + 640;
  float* dec = tot + 768;
  const u16* lf = dir ? p.lfb : p.lff;
  u16* og = dir ? p.ob : p.of;
  const int kp = lane;
  const int k16 = (2 * kp) & 15, grp = k16 >> 2;
  const int pk0 = ((2 * kp) & ~15) | ((grp == 1 ? 2 : grp == 2 ? 1 : grp) << 2) | ((2 * kp) & 3);
  const int tp = tid & 31, vc = (tid >> 5) * 16;
  f32x16 S[4];
#pragma unroll
  for (int a = 0; a < 4; ++a)
#pragma unroll
    for (int i = 0; i < 16; ++i) S[a][i] = 0.f;
  const size_t colb = (size_t)hh * 128;
  uint32_t lgv[16], qv[16];
#define HG_LOAD(C)                                                                                   \
  {                                                                                                  \
    const int s0_ = dir ? SEQ - 64 * ((C) + 1) : 64 * (C);                                           \
    const size_t tb_ = (size_t)bi * SEQ + s0_;                                                       \
    _Pragma("unroll") for (int e = 0; e < 16; ++e) {                                                 \
      const int tau = 16 * w + e;                                                                    \
      const size_t tok = tb_ + (dir ? 63 - tau : tau);                                               \
      lgv[e] = *(const uint32_t*)((const char*)(lf + tok * 512 + colb) + (unsigned)(kp * 4));        \
      qv[e] = *(const uint32_t*)((const char*)(p.hq + tok * 512 + colb) + (unsigned)(kp * 4));       \
    }                                                                                                \
  }
  HG_LOAD(0)
  __syncthreads();
  for (int c = 0; c < 64; ++c) {
    const int s0 = dir ? SEQ - 64 * (c + 1) : 64 * c;
    const size_t tb = (size_t)bi * SEQ + s0;
    const size_t tok0 = tb + (dir ? 63 - 2 * tp : 2 * tp), tok1 = tb + (dir ? 62 - 2 * tp : 2 * tp + 1);
    const u32x4 ia0 = *(const u32x4*)(p.hi + tok0 * 512 + colb + vc), ia1 = *(const u32x4*)(p.hi + tok0 * 512 + colb + vc + 8);
    const u32x4 ib0 = *(const u32x4*)(p.hi + tok1 * 512 + colb + vc), ib1 = *(const u32x4*)(p.hi + tok1 * 512 + colb + vc + 8);
    {
      float2 run = make_float2(0.f, 0.f);
#pragma unroll
      for (int e = 0; e < 16; ++e) { run.x += h2f_lo(lgv[e]); run.y += h2f_hi(lgv[e]); }
      *(float2*)(tot + w * 128 + 2 * kp) = run;
      if (w == 2) *(float2*)(first2 + 2 * kp) = make_float2(h2f_lo(lgv[0]), h2f_hi(lgv[0]));
    }
    __syncthreads();
    {
      const float2 t0 = *(const float2*)(tot + 2 * kp), t1 = *(const float2*)(tot + 128 + 2 * kp);
      const float2 t2 = *(const float2*)(tot + 256 + 2 * kp), t3 = *(const float2*)(tot + 384 + 2 * kp);
      const float2 f2 = *(const float2*)(first2 + 2 * kp);
      float2 pre = make_float2(0.f, 0.f);
      if (w > 0) { pre.x += t0.x; pre.y += t0.y; }
      if (w > 1) { pre.x += t1.x; pre.y += t1.y; }
      if (w > 2) { pre.x += t2.x; pre.y += t2.y; }
      const float2 bmid = make_float2(t0.x + t1.x + f2.x, t0.y + t1.y + f2.y);
      const float2 blast = make_float2(t0.x + t1.x + t2.x + t3.x, t0.y + t1.y + t2.y + t3.y);
      const float ccx = __expf(blast.x - bmid.x), ccy = __expf(blast.y - bmid.y);
      uint32_t kux[8], kuy[8];
      float pkx = 0.f, pky = 0.f;
      float2 run = make_float2(pre.x - bmid.x, pre.y - bmid.y);
#pragma unroll
      for (int e = 0; e < 16; ++e) {
        const float lgx = h2f_lo(lgv[e]), lgy = h2f_hi(lgv[e]);
        run.x += lgx; run.y += lgy;
        const float rx = run.x, ry = run.y;
        const float e1x = __expf(rx), e1y = __expf(ry), e2x = __expf(-rx), e2y = __expf(-ry);
        const float gx = 1.f - __expf(lgx), gy = 1.f - __expf(lgy);
        const float qx = __uint_as_float(qv[e] << 16), qy = __uint_as_float(qv[e] & 0xffff0000u);
        const float kmx = gx * e2x, kmy = gy * e2y;
        const int t = 16 * w + e;
        *(uint32_t*)(QM + t * HQP + pk0) = pack2(qx * e1x, qy * e1y);
        *(uint32_t*)(KM + t * HQP + pk0) = pack2(kmx, kmy);
        if (e & 1) { kux[e >> 1] = pack2(pkx, kmx * ccx); kuy[e >> 1] = pack2(pky, kmy * ccy); }
        else { pkx = kmx * ccx; pky = kmy * ccy; }
      }
      u32x4* d0 = (u32x4*)(KUT + (2 * kp) * HSP + 16 * w);
      u32x4* d1 = (u32x4*)(KUT + (2 * kp + 1) * HSP + 16 * w);
      u32x4 v;
      v.x = kux[0]; v.y = kux[1]; v.z = kux[2]; v.w = kux[3]; d0[0] = v;
      v.x = kux[4]; v.y = kux[5]; v.z = kux[6]; v.w = kux[7]; d0[1] = v;
      v.x = kuy[0]; v.y = kuy[1]; v.z = kuy[2]; v.w = kuy[3]; d1[0] = v;
      v.x = kuy[4]; v.y = kuy[5]; v.z = kuy[6]; v.w = kuy[7]; d1[1] = v;
      if (w == 0) {
        *(float2*)(emid + 2 * kp) = make_float2(__expf(bmid.x), __expf(bmid.y));
        *(float2*)(dec + 2 * kp) = make_float2(__expf(blast.x), __expf(blast.y));
      }
    }
    {
      uint32_t* d = (uint32_t*)(IT + vc * HSP + 2 * tp);
#pragma unroll
      for (int j = 0; j < 4; ++j) {
        d[(2 * j) * (HSP / 2)] = (ia0[j] & 0xffffu) | (ib0[j] << 16);
        d[(2 * j + 1) * (HSP / 2)] = (ia0[j] >> 16) | (ib0[j] & 0xffff0000u);
        d[(8 + 2 * j) * (HSP / 2)] = (ia1[j] & 0xffffu) | (ib1[j] << 16);
        d[(8 + 2 * j + 1) * (HSP / 2)] = (ia1[j] >> 16) | (ib1[j] & 0xffff0000u);
      }
    }
    __syncthreads();
    if (c + 1 < 64) HG_LOAD(c + 1)
    {
      const int ti = w >> 1, si = w & 1;
      f32x16 d;
#pragma unroll
      for (int i = 0; i < 16; ++i) d[i] = 0.f;
      if (w != 1) {
#pragma unroll
        for (int ks = 0; ks < 8; ++ks) {
          const bf16x8 af = *(const bf16x8*)(KM + (si * 32 + r) * HQP + ks * 16 + h * 8);
          const bf16x8 bf = *(const bf16x8*)(QM + (ti * 32 + r) * HQP + ks * 16 + h * 8);
          d = MFMA32(af, bf, d);
        }
      }
      __syncthreads();
      const int t = ti * 32 + r;
#pragma unroll
      for (int g = 0; g < 4; ++g) {
        const int sb = si * 32 + 8 * g + 4 * h;
        u32x2 v;
        v.x = pack2(sb + 0 <= t ? d[4 * g + 0] : 0.f, sb + 1 <= t ? d[4 * g + 1] : 0.f);
        v.y = pack2(sb + 2 <= t ? d[4 * g + 2] : 0.f, sb + 3 <= t ? d[4 * g + 3] : 0.f);
        *(u32x2*)(AM + t * HSP + sb) = v;
      }
    }
    __syncthreads();
    bf16x8 ifr[4];
#pragma unroll
    for (int s4 = 0; s4 < 4; ++s4) ifr[s4] = *(const bf16x8*)(IT + (w * 32 + r) * HSP + 16 * s4 + 8 * h);
    {
      bf16x8 sp[8];
#pragma unroll
      for (int ks = 0; ks < 8; ++ks) {
        const int kt4 = ks >> 1, hf = ks & 1;
        const float4 ea = *(const float4*)(emid + kt4 * 32 + 16 * hf + 4 * h);
        const float4 eb = *(const float4*)(emid + kt4 * 32 + 16 * hf + 8 + 4 * h);
        u32x4 pk;
        pk.x = pack2(S[kt4][8 * hf + 0] * ea.x, S[kt4][8 * hf + 1] * ea.y);
        pk.y = pack2(S[kt4][8 * hf + 2] * ea.z, S[kt4][8 * hf + 3] * ea.w);
        pk.z = pack2(S[kt4][8 * hf + 4] * eb.x, S[kt4][8 * hf + 5] * eb.y);
        pk.w = pack2(S[kt4][8 * hf + 6] * eb.z, S[kt4][8 * hf + 7] * eb.w);
        sp[ks] = __builtin_bit_cast(bf16x8, pk);
      }
#pragma unroll
      for (int ti = 0; ti < 2; ++ti) {
        f32x16 oa;
#pragma unroll
        for (int i = 0; i < 16; ++i) oa[i] = 0.f;
#pragma unroll
        for (int s4 = 0; s4 < (ti == 0 ? 2 : 4); ++s4) {
          const bf16x8 am = *(const bf16x8*)(AM + (ti * 32 + r) * HSP + 16 * s4 + 8 * h);
          oa = MFMA32(am, ifr[s4], oa);
        }
#pragma unroll
        for (int ks = 0; ks < 8; ++ks) {
          const bf16x8 qf = *(const bf16x8*)(QM + (ti * 32 + r) * HQP + ks * 16 + 8 * h);
          oa = MFMA32(qf, sp[ks], oa);
        }
#pragma unroll
        for (int i = 0; i < 16; ++i) {
          const int tau = ti * 32 + crow(i, h);
          const size_t tok = tb + (dir ? 63 - tau : tau);
          og[tok * 512 + colb + w * 32 + r] = f2bf(oa[i]);
        }
      }
    }
#pragma unroll
    for (int kt4 = 0; kt4 < 4; ++kt4) {
#pragma unroll
      for (int g = 0; g < 4; ++g) {
        const float4 dd = *(const float4*)(dec + kt4 * 32 + 8 * g + 4 * h);
        S[kt4][4 * g + 0] *= dd.x; S[kt4][4 * g + 1] *= dd.y; S[kt4][4 * g + 2] *= dd.z; S[kt4][4 * g + 3] *= dd.w;
      }
#pragma unroll
      for (int s4 = 0; s4 < 4; ++s4) {
        const bf16x8 kf = *(const bf16x8*)(KUT + (kt4 * 32 + r) * HSP + 16 * s4 + 8 * h);
        S[kt4] = MFMA32(kf, ifr[s4], S[kt4]);
      }
    }
    __syncthreads();
  }
#undef HG_LOAD
}

__global__ __launch_bounds__(256) void naive_attn(Params p) {
  const int gid = blockIdx.x * 256 + threadIdx.x;
  const int s = gid & 4095, bh = gid >> 12, head = bh & 7, bi = bh >> 3, kvh = head >> 2;
  float qv[64], acc[64];
  const u16* qp = p.q + ((size_t)(bi * 8 + head) * SEQ + s) * 64;
#pragma unroll
  for (int d = 0; d < 64; ++d) { qv[d] = bf2f(qp[d]); acc[d] = 0.f; }
  float mx = -INFINITY, l = 0.f;
  const u16* kp = p.k + (size_t)(bi * 2 + kvh) * SEQ * 64;
  const u16* vp = p.vT + (size_t)(bi * 2 + kvh) * 64 * SEQ;
  for (int key = 0; key < SEQ; ++key) {
    float sc = 0.f;
#pragma unroll
    for (int d = 0; d < 64; ++d) sc += qv[d] * bf2f(kp[(size_t)key * 64 + d]);
    const float mn = fmaxf(mx, sc);
    const float al = exp2f(mx - mn), pp = exp2f(sc - mn);
    l = l * al + pp;
#pragma unroll
    for (int d = 0; d < 64; ++d) acc[d] = acc[d] * al + pp * bf2f(vp[(size_t)d * SEQ + key]);
    mx = mn;
  }
  const float il = 1.f / l;
  u16* op = p.attn + ((size_t)bi * SEQ + s) * 512 + head * 64;
#pragma unroll
  for (int d = 0; d < 64; ++d) op[d] = f2bf(acc[d] * il);
}

__global__ __launch_bounds__(1024) void naive_hgrn(Params p) {
  __shared__ float red[8][128];
  const int dir = blockIdx.x & 1, hh = (blockIdx.x >> 1) & 3, bi = blockIdx.x >> 3;
  const int v = threadIdx.x & 127, kq = threadIdx.x >> 7;
  float S[16];
#pragma unroll
  for (int i = 0; i < 16; ++i) S[i] = 0.f;
  const u16* lf = dir ? p.lfb : p.lff;
  u16* o = dir ? p.ob : p.of;
  for (int step = 0; step < SEQ; ++step) {
    const int s = dir ? SEQ - 1 - step : step;
    const size_t base = ((size_t)bi * SEQ + s) * 512 + hh * 128;
    const float iv = bf2f(p.hi[base + v]);
    float part = 0.f;
#pragma unroll
    for (int kk = 0; kk < 16; ++kk) {
      const int k = kq * 16 + kk;
      const float lg = (float)__builtin_bit_cast(_Float16, lf[base + k]);
      const float f = expf(lg), g = -expm1f(lg);
      const float qk = bf2f(p.hq[base + k]);
      S[kk] = f * S[kk] + g * iv;
      part += S[kk] * qk;
    }
    red[kq][v] = part;
    __syncthreads();
    if (kq == 0) {
      float t = 0.f;
#pragma unroll
      for (int j = 0; j < 8; ++j) t += red[j][v];
      o[base + v] = f2bf(t);
    }
    __syncthreads();
  }
}

DI void unpack8(const uint4 u, float (&v)[8]) {
  v[0] = __uint_as_float(u.x << 16); v[1] = __uint_as_float(u.x & 0xffff0000u);
  v[2] = __uint_as_float(u.y << 16); v[3] = __uint_as_float(u.y & 0xffff0000u);
  v[4] = __uint_as_float(u.z << 16); v[5] = __uint_as_float(u.z & 0xffff0000u);
  v[6] = __uint_as_float(u.w << 16); v[7] = __uint_as_float(u.w & 0xffff0000u);
}
__device__ void phase_mix(const Params& p, int bid, int nblk) {
  const int lane = threadIdx.x & 63, w = threadIdx.x >> 6;
  u16* mix = p.mix;
  float wa[8], wh[8];
#pragma unroll
  for (int e = 0; e < 8; ++e) { wa[e] = p.attn_norm_w[lane * 8 + e]; wh[e] = p.hg_norm_w[(lane & 15) * 8 + e]; }
  const int stride = nblk * 4;
  for (int m0 = bid * 4 + w; m0 < MTOK; m0 += 4 * stride) {
    uint4 ua[4], ug[4], u1[4], u2[4], uh[4];
#pragma unroll
    for (int u = 0; u < 4; ++u) {
      const int m = m0 + u * stride;
      if (m < MTOK) {
        const size_t rb = (size_t)m * 512 + lane * 8;
        ua[u] = *(const uint4*)(p.attn + rb); ug[u] = *(const uint4*)(p.ga + rb);
        u1[u] = *(const uint4*)(p.of + rb); u2[u] = *(const uint4*)(p.ob + rb); uh[u] = *(const uint4*)(p.gh + rb);
      }
    }
#pragma unroll
    for (int u = 0; u < 4; ++u) {
      const int m = m0 + u * stride;
      if (m < MTOK) {
        float a[8], g[8], f1[8], f2[8];
        unpack8(ua[u], a); unpack8(ug[u], g);
        float ss = 0.f;
#pragma unroll
        for (int e = 0; e < 8; ++e) ss += a[e] * a[e];
#pragma unroll
        for (int o = 32; o >= 1; o >>= 1) ss += __shfl_xor(ss, o);
        float rstd = rsqrtf(ss * (1.f / 512.f) + 1e-6f);
        float r[8];
#pragma unroll
        for (int e = 0; e < 8; ++e) r[e] = a[e] * rstd * wa[e] * g[e];
        uint4 o1; o1.x = pack2(r[0], r[1]); o1.y = pack2(r[2], r[3]); o1.z = pack2(r[4], r[5]); o1.w = pack2(r[6], r[7]);
        *(uint4*)(mix + (size_t)m * 1024 + lane * 8) = o1;
        unpack8(u1[u], f1); unpack8(u2[u], f2); unpack8(uh[u], g);
        ss = 0.f;
#pragma unroll
        for (int e = 0; e < 8; ++e) { a[e] = f1[e] + f2[e]; ss += a[e] * a[e]; }
#pragma unroll
        for (int o = 8; o >= 1; o >>= 1) ss += __shfl_xor(ss, o);
        rstd = rsqrtf(ss * (1.f / 128.f) + 1e-6f);
#pragma unroll
        for (int e = 0; e < 8; ++e) r[e] = a[e] * rstd * wh[e] * g[e];
        o1.x = pack2(r[0], r[1]); o1.y = pack2(r[2], r[3]); o1.z = pack2(r[4], r[5]); o1.w = pack2(r[6], r[7]);
        *(uint4*)(mix + (size_t)m * 1024 + 512 + lane * 8) = o1;
      }
    }
  }
}

__device__ void phase3(const Params& p, char* smem, int bid, int nblk, const XMap xm) {
  const int lane = threadIdx.x & 63, w = threadIdx.x >> 6;
  const int wn = w & 1, wm = w >> 1;
  const int r0 = lane & 31, h0 = lane >> 5;
  const int ntiles = xm.xcc >= 0 ? 256 : (MTOK / 128) * 8;
  for (int tile = xm.xcc >= 0 ? xm.rank : bid; tile < ntiles; tile += xm.xcc >= 0 ? xm.nloc : nblk) {
    int mt, nt;
    if (xm.xcc >= 0) { const int c = tile >> 6, q = tile & 63; mt = xm.xcc * 32 + c * 8 + (q >> 3); nt = q & 7; }
    else { mt = tile >> 3; nt = tile & 7; }
    f32x16 acc[2][2];
    gemm_mainloop(p.woutT, p.mix, nt * 128, mt * 128, smem, acc);
    int r = r0, h = h0;
    asm volatile("" : "+v"(r), "+v"(h));
#pragma unroll
    for (int b = 0; b < 2; ++b) {
      const size_t m = mt * 128 + wm * 64 + b * 32 + r;
#pragma unroll
      for (int a = 0; a < 2; ++a)
#pragma unroll
        for (int g = 0; g < 4; ++g) {
          const int n = nt * 128 + wn * 64 + a * 32 + 8 * g + 4 * h;
          const float4 xv = *(const float4*)(p.x + m * 1024 + n);
          float4 o;
          o.x = DN_ALPHA * xv.x + acc[a][b][4 * g + 0];
          o.y = DN_ALPHA * xv.y + acc[a][b][4 * g + 1];
          o.z = DN_ALPHA * xv.z + acc[a][b][4 * g + 2];
          o.w = DN_ALPHA * xv.w + acc[a][b][4 * g + 3];
          *(float4*)(p.z + m * 1024 + n) = o;
        }
    }
  }
}

__device__ void phase4(const Params& p, int bid, int nblk) {
  const int lane = threadIdx.x & 63, w = threadIdx.x >> 6;
  const int stride = nblk * 4;
  for (int m0 = bid * 4 + w; m0 < MTOK; m0 += 4 * stride) {
    float4 v[4][4];
#pragma unroll
    for (int u = 0; u < 4; ++u) {
      const int m = m0 + u * stride;
      if (m < MTOK) {
        const float4* row = (const float4*)(p.z + (size_t)m * 1024);
#pragma unroll
        for (int j = 0; j < 4; ++j) v[u][j] = row[lane + 64 * j];
      }
    }
#pragma unroll
    for (int u = 0; u < 4; ++u) {
      const int m = m0 + u * stride;
      if (m < MTOK) {
        float4* row = (float4*)(p.out + (size_t)m * 1024);
        float s = 0.f;
#pragma unroll
        for (int j = 0; j < 4; ++j) s += v[u][j].x + v[u][j].y + v[u][j].z + v[u][j].w;
#pragma unroll
        for (int o = 32; o >= 1; o >>= 1) s += __shfl_xor(s, o);
        const float mu = s * (1.f / 1024.f);
        float q = 0.f;
#pragma unroll
        for (int j = 0; j < 4; ++j) {
          v[u][j].x -= mu; v[u][j].y -= mu; v[u][j].z -= mu; v[u][j].w -= mu;
          q += v[u][j].x * v[u][j].x + v[u][j].y * v[u][j].y + v[u][j].z * v[u][j].z + v[u][j].w * v[u][j].w;
        }
#pragma unroll
        for (int o = 32; o >= 1; o >>= 1) q += __shfl_xor(q, o);
        const float rstd = rsqrtf(q * (1.f / 1024.f) + 1e-5f);
#pragma unroll
        for (int j = 0; j < 4; ++j) {
          const float4 wv = ((const float4*)p.ln_w)[lane + 64 * j], bv = ((const float4*)p.ln_b)[lane + 64 * j];
          float4 o;
          o.x = v[u][j].x * rstd * wv.x + bv.x; o.y = v[u][j].y * rstd * wv.y + bv.y;
          o.z = v[u][j].z * rstd * wv.z + bv.z; o.w = v[u][j].w * rstd * wv.w + bv.w;
          row[lane + 64 * j] = o;
        }
      }
    }
  }
}


#define XB_TMO      128
#define XB_XCNT(j)  (256  + 64 * (j))
#define XB_XSUB(j)  (1280 + 64 * (j))
#define XB_XGEN(j)  (2304 + 64 * (j))
#define XB_TOP      3328
#define XB_TOPGEN   3392
#define XCD_BAR_WORDS 3456
#define XB_SPIN_CAP (1u << 18)
#define LAS __attribute__((address_space(3)))
DI unsigned xb_ld(unsigned* p) { return __hip_atomic_load(p, __ATOMIC_RELAXED, __HIP_MEMORY_SCOPE_AGENT); }
DI unsigned xb_add(unsigned* p, unsigned v) { return __hip_atomic_fetch_add(p, v, __ATOMIC_RELAXED, __HIP_MEMORY_SCOPE_AGENT); }
DI unsigned xb_xcc_id() { return (unsigned)__builtin_amdgcn_s_getreg((3 << 11) | 20) & 0xFu; }
#define XB_SPIN(cond, bar) do { unsigned _sp = 0; while (cond) { __builtin_amdgcn_s_sleep(1); \
    if ((++_sp & 255u) == 0u) { if (xb_ld(&(bar)[XB_TMO])) break; if (_sp > XB_SPIN_CAP) { atomicAdd(&(bar)[XB_TMO], 1u); break; } } } } while (0)
struct XcdBarrier { unsigned* bar; unsigned x; volatile LAS unsigned* st; };
DI XcdBarrier xcd_barrier_post(unsigned* bar, volatile LAS unsigned* st, unsigned& rank) {
  XcdBarrier b; b.bar = bar; b.x = xb_xcc_id(); b.st = st;
  rank = 0u;
  if (threadIdx.x == 0) rank = xb_add(&bar[XB_XCNT(b.x)], 1u);
  return b;
}
DI void xcd_barrier_complete(unsigned* bar, unsigned x, unsigned& nloc, unsigned& nx) {
  const unsigned G = gridDim.x * gridDim.y * gridDim.z;
  unsigned sum, cnt, mine, sp = 0u;
  for (;;) {
    sum = 0u; cnt = 0u; mine = 0u;
#pragma unroll
    for (unsigned j = 0; j < 16; ++j) { const unsigned c = xb_ld(&bar[XB_XCNT(j)]); sum += c; cnt += (c > 0u) ? 1u : 0u; mine = (j == x) ? c : mine; }
    if (sum == G) break;
    __builtin_amdgcn_s_sleep(1);
    if ((++sp & 255u) == 0u) { if (xb_ld(&bar[XB_TMO])) break; if (sp > XB_SPIN_CAP) { atomicAdd(&bar[XB_TMO], 1u); break; } }
  }
  nloc = mine > 0u ? mine : 1u; nx = cnt > 0u ? cnt : 1u;
}
DI void xcd_barrier(const XcdBarrier& b) {
  asm volatile("s_waitcnt vmcnt(0)" ::: "memory");
  __syncthreads();
  if (threadIdx.x == 0) {
    unsigned* bar = b.bar;
    __builtin_amdgcn_s_waitcnt(0);
    unsigned nloc = b.st[0], nx = b.st[1];
    if (nloc == 0u) { xcd_barrier_complete(bar, b.x, nloc, nx); b.st[0] = nloc; b.st[1] = nx; }
    const unsigned old = xb_add(&bar[XB_XSUB(b.x)], 1u);
    const unsigned gen = old / nloc;
    if (old + 1u == (gen + 1u) * nloc) {
      __builtin_amdgcn_fence(__ATOMIC_RELEASE, "agent");
      asm volatile("s_waitcnt vmcnt(0)" ::: "memory");
      const unsigned og = xb_add(&bar[XB_TOP], 1u);
      const unsigned tg = og / nx;
      if (og + 1u == (tg + 1u) * nx) xb_add(&bar[XB_TOPGEN], 1u);
      else XB_SPIN(xb_ld(&bar[XB_TOPGEN]) == tg, bar);
      __builtin_amdgcn_fence(__ATOMIC_ACQUIRE, "agent");
      xb_add(&bar[XB_XGEN(b.x)], 1u);
      asm volatile("s_waitcnt vmcnt(0)" ::: "memory");
    } else {
      XB_SPIN(xb_ld(&bar[XB_XGEN(b.x)]) == gen, bar);
      __builtin_amdgcn_fence(__ATOMIC_ACQUIRE, "agent");
      asm volatile("s_waitcnt vmcnt(0)" ::: "memory");
    }
  }
  __syncthreads();
}

constexpr int MEGA_LDS = HG_LDS > GEMM_LDS ? HG_LDS : GEMM_LDS;
__global__ void __launch_bounds__(256, 2) mega_kernel(Params p) {
  __shared__ __attribute__((aligned(16))) char smem[MEGA_LDS];
  __shared__ uint4 xb_words;
  __shared__ int s_item;
  __shared__ int s_xm[4];
  cg::grid_group grid = cg::this_grid();
  const int bid = blockIdx.x, nblk = gridDim.x;
  if (threadIdx.x == 0) xb_words = make_uint4(0u, 0u, 0u, 0u);
  __syncthreads();
  unsigned my_rank;
  XcdBarrier xb = xcd_barrier_post(p.bar, (volatile LAS unsigned*)&xb_words, my_rank);
  if (p.out == nullptr) grid.sync();
  phase0(p, smem, bid, nblk);
  xcd_barrier(xb);
  if (threadIdx.x == 0) {
    unsigned sum = 0;
#pragma unroll
    for (int j = 0; j < 8; ++j) sum += xb_ld(&p.bar[XB_XCNT(j)]);
    const bool ok = sum == (unsigned)nblk && xb.x < 8u && xb_words.y == 8u;
    s_xm[0] = ok ? (int)xb.x : -1; s_xm[1] = (int)my_rank; s_xm[2] = (int)xb_words.x;
  }
  __syncthreads();
  XMap xm; xm.xcc = s_xm[0]; xm.rank = s_xm[1]; xm.nloc = s_xm[2];
  phase1(p, smem, bid, nblk, xm);
  xcd_barrier(xb);
  if (bid < 64) hgrn_item(p, smem, bid);
  for (;;) {
    __syncthreads();
    if (threadIdx.x == 0) s_item = atomicAdd(p.ctr, 1);
    __syncthreads();
    const int it = s_item;
    if (it >= 2048) break;
    attn_item(p, smem, it);
  }
  xcd_barrier(xb);
  phase_mix(p, bid, nblk);
  xcd_barrier(xb);
  phase3(p, smem, bid, nblk, xm);
  xcd_barrier(xb);
  phase4(p, bid, nblk);
}

__global__ __launch_bounds__(256) void k_phase0(Params p) { __shared__ __attribute__((aligned(16))) char smem[64 * 65 * 4]; phase0(p, smem, blockIdx.x, gridDim.x); }
__global__ __launch_bounds__(256) void k_phase1(Params p) { __shared__ __attribute__((aligned(16))) char smem[GEMM_LDS]; XMap xm; xm.xcc = -1; xm.rank = 0; xm.nloc = 1; phase1(p, smem, blockIdx.x, gridDim.x, xm); }
__global__ __launch_bounds__(256) void k_attn(Params p) { __shared__ __attribute__((aligned(16))) char smem[ATT_LDS]; for (int it = blockIdx.x; it < 2048; it += gridDim.x) attn_item(p, smem, it); }
__global__ __launch_bounds__(256) void k_hgrn(Params p) { __shared__ __attribute__((aligned(16))) char smem[HG_LDS]; for (int it = blockIdx.x; it < 64; it += gridDim.x) hgrn_item(p, smem, it); }
__global__ __launch_bounds__(256) void k_mix(Params p) { phase_mix(p, blockIdx.x, gridDim.x); }
__global__ __launch_bounds__(256) void k_phase3(Params p) { __shared__ __attribute__((aligned(16))) char smem[GEMM_LDS]; XMap xm; xm.xcc = -1; xm.rank = 0; xm.nloc = 1; phase3(p, smem, blockIdx.x, gridDim.x, xm); }
__global__ __launch_bounds__(256) void k_phase4(Params p) { phase4(p, blockIdx.x, gridDim.x); }

extern "C" void kernel_launch(void* const* d_in, const int* in_sizes, int n_in, void* d_out, int out_size, void* d_ws, size_t ws_size,
                              hipStream_t stream) {
  Params p{};
  p.x = (const float*)d_in[0]; p.w_in = (const float*)d_in[1]; p.q_norm_w = (const float*)d_in[2]; p.k_norm_w = (const float*)d_in[3];
  p.attn_norm_w = (const float*)d_in[4]; p.lb_logits = (const float*)d_in[5]; p.hg_norm_w = (const float*)d_in[6];
  p.w_out = (const float*)d_in[7]; p.ln_w = (const float*)d_in[8]; p.ln_b = (const float*)d_in[9];
  p.out = (float*)d_out;
  char* ws = (char*)d_ws;
  size_t off = 0;
  auto take = [&](size_t bytes) { char* r = ws + off; off += (bytes + 255) & ~(size_t)255; return r; };
  p.xb = (u16*)take((size_t)MTOK * 1024 * 2);
  p.winT = (u16*)take((size_t)INW * 1024 * 2);
  p.woutT = (u16*)take((size_t)1024 * 1024 * 2);
  p.rope = (float2*)take(1024 * 8);
  p.lbv = (float*)take(1024 * 4);
  p.q = (u16*)take((size_t)MTOK * 512 * 2);
  p.k = (u16*)take((size_t)MTOK * 128 * 2);
  p.vT = (u16*)take((size_t)MTOK * 128 * 2);
  p.ga = (u16*)take((size_t)MTOK * 512 * 2);
  p.hq = (u16*)take((size_t)MTOK * 512 * 2);
  p.hi = (u16*)take((size_t)MTOK * 512 * 2);
  p.lff = (u16*)take((size_t)MTOK * 512 * 4);
  p.lfb = (u16*)take((size_t)MTOK * 512 * 4);
  p.gh = (u16*)take((size_t)MTOK * 512 * 2);
  p.attn = (u16*)take((size_t)MTOK * 512 * 2);
  p.of = (u16*)take((size_t)MTOK * 512 * 2);
  p.ob = (u16*)take((size_t)MTOK * 512 * 2);
  p.ctr = (int*)take(256);
  p.bar = (unsigned*)take(XCD_BAR_WORDS * 4);
  p.mix = p.hq;
  p.z = (float*)p.lff;
  if (off > ws_size) { fprintf(stderr, "workspace too small: need %zu have %zu\n", off, ws_size); return; }
#if ONE_LAUNCH
  static int grid_blocks = 0;
  if (!grid_blocks) {
    int dev = 0, cus = 0, per_cu = 0;
    hipGetDevice(&dev);
    hipDeviceGetAttribute(&cus, hipDeviceAttributeMultiprocessorCount, dev);
    hipOccupancyMaxActiveBlocksPerMultiprocessor(&per_cu, mega_kernel, 256, 0);
    if (per_cu > 2) per_cu = 2;
    grid_blocks = cus * per_cu;
    if (grid_blocks < 64) fprintf(stderr, "grid too small: %d\n", grid_blocks);
  }
  hipMemsetAsync(p.ctr, 0, 256 + ((XCD_BAR_WORDS * 4 + 255) & ~255), stream);
  void* args[] = {&p};
  hipError_t e = hipLaunchCooperativeKernel((void*)mega_kernel, dim3(grid_blocks), dim3(256), args, 0, stream);
  if (e != hipSuccess) fprintf(stderr, "cooperative launch failed: %s (grid %d)\n", hipGetErrorString(e), grid_blocks);
#else
  k_phase0<<<1024, 256, 0, stream>>>(p);
  k_phase1<<<512, 256, 0, stream>>>(p);
  k_attn<<<2048, 256, 0, stream>>>(p);
  k_hgrn<<<64, 256, 0, stream>>>(p);
  k_mix<<<2048, 256, 0, stream>>>(p);
  k_phase3<<<512, 256, 0, stream>>>(p);
  k_phase4<<<2048, 256, 0, stream>>>(p);
#endif
}
```

```cpp
#include <hip/hip_runtime.h>
#include <hip/hip_cooperative_groups.h>
#include <stdint.h>
#include <stdio.h>

namespace cg = cooperative_groups;

#ifndef ONE_LAUNCH
#define ONE_LAUNCH 1
#endif
#ifndef PROBE_P0
#define PROBE_P0 0
#endif
#ifndef PROBE_MIX
#define PROBE_MIX 0
#endif
#ifndef PROBE_P1
#define PROBE_P1 0
#endif
#ifndef PROBE_HG
#define PROBE_HG 0
#endif
#ifndef PROBE_AT
#define PROBE_AT 0
#endif
#ifndef PROBE_P3
#define PROBE_P3 0
#endif

typedef __attribute__((ext_vector_type(8))) short bf16x8;
typedef __attribute__((ext_vector_type(4))) short s16x4;
typedef __attribute__((ext_vector_type(16))) float f32x16;
typedef unsigned short u16;
typedef __attribute__((ext_vector_type(4))) unsigned u32x4;
typedef __attribute__((ext_vector_type(2))) unsigned u32x2;

#define DI __device__ __forceinline__
#define MFMA32(a, b, c) __builtin_amdgcn_mfma_f32_32x32x16_bf16((a), (b), (c), 0, 0, 0)

constexpr int MTOK = 32768;
constexpr int SEQ = 4096;
constexpr int DM = 1024;
constexpr int INW = 3840;
constexpr float Q_PRESCALE = 0.125f * 1.4426950408889634f;
constexpr float HQ_SCALE = 0.08838834764831845f;
constexpr float DN_ALPHA = 1.189207115002721f;

struct Params {
  const float* x; const float* w_in; const float* q_norm_w; const float* k_norm_w;
  const float* attn_norm_w; const float* lb_logits; const float* hg_norm_w; const float* w_out;
  const float* ln_w; const float* ln_b;
  float* out;
  u16* xb;
  u16* winT;
  u16* woutT;
  float2* rope;
  float* lbv;
  u16* q;
  u16* k;
  u16* vT;
  u16* ga;
  u16* hq;
  u16* hi;
  u16* lff;
  u16* lfb;
  u16* gh;
  u16* attn;
  u16* of;
  u16* ob;
  int* ctr;
  unsigned* bar;
  u16* mix;
  float* z;
};

DI u16 f2bf(float x) { uint32_t u = __float_as_uint(x); u += 0x7fffu + ((u >> 16) & 1u); return (u16)(u >> 16); }
DI float bf2f(u16 v) { return __uint_as_float(((uint32_t)v) << 16); }
typedef __attribute__((ext_vector_type(2))) float f32x2_t;
typedef __attribute__((ext_vector_type(2))) __bf16 bf16x2_t;
DI uint32_t pack2(float a, float b) { f32x2_t v = {a, b}; bf16x2_t r = __builtin_convertvector(v, bf16x2_t); return __builtin_bit_cast(uint32_t, r); }
typedef __attribute__((ext_vector_type(2))) _Float16 f16x2_t;
DI uint32_t pack2h(float a, float b) { f16x2_t r = {(_Float16)a, (_Float16)b}; return __builtin_bit_cast(uint32_t, r); }
DI float h2f_lo(uint32_t u) { return (float)__builtin_bit_cast(f16x2_t, u)[0]; }
DI float h2f_hi(uint32_t u) { return (float)__builtin_bit_cast(f16x2_t, u)[1]; }
DI int crow(int i, int h) { return (i & 3) + 8 * (i >> 2) + 4 * h; }
DI float silu_f(float v) { return v * __builtin_amdgcn_rcpf(1.f + __expf(-v)); }

__device__ void phase0(const Params& p, char* smem, int bid, int nblk) {
  const int tid = threadIdx.x;
  {
    const size_t nvec = (size_t)MTOK * DM / 8;
    const size_t T = (size_t)nblk * 256;
    for (size_t i = (size_t)bid * 256 + tid; i < nvec; i += 4 * T) {
      float4 a[4], b[4];
#pragma unroll
      for (int u = 0; u < 4; ++u) {
        const size_t ii = i + u * T;
        if (ii < nvec) { a[u] = ((const float4*)p.x)[2 * ii]; b[u] = ((const float4*)p.x)[2 * ii + 1]; }
      }
#pragma unroll
      for (int u = 0; u < 4; ++u) {
        const size_t ii = i + u * T;
        if (ii < nvec) {
          uint4 o; o.x = pack2(a[u].x, a[u].y); o.y = pack2(a[u].z, a[u].w); o.z = pack2(b[u].x, b[u].y); o.w = pack2(b[u].z, b[u].w);
          ((uint4*)p.xb)[ii] = o;
        }
      }
    }
  }
  {
    float* t = (float*)smem;
    const int ntile_in = 16 * 60, ntile_all = ntile_in + 16 * 16;
    for (int tile = bid; tile < ntile_all; tile += nblk) {
      const float* src; u16* dst; int N, kt, nt;
      if (tile < ntile_in) { src = p.w_in; dst = p.winT; N = INW; kt = tile / 60; nt = tile % 60; }
      else { int tt = tile - ntile_in; src = p.w_out; dst = p.woutT; N = DM; kt = tt / 16; nt = tt % 16; }
      __syncthreads();
#pragma unroll
      for (int j = 0; j < 4; ++j) {
        const int kk = (tid >> 4) + 16 * j, nn = (tid & 15) * 4;
        const float4 v = *(const float4*)(src + (size_t)(kt * 64 + kk) * N + nt * 64 + nn);
        t[kk * 65 + nn] = v.x; t[kk * 65 + nn + 1] = v.y; t[kk * 65 + nn + 2] = v.z; t[kk * 65 + nn + 3] = v.w;
      }
      __syncthreads();
      const int n = tid >> 2, kc = (tid & 3) * 16;
      uint32_t o[8];
#pragma unroll
      for (int j = 0; j < 8; ++j) o[j] = pack2(t[(kc + 2 * j) * 65 + n], t[(kc + 2 * j + 1) * 65 + n]);
      uint4* d = (uint4*)(dst + (size_t)(nt * 64 + n) * 1024 + kt * 64 + kc);
      d[0] = make_uint4(o[0], o[1], o[2], o[3]);
      d[1] = make_uint4(o[4], o[5], o[6], o[7]);
    }
  }
  for (int i = bid * 256 + tid; i < 2048; i += nblk * 256) {
    if (i < 1024) {
      const int pos = i >> 4, j = i & 15;
      const float inv = powf(10000.f, -(float)(2 * j) / 32.f);
      const float ang = (float)pos * inv;
      p.rope[i] = make_float2(cosf(ang), sinf(ang));
    } else {
      const int ii = i - 1024, dir = ii >> 9, wcol = ii & 511;
      const float l0 = p.lb_logits[(dir * 2 + 0) * 512 + wcol], l1 = p.lb_logits[(dir * 2 + 1) * 512 + wcol];
      const float mx = fmaxf(l0, l1);
      const float e0 = expf(l0 - mx), e1 = expf(l1 - mx);
      p.lbv[ii] = e0 / (e0 + e1);
    }
  }
}

constexpr int GP = 72;
constexpr int EP = 136;
constexpr int EPF = 132;
constexpr int GEMM_LDS = 2 * 2 * 128 * GP * 2;

DI void gemm_mainloop(const u16* __restrict__ A, const u16* __restrict__ B, int n0, int m0, char* smem, f32x16 (&acc)[2][2]) {
  const int tid = threadIdx.x, lane = tid & 63, w = __builtin_amdgcn_readfirstlane(tid >> 6);
  const int wn = w & 1, wm = w >> 1;
  const int lc = tid & 7, lr = tid >> 3;
  u16* sm = (u16*)smem;
  const u16* gA = A + (size_t)(n0 + lr) * 1024 + lc * 8;
  const u16* gB = B + (size_t)(m0 + lr) * 1024 + lc * 8;
#pragma unroll
  for (int a = 0; a < 2; ++a)
#pragma unroll
    for (int b = 0; b < 2; ++b)
#pragma unroll
      for (int i = 0; i < 16; ++i) acc[a][b][i] = 0.f;
  u32x4 ra0[4], rb0[4], ra1[4], rb1[4];
#pragma unroll
  for (int j = 0; j < 4; ++j) { ra0[j] = *(const u32x4*)(gA + (size_t)j * 32 * 1024); rb0[j] = *(const u32x4*)(gB + (size_t)j * 32 * 1024); }
#pragma unroll
  for (int j = 0; j < 4; ++j) { ra1[j] = *(const u32x4*)(gA + (size_t)j * 32 * 1024 + 64); rb1[j] = *(const u32x4*)(gB + (size_t)j * 32 * 1024 + 64); }
  __syncthreads();
#pragma unroll
  for (int j = 0; j < 4; ++j) {
    *(u32x4*)(sm + (0 * 128 + lr + 32 * j) * GP + lc * 8) = ra0[j];
    *(u32x4*)(sm + (1 * 128 + lr + 32 * j) * GP + lc * 8) = rb0[j];
  }
  __syncthreads();
  const int fr = lane & 31, fh = lane >> 5;
  const u16* fa = sm + (wn * 64 + fr) * GP + fh * 8;
  const u16* fb = sm + (128 + wm * 64 + fr) * GP + fh * 8;
#define GEMM_COMPUTE(ST)                                                                          \
  _Pragma("unroll") for (int ks = 0; ks < 4; ++ks) {                                              \
    bf16x8 af[2], bfr[2];                                                                         \
    _Pragma("unroll") for (int a = 0; a < 2; ++a) af[a] = *(const bf16x8*)(fa + ((ST) * 256 + a * 32) * GP + ks * 16);   \
    _Pragma("unroll") for (int b = 0; b < 2; ++b) bfr[b] = *(const bf16x8*)(fb + ((ST) * 256 + b * 32) * GP + ks * 16);  \
    _Pragma("unroll") for (int a = 0; a < 2; ++a)                                                 \
      _Pragma("unroll") for (int b = 0; b < 2; ++b) acc[a][b] = MFMA32(af[a], bfr[b], acc[a][b]); \
  }
  for (int kt = 0; kt < 16; kt += 2) {
    if (kt + 2 < 16) {
#pragma unroll
      for (int j = 0; j < 4; ++j) {
        ra0[j] = *(const u32x4*)(gA + (size_t)j * 32 * 1024 + (kt + 2) * 64);
        rb0[j] = *(const u32x4*)(gB + (size_t)j * 32 * 1024 + (kt + 2) * 64);
      }
    }
    __builtin_amdgcn_sched_barrier(0);
    GEMM_COMPUTE(0)
#pragma unroll
    for (int j = 0; j < 4; ++j) {
      *(u32x4*)(sm + ((2 + 0) * 128 + lr + 32 * j) * GP + lc * 8) = ra1[j];
      *(u32x4*)(sm + ((2 + 1) * 128 + lr + 32 * j) * GP + lc * 8) = rb1[j];
    }
    __syncthreads();
    if (kt + 3 < 16) {
#pragma unroll
      for (int j = 0; j < 4; ++j) {
        ra1[j] = *(const u32x4*)(gA + (size_t)j * 32 * 1024 + (kt + 3) * 64);
        rb1[j] = *(const u32x4*)(gB + (size_t)j * 32 * 1024 + (kt + 3) * 64);
      }
    }
    __builtin_amdgcn_sched_barrier(0);
    GEMM_COMPUTE(1)
    if (kt + 2 < 16) {
#pragma unroll
      for (int j = 0; j < 4; ++j) {
        *(u32x4*)(sm + (0 * 128 + lr + 32 * j) * GP + lc * 8) = ra0[j];
        *(u32x4*)(sm + (1 * 128 + lr + 32 * j) * GP + lc * 8) = rb0[j];
      }
    }
    __syncthreads();
  }
#undef GEMM_COMPUTE
}

struct XMap { int xcc, rank, nloc; };
__device__ void phase1(const Params& p, char* smem, int bid, int nblk, const XMap xm) {
  const int lane = threadIdx.x & 63, w = threadIdx.x >> 6;
  const int wn = w & 1, wm = w >> 1;
  const int r0 = lane & 31, h0 = lane >> 5;
  const int ntiles = xm.xcc >= 0 ? 960 : (MTOK / 128) * 30;
  for (int tile0 = xm.xcc >= 0 ? xm.rank : bid; tile0 < ntiles * (1 + PROBE_P1); tile0 += xm.xcc >= 0 ? xm.nloc : nblk) {
    const int tile = tile0 >= ntiles ? tile0 - ntiles : tile0;
    int mt, nt;
    if (xm.xcc >= 0) {
      int ml;
      if (tile < 768) { const int g = tile >> 8, rem = tile & 255, c = rem >> 6, q = rem & 63; ml = c * 8 + (q >> 3); nt = g * 8 + (q & 7); }
      else { const int t2 = tile - 768, c = t2 / 48, q = t2 % 48; ml = c * 8 + q / 6; nt = 24 + q % 6; }
      mt = xm.xcc * 32 + ml;
    } else { mt = tile / 30; nt = tile % 30; }
    f32x16 acc[2][2];
    gemm_mainloop(p.winT, p.xb, nt * 128, mt * 128, smem, acc);
    int r = r0, h = h0;
    asm volatile("" : "+v"(r), "+v"(h));
    u16* T = (u16*)smem;
    const int mbase = mt * 128 + wm * 64;
    if (nt <= 4) {
      const bool isq = nt < 4;
      const float* nw = isq ? p.q_norm_w : p.k_norm_w;
      const float sc = isq ? Q_PRESCALE : 1.0f;
#pragma unroll
      for (int b = 0; b < 2; ++b) {
        const int m = mbase + b * 32 + r;
        const int s = m & 4095;
        const int rp = s >> 6, cp = s & 63;
        float ss = 0.f;
#pragma unroll
        for (int a = 0; a < 2; ++a)
#pragma unroll
          for (int i = 0; i < 16; ++i) ss += acc[a][b][i] * acc[a][b][i];
        ss += __shfl_xor(ss, 32);
        const float rstd = rsqrtf(ss * (1.f / 64.f) + 1e-6f);
        u16* trow = T + (wm * 64 + b * 32 + r) * EP + wn * 64 + 4 * h;
#pragma unroll
        for (int a = 0; a < 2; ++a) {
          const int pos = a == 0 ? rp : cp;
          float y[16], o[16];
#pragma unroll
          for (int i = 0; i < 16; ++i) y[i] = acc[a][b][i] * rstd * nw[a * 32 + crow(i, h)];
#pragma unroll
          for (int i = 0; i < 8; ++i) {
            const float2 cs = p.rope[pos * 16 + crow(i, h)];
            o[i] = (y[i] * cs.x - y[i + 8] * cs.y) * sc;
            o[i + 8] = (y[i + 8] * cs.x + y[i] * cs.y) * sc;
          }
#pragma unroll
          for (int g = 0; g < 4; ++g) {
            u32x2 v; v.x = pack2(o[4 * g], o[4 * g + 1]); v.y = pack2(o[4 * g + 2], o[4 * g + 3]);
            *(u32x2*)(trow + a * 32 + 8 * g) = v;
          }
        }
      }
    } else if (nt == 5) {
#pragma unroll
      for (int b = 0; b < 2; ++b)
#pragma unroll
        for (int a = 0; a < 2; ++a)
#pragma unroll
          for (int i = 0; i < 16; ++i) T[(wn * 64 + a * 32 + crow(i, h)) * EP + wm * 64 + b * 32 + r] = f2bf(acc[a][b][i]);
    } else {
      const int gi = (nt - 6) >> 2;
      const int cb = ((nt - 6) & 3) * 128 + wn * 64;
#pragma unroll
      for (int b = 0; b < 2; ++b) {
        u16* trow = T + (wm * 64 + b * 32 + r) * EP + wn * 64 + 4 * h;
#pragma unroll
        for (int a = 0; a < 2; ++a)
#pragma unroll
          for (int g = 0; g < 4; ++g) {
            float v[4];
#pragma unroll
            for (int e = 0; e < 4; ++e) v[e] = acc[a][b][4 * g + e];
            u32x2 o;
            if (gi == 3 || gi == 4) {
              const float4 lb = *(const float4*)(p.lbv + (gi - 3) * 512 + cb + a * 32 + 8 * g + 4 * h);
              const float ox = __logf(lb.x + (1.f - lb.x) * __builtin_amdgcn_rcpf(1.f + __expf(-v[0])));
              const float oy = __logf(lb.y + (1.f - lb.y) * __builtin_amdgcn_rcpf(1.f + __expf(-v[1])));
              const float oz = __logf(lb.z + (1.f - lb.z) * __builtin_amdgcn_rcpf(1.f + __expf(-v[2])));
              const float ow = __logf(lb.w + (1.f - lb.w) * __builtin_amdgcn_rcpf(1.f + __expf(-v[3])));
              o.x = pack2h(ox, oy); o.y = pack2h(oz, ow);
            } else {
              if (gi == 0 || gi == 5) {
#pragma unroll
                for (int e = 0; e < 4; ++e) v[e] = silu_f(v[e]);
              } else if (gi == 1) {
#pragma unroll
                for (int e = 0; e < 4; ++e) v[e] = silu_f(v[e]) * HQ_SCALE;
              }
              o.x = pack2(v[0], v[1]); o.y = pack2(v[2], v[3]);
            }
            *(u32x2*)(trow + a * 32 + 8 * g) = o;
          }
      }
    }
    __syncthreads();
    {
      const int tid = threadIdx.x;
      const int ch = tid & 15, rw = tid >> 4;
      const int bi = (mt * 128) >> 12, s0 = (mt * 128) & 4095;
      u16* dbase; size_t rstride;
      if (nt < 4)       { dbase = p.q + ((size_t)(bi * 8 + nt * 2 + (ch >> 3)) * SEQ + s0) * 64 + (ch & 7) * 8; rstride = 64; }
      else if (nt == 4) { dbase = p.k + ((size_t)(bi * 2 + (ch >> 3)) * SEQ + s0) * 64 + (ch & 7) * 8; rstride = 64; }
      else if (nt == 5) { dbase = p.vT + (size_t)(bi * 2) * 64 * SEQ + s0 + ch * 8; rstride = SEQ; }
      else {
        const int gi = (nt - 6) >> 2;
        u16* gb = gi == 0 ? p.ga : gi == 1 ? p.hq : gi == 2 ? p.hi : gi == 3 ? p.lff : gi == 4 ? p.lfb : p.gh;
        dbase = gb + (size_t)(mt * 128) * 512 + ((nt - 6) & 3) * 128 + ch * 8; rstride = 512;
      }
#pragma unroll
      for (int j = 0; j < 8; ++j) {
        const int row = j * 16 + rw;
        const u32x4 v = *(const u32x4*)(T + row * EP + ch * 8);
        *(u32x4*)(dbase + (size_t)row * rstride) = v;
      }
    }
  }
}

constexpr int AP = 72;
constexpr int ATT_LDS = 2 * 2 * 64 * AP * 2;
DI float fast_exp2(float x) { return __builtin_amdgcn_exp2f(x); }

__device__ void attn_item(const Params& p, char* smem, int item) {
  const int tid = threadIdx.x, lane = tid & 63, w = __builtin_amdgcn_readfirstlane(tid >> 6), r = lane & 31, h = lane >> 5;
  const int qb = item & 31, head = (item >> 5) & 7, bi = item >> 8;
  const int kvh = head >> 2;
  const int q0 = qb * 128 + w * 32;
  u16* sm = (u16*)smem;
  bf16x8 qf[4];
  {
    const u16* qp = p.q + ((size_t)(bi * 8 + head) * SEQ + q0 + r) * 64 + h * 8;
#pragma unroll
    for (int ks = 0; ks < 4; ++ks) qf[ks] = *(const bf16x8*)(qp + ks * 16);
  }
  const int lc = tid & 7, lr = tid >> 3;
  const u16* kg = p.k + (size_t)(bi * 2 + kvh) * SEQ * 64 + (size_t)lr * 64 + lc * 8;
  const u16* vg = p.vT + (size_t)(bi * 2 + kvh) * 64 * SEQ + (size_t)lr * SEQ + lc * 8;
  const int kw = lr * AP + lc * 8;
  const int vw = lr * AP + (lc >> 1) * 16 + (lc & 1) * 4;
  u32x4 rk[2], rv[2];
#define ATT_LOADK(T) _Pragma("unroll") for (int j = 0; j < 2; ++j) rk[j] = *(const u32x4*)(kg + (size_t)((T) * 64 + j * 32) * 64);
#define ATT_LOADV(T) _Pragma("unroll") for (int j = 0; j < 2; ++j) rv[j] = *(const u32x4*)(vg + (size_t)j * 32 * SEQ + (T) * 64);
#define ATT_STOREK(S) _Pragma("unroll") for (int j = 0; j < 2; ++j) *(u32x4*)(sm + (S) * 64 * AP + kw + j * 32 * AP) = rk[j];
#define ATT_STOREV(S) _Pragma("unroll") for (int j = 0; j < 2; ++j) { u16* vd = sm + (2 + (S)) * 64 * AP + vw + j * 32 * AP; *(u32x2*)(vd) = rv[j].xy; *(u32x2*)(vd + 8) = rv[j].zw; }
#define ATT_QK(DST, S)                                                                      \
  _Pragma("unroll") for (int kt2 = 0; kt2 < 2; ++kt2) {                                     \
    _Pragma("unroll") for (int i = 0; i < 16; ++i) DST[kt2][i] = 0.f;                       \
    _Pragma("unroll") for (int ks = 0; ks < 4; ++ks) {                                      \
      const bf16x8 kf = *(const bf16x8*)(sm + (S) * 64 * AP + (kt2 * 32 + r) * AP + ks * 16 + h * 8); \
      DST[kt2] = MFMA32(kf, qf[ks], DST[kt2]);                                              \
    }                                                                                       \
  }
  ATT_LOADK(0) ATT_LOADV(0)
  __syncthreads();
  ATT_STOREK(0) ATT_STOREV(0)
  ATT_LOADK(1)
  ATT_STOREK(1)
  __syncthreads();
  f32x16 o[2];
#pragma unroll
  for (int dt = 0; dt < 2; ++dt)
#pragma unroll
    for (int i = 0; i < 16; ++i) o[dt][i] = 0.f;
  float mrun = -INFINITY, lsum = 0.f;
  f32x16 sa[2], sb[2];
  ATT_QK(sa, 0)
  __syncthreads();
#define ATT_STEP(CUR, NXT, T)                                                               \
  {                                                                                         \
    const int t_ = (T);                                                                     \
    if (t_ + 2 < 64) { ATT_LOADK(t_ + 2) }                                                  \
    if (t_ + 1 < 64) { ATT_LOADV(t_ + 1) }                                                  \
    if (t_ + 1 < 64) { ATT_QK(NXT, (t_ + 1) & 1) }                                          \
    float mx = CUR[0][0];                                                                   \
    _Pragma("unroll") for (int i = 1; i < 16; ++i) mx = fmaxf(mx, CUR[0][i]);               \
    _Pragma("unroll") for (int i = 0; i < 16; ++i) mx = fmaxf(mx, CUR[1][i]);               \
    mx = fmaxf(mx, __shfl_xor(mx, 32));                                                     \
    if (__any(mx > mrun)) {                                                                 \
      const float mn = fmaxf(mrun, mx);                                                     \
      const float al = fast_exp2(mrun - mn);                                                \
      lsum *= al;                                                                           \
      _Pragma("unroll") for (int dt = 0; dt < 2; ++dt)                                      \
        _Pragma("unroll") for (int i = 0; i < 16; ++i) o[dt][i] *= al;                      \
      mrun = mn;                                                                            \
    }                                                                                       \
    _Pragma("unroll") for (int kt2 = 0; kt2 < 2; ++kt2)                                     \
      _Pragma("unroll") for (int i = 0; i < 16; ++i) { const float e = fast_exp2(CUR[kt2][i] - mrun); CUR[kt2][i] = e; lsum += e; } \
    _Pragma("unroll") for (int s2 = 0; s2 < 4; ++s2) {                                      \
      u32x4 pk;                                                                             \
      pk.x = pack2(CUR[s2 >> 1][8 * (s2 & 1) + 0], CUR[s2 >> 1][8 * (s2 & 1) + 1]);         \
      pk.y = pack2(CUR[s2 >> 1][8 * (s2 & 1) + 2], CUR[s2 >> 1][8 * (s2 & 1) + 3]);         \
      pk.z = pack2(CUR[s2 >> 1][8 * (s2 & 1) + 4], CUR[s2 >> 1][8 * (s2 & 1) + 5]);         \
      pk.w = pack2(CUR[s2 >> 1][8 * (s2 & 1) + 6], CUR[s2 >> 1][8 * (s2 & 1) + 7]);         \
      const bf16x8 pf = __builtin_bit_cast(bf16x8, pk);                                     \
      _Pragma("unroll") for (int dt = 0; dt < 2; ++dt) {                                    \
        const bf16x8 vf = *(const bf16x8*)(sm + (2 + (t_ & 1)) * 64 * AP + (dt * 32 + r) * AP + s2 * 16 + h * 8); \
        o[dt] = MFMA32(vf, pf, o[dt]);                                                      \
      }                                                                                     \
    }                                                                                       \
    if (t_ + 2 < 64) { ATT_STOREK(t_ & 1) }                                                 \
    if (t_ + 1 < 64) { ATT_STOREV((t_ + 1) & 1) }                                           \
    __syncthreads();                                                                        \
  }
  for (int t = 0; t < 64; t += 2) {
    ATT_STEP(sa, sb, t)
    ATT_STEP(sb, sa, t + 1)
  }
#undef ATT_STEP
#undef ATT_QK
#undef ATT_LOADK
#undef ATT_LOADV
#undef ATT_STOREK
#undef ATT_STOREV
  lsum += __shfl_xor(lsum, 32);
  const float il = 1.f / lsum;
  u16* op = p.attn + ((size_t)bi * SEQ + q0 + r) * 512 + head * 64 + 4 * h;
#pragma unroll
  for (int dt = 0; dt < 2; ++dt)
#pragma unroll
    for (int g = 0; g < 4; ++g) {
      u32x2 v; v.x = pack2(o[dt][4 * g] * il, o[dt][4 * g + 1] * il); v.y = pack2(o[dt][4 * g + 2] * il, o[dt][4 * g + 3] * il);
      *(u32x2*)(op + dt * 32 + 8 * g) = v;
    }
}

constexpr int HQP = 136;
constexpr int HSP = 72;
constexpr int H_QM = 0;
constexpr int H_KM = H_QM + 64 * HQP * 2;
constexpr int H_KUT = H_KM + 64 * HQP * 2;
constexpr int H_IT = H_KUT + 128 * HSP * 2;
constexpr int H_F32 = H_IT + 128 * HSP * 2;
constexpr int HG_LDS = H_F32 + 7 * 128 * 4;

__device__ void hgrn_item(const Params& p, char* smem, int item) {
  const int tid = threadIdx.x, lane = tid & 63, w = __builtin_amdgcn_readfirstlane(tid >> 6), r = lane & 31, h = lane >> 5;
  const int dir = item & 1, hh = (item >> 1) & 3, bi = item >> 3;
  u16* QM = (u16*)(smem + H_QM);
  u16* KM = (u16*)(smem + H_KM);
  u16* AM = (u16*)(smem + H_KM);
  u16* KUT = (u16*)(smem + H_KUT);
  u16* IT = (u16*)(smem + H_IT);
  float* tot = (float*)(smem + H_F32);
  float* first2 = tot + 512;
  float* emid = tot + 640;
  float* dec = tot + 768;
  const u16* lf = dir ? p.lfb : p.lff;
  u16* og = dir ? p.ob : p.of;
  const int kp = lane;
  const int k16 = (2 * kp) & 15, grp = k16 >> 2;
  const int pk0 = ((2 * kp) & ~15) | ((grp == 1 ? 2 : grp == 2 ? 1 : grp) << 2) | ((2 * kp) & 3);
  const int tp = tid & 31, vc = (tid >> 5) * 16;
  f32x16 S[4];
#pragma unroll
  for (int a = 0; a < 4; ++a)
#pragma unroll
    for (int i = 0; i < 16; ++i) S[a][i] = 0.f;
  const size_t colb = (size_t)hh * 128;
  const unsigned olane = (unsigned)((dir ? 4 - 4 * h : 4 * h) * 1024 + (hh * 128 + w * 32 + r) * 2);
  uint32_t lgv[16], qv[16];
#define HG_LOAD(C)                                                                                   \
  {                                                                                                  \
    const int s0_ = dir ? SEQ - 64 * ((C) + 1) : 64 * (C);                                           \
    const size_t tb_ = (size_t)bi * SEQ + s0_;                                                       \
    _Pragma("unroll") for (int e = 0; e < 16; ++e) {                                                 \
      const int tau = 16 * w + e;                                                                    \
      const size_t tok = tb_ + (dir ? 63 - tau : tau);                                               \
      lgv[e] = *(const uint32_t*)((const char*)(lf + tok * 512 + colb) + (unsigned)(kp * 4));        \
      qv[e] = *(const uint32_t*)((const char*)(p.hq + tok * 512 + colb) + (unsigned)(kp * 4));       \
    }                                                                                                \
  }
  HG_LOAD(0)
  __syncthreads();
  for (int c0 = 0; c0 < 64 * (1 + PROBE_HG); ++c0) {
    const int c = c0 & 63;
#if PROBE_HG
    if (c0 == 64) {
#pragma unroll
      for (int a = 0; a < 4; ++a)
#pragma unroll
        for (int i = 0; i < 16; ++i) S[a][i] = 0.f;
    }
#endif
    const int s0 = dir ? SEQ - 64 * (c + 1) : 64 * c;
    const size_t tb = (size_t)bi * SEQ + s0;
    const size_t tok0 = tb + (dir ? 63 - 2 * tp : 2 * tp), tok1 = tb + (dir ? 62 - 2 * tp : 2 * tp + 1);
    const u32x4 ia0 = *(const u32x4*)(p.hi + tok0 * 512 + colb + vc), ia1 = *(const u32x4*)(p.hi + tok0 * 512 + colb + vc + 8);
    const u32x4 ib0 = *(const u32x4*)(p.hi + tok1 * 512 + colb + vc), ib1 = *(const u32x4*)(p.hi + tok1 * 512 + colb + vc + 8);
    {
      float2 run = make_float2(0.f, 0.f);
#pragma unroll
      for (int e = 0; e < 16; ++e) { run.x += h2f_lo(lgv[e]); run.y += h2f_hi(lgv[e]); }
      *(float2*)(tot + w * 128 + 2 * kp) = run;
      if (w == 2) *(float2*)(first2 + 2 * kp) = make_float2(h2f_lo(lgv[0]), h2f_hi(lgv[0]));
    }
    __syncthreads();
    {
      const float2 t0 = *(const float2*)(tot + 2 * kp), t1 = *(const float2*)(tot + 128 + 2 * kp);
      const float2 t2 = *(const float2*)(tot + 256 + 2 * kp), t3 = *(const float2*)(tot + 384 + 2 * kp);
      const float2 f2 = *(const float2*)(first2 + 2 * kp);
      float2 pre = make_float2(0.f, 0.f);
      if (w > 0) { pre.x += t0.x; pre.y += t0.y; }
      if (w > 1) { pre.x += t1.x; pre.y += t1.y; }
      if (w > 2) { pre.x += t2.x; pre.y += t2.y; }
      const float2 bmid = make_float2(t0.x + t1.x + f2.x, t0.y + t1.y + f2.y);
      const float2 blast = make_float2(t0.x + t1.x + t2.x + t3.x, t0.y + t1.y + t2.y + t3.y);
      const float ccx = __expf(blast.x - bmid.x), ccy = __expf(blast.y - bmid.y);
      uint32_t kux[8], kuy[8];
      float pkx = 0.f, pky = 0.f;
      float2 run = make_float2(pre.x - bmid.x, pre.y - bmid.y);
#pragma unroll
      for (int e = 0; e < 16; ++e) {
        const float lgx = h2f_lo(lgv[e]), lgy = h2f_hi(lgv[e]);
        run.x += lgx; run.y += lgy;
        const float rx = run.x, ry = run.y;
        const float e1x = __expf(rx), e1y = __expf(ry), e2x = __expf(-rx), e2y = __expf(-ry);
        const float gx = 1.f - __expf(lgx), gy = 1.f - __expf(lgy);
        const float qx = __uint_as_float(qv[e] << 16), qy = __uint_as_float(qv[e] & 0xffff0000u);
        const float kmx = gx * e2x, kmy = gy * e2y;
        const int t = 16 * w + e;
        *(uint32_t*)(QM + t * HQP + pk0) = pack2(qx * e1x, qy * e1y);
        *(uint32_t*)(KM + t * HQP + pk0) = pack2(kmx, kmy);
        if (e & 1) { kux[e >> 1] = pack2(pkx, kmx * ccx); kuy[e >> 1] = pack2(pky, kmy * ccy); }
        else { pkx = kmx * ccx; pky = kmy * ccy; }
      }
      u32x4* d0 = (u32x4*)(KUT + (2 * kp) * HSP + 16 * w);
      u32x4* d1 = (u32x4*)(KUT + (2 * kp + 1) * HSP + 16 * w);
      u32x4 v;
      v.x = kux[0]; v.y = kux[1]; v.z = kux[2]; v.w = kux[3]; d0[0] = v;
      v.x = kux[4]; v.y = kux[5]; v.z = kux[6]; v.w = kux[7]; d0[1] = v;
      v.x = kuy[0]; v.y = kuy[1]; v.z = kuy[2]; v.w = kuy[3]; d1[0] = v;
      v.x = kuy[4]; v.y = kuy[5]; v.z = kuy[6]; v.w = kuy[7]; d1[1] = v;
      if (w == 0) {
        *(float2*)(emid + 2 * kp) = make_float2(__expf(bmid.x), __expf(bmid.y));
        *(float2*)(dec + 2 * kp) = make_float2(__expf(blast.x), __expf(blast.y));
      }
    }
    {
      uint32_t* d = (uint32_t*)(IT + vc * HSP + 2 * tp);
#pragma unroll
      for (int j = 0; j < 4; ++j) {
        d[(2 * j) * (HSP / 2)] = (ia0[j] & 0xffffu) | (ib0[j] << 16);
        d[(2 * j + 1) * (HSP / 2)] = (ia0[j] >> 16) | (ib0[j] & 0xffff0000u);
        d[(8 + 2 * j) * (HSP / 2)] = (ia1[j] & 0xffffu) | (ib1[j] << 16);
        d[(8 + 2 * j + 1) * (HSP / 2)] = (ia1[j] >> 16) | (ib1[j] & 0xffff0000u);
      }
    }
    __syncthreads();
    if (c0 + 1 < 64 * (1 + PROBE_HG)) HG_LOAD((c + 1) & 63)
    {
      const int ti = w >> 1, si = w & 1;
      f32x16 d;
#pragma unroll
      for (int i = 0; i < 16; ++i) d[i] = 0.f;
      if (w != 1) {
#pragma unroll
        for (int ks = 0; ks < 8; ++ks) {
          const bf16x8 af = *(const bf16x8*)(KM + (si * 32 + r) * HQP + ks * 16 + h * 8);
          const bf16x8 bf = *(const bf16x8*)(QM + (ti * 32 + r) * HQP + ks * 16 + h * 8);
          d = MFMA32(af, bf, d);
        }
      }
      __syncthreads();
      const int t = ti * 32 + r;
#pragma unroll
      for (int g = 0; g < 4; ++g) {
        const int sb = si * 32 + 8 * g + 4 * h;
        u32x2 v;
        v.x = pack2(sb + 0 <= t ? d[4 * g + 0] : 0.f, sb + 1 <= t ? d[4 * g + 1] : 0.f);
        v.y = pack2(sb + 2 <= t ? d[4 * g + 2] : 0.f, sb + 3 <= t ? d[4 * g + 3] : 0.f);
        *(u32x2*)(AM + t * HSP + sb) = v;
      }
    }
    __syncthreads();
    {
      f32x16 oa0, oa1;
#pragma unroll
      for (int i = 0; i < 16; ++i) { oa0[i] = 0.f; oa1[i] = 0.f; }
#pragma unroll
      for (int s4 = 0; s4 < 4; ++s4) {
        const bf16x8 ifr = *(const bf16x8*)(IT + (w * 32 + r) * HSP + 16 * s4 + 8 * h);
        const bf16x8 am1 = *(const bf16x8*)(AM + (32 + r) * HSP + 16 * s4 + 8 * h);
        oa1 = MFMA32(am1, ifr, oa1);
        if (s4 < 2) {
          const bf16x8 am0 = *(const bf16x8*)(AM + r * HSP + 16 * s4 + 8 * h);
          oa0 = MFMA32(am0, ifr, oa0);
        }
      }
#pragma unroll
      for (int ks = 0; ks < 8; ++ks) {
        const int kt4 = ks >> 1, hf = ks & 1;
        const float4 ea = *(const float4*)(emid + kt4 * 32 + 16 * hf + 4 * h);
        const float4 eb = *(const float4*)(emid + kt4 * 32 + 16 * hf + 8 + 4 * h);
        u32x4 pk;
        pk.x = pack2(S[kt4][8 * hf + 0] * ea.x, S[kt4][8 * hf + 1] * ea.y);
        pk.y = pack2(S[kt4][8 * hf + 2] * ea.z, S[kt4][8 * hf + 3] * ea.w);
        pk.z = pack2(S[kt4][8 * hf + 4] * eb.x, S[kt4][8 * hf + 5] * eb.y);
        pk.w = pack2(S[kt4][8 * hf + 6] * eb.z, S[kt4][8 * hf + 7] * eb.w);
        const bf16x8 sp = __builtin_bit_cast(bf16x8, pk);
        const bf16x8 qf0 = *(const bf16x8*)(QM + r * HQP + ks * 16 + 8 * h);
        const bf16x8 qf1 = *(const bf16x8*)(QM + (32 + r) * HQP + ks * 16 + 8 * h);
        oa0 = MFMA32(qf0, sp, oa0);
        oa1 = MFMA32(qf1, sp, oa1);
      }
      char* ogb = (char*)og + olane;
#pragma unroll
      for (int i = 0; i < 16; ++i) {
        const int ci = (i & 3) + 8 * (i >> 2);
        const size_t r0 = dir ? tb + 59 - ci : tb + ci;
        const size_t r1 = dir ? tb + 27 - ci : tb + 32 + ci;
        *(u16*)(ogb + r0 * 1024) = f2bf(oa0[i]);
        *(u16*)(ogb + r1 * 1024) = f2bf(oa1[i]);
      }
    }
#pragma unroll
    for (int kt4 = 0; kt4 < 4; ++kt4) {
#pragma unroll
      for (int g = 0; g < 4; ++g) {
        const float4 dd = *(const float4*)(dec + kt4 * 32 + 8 * g + 4 * h);
        S[kt4][4 * g + 0] *= dd.x; S[kt4][4 * g + 1] *= dd.y; S[kt4][4 * g + 2] *= dd.z; S[kt4][4 * g + 3] *= dd.w;
      }
    }
#pragma unroll
    for (int s4 = 0; s4 < 4; ++s4) {
      const bf16x8 ifr = *(const bf16x8*)(IT + (w * 32 + r) * HSP + 16 * s4 + 8 * h);
#pragma unroll
      for (int kt4 = 0; kt4 < 4; ++kt4) {
        const bf16x8 kf = *(const bf16x8*)(KUT + (kt4 * 32 + r) * HSP + 16 * s4 + 8 * h);
        S[kt4] = MFMA32(kf, ifr, S[kt4]);
      }
    }
    __syncthreads();
  }
#undef HG_LOAD
}

__global__ __launch_bounds__(256) void naive_attn(Params p) {
  const int gid = blockIdx.x * 256 + threadIdx.x;
  const int s = gid & 4095, bh = gid >> 12, head = bh & 7, bi = bh >> 3, kvh = head >> 2;
  float qv[64], acc[64];
  const u16* qp = p.q + ((size_t)(bi * 8 + head) * SEQ + s) * 64;
#pragma unroll
  for (int d = 0; d < 64; ++d) { qv[d] = bf2f(qp[d]); acc[d] = 0.f; }
  float mx = -INFINITY, l = 0.f;
  const u16* kp = p.k + (size_t)(bi * 2 + kvh) * SEQ * 64;
  const u16* vp = p.vT + (size_t)(bi * 2 + kvh) * 64 * SEQ;
  for (int key = 0; key < SEQ; ++key) {
    float sc = 0.f;
#pragma unroll
    for (int d = 0; d < 64; ++d) sc += qv[d] * bf2f(kp[(size_t)key * 64 + d]);
    const float mn = fmaxf(mx, sc);
    const float al = exp2f(mx - mn), pp = exp2f(sc - mn);
    l = l * al + pp;
#pragma unroll
    for (int d = 0; d < 64; ++d) acc[d] = acc[d] * al + pp * bf2f(vp[(size_t)d * SEQ + key]);
    mx = mn;
  }
  const float il = 1.f / l;
  u16* op = p.attn + ((size_t)bi * SEQ + s) * 512 + head * 64;
#pragma unroll
  for (int d = 0; d < 64; ++d) op[d] = f2bf(acc[d] * il);
}

__global__ __launch_bounds__(1024) void naive_hgrn(Params p) {
  __shared__ float red[8][128];
  const int dir = blockIdx.x & 1, hh = (blockIdx.x >> 1) & 3, bi = blockIdx.x >> 3;
  const int v = threadIdx.x & 127, kq = threadIdx.x >> 7;
  float S[16];
#pragma unroll
  for (int i = 0; i < 16; ++i) S[i] = 0.f;
  const u16* lf = dir ? p.lfb : p.lff;
  u16* o = dir ? p.ob : p.of;
  for (int step = 0; step < SEQ; ++step) {
    const int s = dir ? SEQ - 1 - step : step;
    const size_t base = ((size_t)bi * SEQ + s) * 512 + hh * 128;
    const float iv = bf2f(p.hi[base + v]);
    float part = 0.f;
#pragma unroll
    for (int kk = 0; kk < 16; ++kk) {
      const int k = kq * 16 + kk;
      const float lg = (float)__builtin_bit_cast(_Float16, lf[base + k]);
      const float f = expf(lg), g = -expm1f(lg);
      const float qk = bf2f(p.hq[base + k]);
      S[kk] = f * S[kk] + g * iv;
      part += S[kk] * qk;
    }
    red[kq][v] = part;
    __syncthreads();
    if (kq == 0) {
      float t = 0.f;
#pragma unroll
      for (int j = 0; j < 8; ++j) t += red[j][v];
      o[base + v] = f2bf(t);
    }
    __syncthreads();
  }
}

DI void unpack8(const uint4 u, float (&v)[8]) {
  v[0] = __uint_as_float(u.x << 16); v[1] = __uint_as_float(u.x & 0xffff0000u);
  v[2] = __uint_as_float(u.y << 16); v[3] = __uint_as_float(u.y & 0xffff0000u);
  v[4] = __uint_as_float(u.z << 16); v[5] = __uint_as_float(u.z & 0xffff0000u);
  v[6] = __uint_as_float(u.w << 16); v[7] = __uint_as_float(u.w & 0xffff0000u);
}
__device__ void phase_mix(const Params& p, int bid, int nblk) {
  const int lane = threadIdx.x & 63, w = threadIdx.x >> 6;
  u16* mix = p.mix;
  float wa[8], wh[8];
#pragma unroll
  for (int e = 0; e < 8; ++e) { wa[e] = p.attn_norm_w[lane * 8 + e]; wh[e] = p.hg_norm_w[(lane & 15) * 8 + e]; }
  const int stride = nblk * 4;
  for (int m0 = bid * 4 + w; m0 < MTOK; m0 += 4 * stride) {
    uint4 ua[4], ug[4], u1[4], u2[4], uh[4];
#pragma unroll
    for (int u = 0; u < 4; ++u) {
      const int m = m0 + u * stride;
      if (m < MTOK) {
        const size_t rb = (size_t)m * 512 + lane * 8;
        ua[u] = *(const uint4*)(p.attn + rb); ug[u] = *(const uint4*)(p.ga + rb);
        u1[u] = *(const uint4*)(p.of + rb); u2[u] = *(const uint4*)(p.ob + rb); uh[u] = *(const uint4*)(p.gh + rb);
      }
    }
#pragma unroll
    for (int u = 0; u < 4; ++u) {
      const int m = m0 + u * stride;
      if (m < MTOK) {
        float a[8], g[8], f1[8], f2[8];
        unpack8(ua[u], a); unpack8(ug[u], g);
        float ss = 0.f;
#pragma unroll
        for (int e = 0; e < 8; ++e) ss += a[e] * a[e];
#pragma unroll
        for (int o = 32; o >= 1; o >>= 1) ss += __shfl_xor(ss, o);
        float rstd = rsqrtf(ss * (1.f / 512.f) + 1e-6f);
        float r[8];
#pragma unroll
        for (int e = 0; e < 8; ++e) r[e] = a[e] * rstd * wa[e] * g[e];
        uint4 o1; o1.x = pack2(r[0], r[1]); o1.y = pack2(r[2], r[3]); o1.z = pack2(r[4], r[5]); o1.w = pack2(r[6], r[7]);
        *(uint4*)(mix + (size_t)m * 1024 + lane * 8) = o1;
        unpack8(u1[u], f1); unpack8(u2[u], f2); unpack8(uh[u], g);
        ss = 0.f;
#pragma unroll
        for (int e = 0; e < 8; ++e) { a[e] = f1[e] + f2[e]; ss += a[e] * a[e]; }
#pragma unroll
        for (int o = 8; o >= 1; o >>= 1) ss += __shfl_xor(ss, o);
        rstd = rsqrtf(ss * (1.f / 128.f) + 1e-6f);
#pragma unroll
        for (int e = 0; e < 8; ++e) r[e] = a[e] * rstd * wh[e] * g[e];
        o1.x = pack2(r[0], r[1]); o1.y = pack2(r[2], r[3]); o1.z = pack2(r[4], r[5]); o1.w = pack2(r[6], r[7]);
        *(uint4*)(mix + (size_t)m * 1024 + 512 + lane * 8) = o1;
      }
    }
  }
}

__device__ void phase3(const Params& p, char* smem, int bid, int nblk, const XMap xm) {
  const int lane = threadIdx.x & 63, w = threadIdx.x >> 6;
  const int wn = w & 1, wm = w >> 1;
  const int r0 = lane & 31, h0 = lane >> 5;
  const int ntiles = xm.xcc >= 0 ? 256 : (MTOK / 128) * 8;
  for (int tile0 = xm.xcc >= 0 ? xm.rank : bid; tile0 < ntiles * (1 + PROBE_P3); tile0 += xm.xcc >= 0 ? xm.nloc : nblk) {
    const int tile = tile0 >= ntiles ? tile0 - ntiles : tile0;
    int mt, nt;
    if (xm.xcc >= 0) { const int c = tile >> 6, q = tile & 63; mt = xm.xcc * 32 + c * 8 + (q >> 3); nt = q & 7; }
    else { mt = tile >> 3; nt = tile & 7; }
    f32x16 acc[2][2];
    gemm_mainloop(p.woutT, p.mix, nt * 128, mt * 128, smem, acc);
    int r = r0, h = h0;
    asm volatile("" : "+v"(r), "+v"(h));
    float* T = (float*)smem;
#pragma unroll
    for (int b = 0; b < 2; ++b) {
      float* trow = T + (wm * 64 + b * 32 + r) * EPF + wn * 64 + 4 * h;
#pragma unroll
      for (int a = 0; a < 2; ++a)
#pragma unroll
        for (int g = 0; g < 4; ++g) {
          float4 o;
          o.x = acc[a][b][4 * g + 0]; o.y = acc[a][b][4 * g + 1]; o.z = acc[a][b][4 * g + 2]; o.w = acc[a][b][4 * g + 3];
          *(float4*)(trow + a * 32 + 8 * g) = o;
        }
    }
    __syncthreads();
    {
      const int tid = threadIdx.x;
      const int ch = tid & 31, rw = tid >> 5;
      const size_t gofs = (size_t)(mt * 128) * 1024 + nt * 128 + ch * 4;
#pragma unroll
      for (int j0 = 0; j0 < 16; j0 += 4) {
        float4 xv[4];
#pragma unroll
        for (int u = 0; u < 4; ++u) xv[u] = *(const float4*)(p.x + gofs + (size_t)((j0 + u) * 8 + rw) * 1024);
#pragma unroll
        for (int u = 0; u < 4; ++u) {
          const int row = (j0 + u) * 8 + rw;
          const float4 y = *(const float4*)(T + row * EPF + ch * 4);
          float4 o;
          o.x = DN_ALPHA * xv[u].x + y.x; o.y = DN_ALPHA * xv[u].y + y.y; o.z = DN_ALPHA * xv[u].z + y.z; o.w = DN_ALPHA * xv[u].w + y.w;
          *(float4*)(p.z + gofs + (size_t)row * 1024) = o;
        }
      }
    }
  }
}

__device__ void phase4(const Params& p, int bid, int nblk) {
  const int lane = threadIdx.x & 63, w = threadIdx.x >> 6;
  const int stride = nblk * 4;
  for (int m0 = bid * 4 + w; m0 < MTOK; m0 += 4 * stride) {
    float4 v[4][4];
#pragma unroll
    for (int u = 0; u < 4; ++u) {
      const int m = m0 + u * stride;
      if (m < MTOK) {
        const float4* row = (const float4*)(p.z + (size_t)m * 1024);
#pragma unroll
        for (int j = 0; j < 4; ++j) v[u][j] = row[lane + 64 * j];
      }
    }
#pragma unroll
    for (int u = 0; u < 4; ++u) {
      const int m = m0 + u * stride;
      if (m < MTOK) {
        float4* row = (float4*)(p.out + (size_t)m * 1024);
        float s = 0.f;
#pragma unroll
        for (int j = 0; j < 4; ++j) s += v[u][j].x + v[u][j].y + v[u][j].z + v[u][j].w;
#pragma unroll
        for (int o = 32; o >= 1; o >>= 1) s += __shfl_xor(s, o);
        const float mu = s * (1.f / 1024.f);
        float q = 0.f;
#pragma unroll
        for (int j = 0; j < 4; ++j) {
          v[u][j].x -= mu; v[u][j].y -= mu; v[u][j].z -= mu; v[u][j].w -= mu;
          q += v[u][j].x * v[u][j].x + v[u][j].y * v[u][j].y + v[u][j].z * v[u][j].z + v[u][j].w * v[u][j].w;
        }
#pragma unroll
        for (int o = 32; o >= 1; o >>= 1) q += __shfl_xor(q, o);
        const float rstd = rsqrtf(q * (1.f / 1024.f) + 1e-5f);
#pragma unroll
        for (int j = 0; j < 4; ++j) {
          const float4 wv = ((const float4*)p.ln_w)[lane + 64 * j], bv = ((const float4*)p.ln_b)[lane + 64 * j];
          float4 o;
          o.x = v[u][j].x * rstd * wv.x + bv.x; o.y = v[u][j].y * rstd * wv.y + bv.y;
          o.z = v[u][j].z * rstd * wv.z + bv.z; o.w = v[u][j].w * rstd * wv.w + bv.w;
          row[lane + 64 * j] = o;
        }
      }
    }
  }
}


#define XB_TMO      128
#define XB_XCNT(j)  (256  + 64 * (j))
#define XB_XSUB(j)  (1280 + 64 * (j))
#define XB_XGEN(j)  (2304 + 64 * (j))
#define XB_TOP      3328
#define XB_TOPGEN   3392
#define XCD_BAR_WORDS 3456
#define XB_SPIN_CAP (1u << 18)
#define LAS __attribute__((address_space(3)))
DI unsigned xb_ld(unsigned* p) { return __hip_atomic_load(p, __ATOMIC_RELAXED, __HIP_MEMORY_SCOPE_AGENT); }
DI unsigned xb_add(unsigned* p, unsigned v) { return __hip_atomic_fetch_add(p, v, __ATOMIC_RELAXED, __HIP_MEMORY_SCOPE_AGENT); }
DI unsigned xb_xcc_id() { return (unsigned)__builtin_amdgcn_s_getreg((3 << 11) | 20) & 0xFu; }
#define XB_SPIN(cond, bar) do { unsigned _sp = 0; while (cond) { __builtin_amdgcn_s_sleep(1); \
    if ((++_sp & 255u) == 0u) { if (xb_ld(&(bar)[XB_TMO])) break; if (_sp > XB_SPIN_CAP) { atomicAdd(&(bar)[XB_TMO], 1u); break; } } } } while (0)
struct XcdBarrier { unsigned* bar; unsigned x; volatile LAS unsigned* st; };
DI XcdBarrier xcd_barrier_post(unsigned* bar, volatile LAS unsigned* st, unsigned& rank) {
  XcdBarrier b; b.bar = bar; b.x = xb_xcc_id(); b.st = st;
  rank = 0u;
  if (threadIdx.x == 0) rank = xb_add(&bar[XB_XCNT(b.x)], 1u);
  return b;
}
DI void xcd_barrier_complete(unsigned* bar, unsigned x, unsigned& nloc, unsigned& nx) {
  const unsigned G = gridDim.x * gridDim.y * gridDim.z;
  unsigned sum, cnt, mine, sp = 0u;
  for (;;) {
    sum = 0u; cnt = 0u; mine = 0u;
#pragma unroll
    for (unsigned j = 0; j < 16; ++j) { const unsigned c = xb_ld(&bar[XB_XCNT(j)]); sum += c; cnt += (c > 0u) ? 1u : 0u; mine = (j == x) ? c : mine; }
    if (sum == G) break;
    __builtin_amdgcn_s_sleep(1);
    if ((++sp & 255u) == 0u) { if (xb_ld(&bar[XB_TMO])) break; if (sp > XB_SPIN_CAP) { atomicAdd(&bar[XB_TMO], 1u); break; } }
  }
  nloc = mine > 0u ? mine : 1u; nx = cnt > 0u ? cnt : 1u;
}
DI void xcd_barrier(const XcdBarrier& b) {
  asm volatile("s_waitcnt vmcnt(0)" ::: "memory");
  __syncthreads();
  if (threadIdx.x == 0) {
    unsigned* bar = b.bar;
    __builtin_amdgcn_s_waitcnt(0);
    unsigned nloc = b.st[0], nx = b.st[1];
    if (nloc == 0u) { xcd_barrier_complete(bar, b.x, nloc, nx); b.st[0] = nloc; b.st[1] = nx; }
    const unsigned old = xb_add(&bar[XB_XSUB(b.x)], 1u);
    const unsigned gen = old / nloc;
    if (old + 1u == (gen + 1u) * nloc) {
      __builtin_amdgcn_fence(__ATOMIC_RELEASE, "agent");
      asm volatile("s_waitcnt vmcnt(0)" ::: "memory");
      const unsigned og = xb_add(&bar[XB_TOP], 1u);
      const unsigned tg = og / nx;
      if (og + 1u == (tg + 1u) * nx) xb_add(&bar[XB_TOPGEN], 1u);
      else XB_SPIN(xb_ld(&bar[XB_TOPGEN]) == tg, bar);
      __builtin_amdgcn_fence(__ATOMIC_ACQUIRE, "agent");
      xb_add(&bar[XB_XGEN(b.x)], 1u);
      asm volatile("s_waitcnt vmcnt(0)" ::: "memory");
    } else {
      XB_SPIN(xb_ld(&bar[XB_XGEN(b.x)]) == gen, bar);
      __builtin_amdgcn_fence(__ATOMIC_ACQUIRE, "agent");
      asm volatile("s_waitcnt vmcnt(0)" ::: "memory");
    }
  }
  __syncthreads();
}

constexpr int MEGA_LDS = HG_LDS > GEMM_LDS ? HG_LDS : GEMM_LDS;
__global__ void __launch_bounds__(256, 2) mega_kernel(Params p) {
  __shared__ __attribute__((aligned(16))) char smem[MEGA_LDS];
  __shared__ uint4 xb_words;
  __shared__ int s_item;
  __shared__ int s_xm[4];
  cg::grid_group grid = cg::this_grid();
  const int bid = blockIdx.x, nblk = gridDim.x;
  if (threadIdx.x == 0) xb_words = make_uint4(0u, 0u, 0u, 0u);
  __syncthreads();
  unsigned my_rank;
  XcdBarrier xb = xcd_barrier_post(p.bar, (volatile LAS unsigned*)&xb_words, my_rank);
  if (p.out == nullptr) grid.sync();
  phase0(p, smem, bid, nblk);
#if PROBE_P0
  phase0(p, smem, bid, nblk);
#endif
  xcd_barrier(xb);
  if (threadIdx.x == 0) {
    unsigned sum = 0;
#pragma unroll
    for (int j = 0; j < 8; ++j) sum += xb_ld(&p.bar[XB_XCNT(j)]);
    const bool ok = sum == (unsigned)nblk && xb.x < 8u && xb_words.y == 8u;
    s_xm[0] = ok ? (int)xb.x : -1; s_xm[1] = (int)my_rank; s_xm[2] = (int)xb_words.x;
  }
  __syncthreads();
  XMap xm; xm.xcc = s_xm[0]; xm.rank = s_xm[1]; xm.nloc = s_xm[2];
  phase1(p, smem, bid, nblk, xm);
  xcd_barrier(xb);
  if (bid < 64) hgrn_item(p, smem, bid);
  for (;;) {
    __syncthreads();
    if (threadIdx.x == 0) s_item = atomicAdd(p.ctr, 1);
    __syncthreads();
    const int it = __builtin_amdgcn_readfirstlane(s_item);
    if (it >= 2048 * (1 + PROBE_AT)) break;
    attn_item(p, smem, it & 2047);
  }
  xcd_barrier(xb);
  phase_mix(p, bid, nblk);
#if PROBE_MIX
  phase_mix(p, bid, nblk);
#endif
  xcd_barrier(xb);
  phase3(p, smem, bid, nblk, xm);
  xcd_barrier(xb);
  phase4(p, bid, nblk);
}

__global__ __launch_bounds__(256) void k_phase0(Params p) { __shared__ __attribute__((aligned(16))) char smem[64 * 65 * 4]; phase0(p, smem, blockIdx.x, gridDim.x); }
__global__ __launch_bounds__(256) void k_phase1(Params p) { __shared__ __attribute__((aligned(16))) char smem[GEMM_LDS]; XMap xm; xm.xcc = -1; xm.rank = 0; xm.nloc = 1; phase1(p, smem, blockIdx.x, gridDim.x, xm); }
__global__ __launch_bounds__(256) void k_attn(Params p) { __shared__ __attribute__((aligned(16))) char smem[ATT_LDS]; for (int it = blockIdx.x; it < 2048; it += gridDim.x) attn_item(p, smem, it); }
__global__ __launch_bounds__(256) void k_hgrn(Params p) { __shared__ __attribute__((aligned(16))) char smem[HG_LDS]; for (int it = blockIdx.x; it < 64; it += gridDim.x) hgrn_item(p, smem, it); }
__global__ __launch_bounds__(256) void k_mix(Params p) { phase_mix(p, blockIdx.x, gridDim.x); }
__global__ __launch_bounds__(256) void k_phase3(Params p) { __shared__ __attribute__((aligned(16))) char smem[GEMM_LDS]; XMap xm; xm.xcc = -1; xm.rank = 0; xm.nloc = 1; phase3(p, smem, blockIdx.x, gridDim.x, xm); }
__global__ __launch_bounds__(256) void k_phase4(Params p) { phase4(p, blockIdx.x, gridDim.x); }

extern "C" void kernel_launch(void* const* d_in, const int* in_sizes, int n_in, void* d_out, int out_size, void* d_ws, size_t ws_size,
                              hipStream_t stream) {
  Params p{};
  p.x = (const float*)d_in[0]; p.w_in = (const float*)d_in[1]; p.q_norm_w = (const float*)d_in[2]; p.k_norm_w = (const float*)d_in[3];
  p.attn_norm_w = (const float*)d_in[4]; p.lb_logits = (const float*)d_in[5]; p.hg_norm_w = (const float*)d_in[6];
  p.w_out = (const float*)d_in[7]; p.ln_w = (const float*)d_in[8]; p.ln_b = (const float*)d_in[9];
  p.out = (float*)d_out;
  char* ws = (char*)d_ws;
  size_t off = 0;
  auto take = [&](size_t bytes) { char* r = ws + off; off += (bytes + 255) & ~(size_t)255; return r; };
  p.xb = (u16*)take((size_t)MTOK * 1024 * 2);
  p.winT = (u16*)take((size_t)INW * 1024 * 2);
  p.woutT = (u16*)take((size_t)1024 * 1024 * 2);
  p.rope = (float2*)take(1024 * 8);
  p.lbv = (float*)take(1024 * 4);
  p.q = (u16*)take((size_t)MTOK * 512 * 2);
  p.k = (u16*)take((size_t)MTOK * 128 * 2);
  p.vT = (u16*)take((size_t)MTOK * 128 * 2);
  p.ga = (u16*)take((size_t)MTOK * 512 * 2);
  p.hq = (u16*)take((size_t)MTOK * 512 * 2);
  p.hi = (u16*)take((size_t)MTOK * 512 * 2);
  p.lff = (u16*)take((size_t)MTOK * 512 * 4);
  p.lfb = (u16*)take((size_t)MTOK * 512 * 4);
  p.gh = (u16*)take((size_t)MTOK * 512 * 2);
  p.attn = (u16*)take((size_t)MTOK * 512 * 2);
  p.of = (u16*)take((size_t)MTOK * 512 * 2);
  p.ob = (u16*)take((size_t)MTOK * 512 * 2);
  p.ctr = (int*)take(256);
  p.bar = (unsigned*)take(XCD_BAR_WORDS * 4);
  p.mix = p.hq;
  p.z = (float*)p.lff;
  if (off > ws_size) { fprintf(stderr, "workspace too small: need %zu have %zu\n", off, ws_size); return; }
#if ONE_LAUNCH
  static int grid_blocks = 0;
  if (!grid_blocks) {
    int dev = 0, cus = 0, per_cu = 0;
    hipGetDevice(&dev);
    hipDeviceGetAttribute(&cus, hipDeviceAttributeMultiprocessorCount, dev);
    hipOccupancyMaxActiveBlocksPerMultiprocessor(&per_cu, mega_kernel, 256, 0);
    if (per_cu > 2) per_cu = 2;
    grid_blocks = cus * per_cu;
    if (grid_blocks < 64) fprintf(stderr, "grid too small: %d\n", grid_blocks);
  }
  hipMemsetAsync(p.ctr, 0, 256 + ((XCD_BAR_WORDS * 4 + 255) & ~255), stream);
  void* args[] = {&p};
  hipError_t e = hipLaunchCooperativeKernel((void*)mega_kernel, dim3(grid_blocks), dim3(256), args, 0, stream);
  if (e != hipSuccess) fprintf(stderr, "cooperative launch failed: %s (grid %d)\n", hipGetErrorString(e), grid_blocks);
#else
  k_phase0<<<1024, 256, 0, stream>>>(p);
  k_phase1<<<512, 256, 0, stream>>>(p);
  k_attn<<<2048, 256, 0, stream>>>(p);
  k_hgrn<<<64, 256, 0, stream>>>(p);
  k_mix<<<2048, 256, 0, stream>>>(p);
  k_phase3<<<512, 256, 0, stream>>>(p);
  k_phase4<<<2048, 256, 0, stream>>>(p);
#endif
}
```

```cpp
#include <hip/hip_runtime.h>
#include <hip/hip_cooperative_groups.h>
#include <stdint.h>
#include <stdio.h>

namespace cg = cooperative_groups;

#ifndef ONE_LAUNCH
#define ONE_LAUNCH 1
#endif
#ifndef PROBE_P0
#define PROBE_P0 0
#endif
#ifndef PROBE_MIX
#define PROBE_MIX 0
#endif
#ifndef PROBE_P1
#define PROBE_P1 0
#endif
#ifndef PROBE_HG
#define PROBE_HG 0
#endif
#ifndef PROBE_AT
#define PROBE_AT 0
#endif
#ifndef PROBE_P3
#define PROBE_P3 0
#endif

typedef __attribute__((ext_vector_type(8))) short bf16x8;
typedef __attribute__((ext_vector_type(4))) short s16x4;
typedef __attribute__((ext_vector_type(16))) float f32x16;
typedef unsigned short u16;
typedef __attribute__((ext_vector_type(4))) unsigned u32x4;
typedef __attribute__((ext_vector_type(2))) unsigned u32x2;

#define DI __device__ __forceinline__
#define MFMA32(a, b, c) __builtin_amdgcn_mfma_f32_32x32x16_bf16((a), (b), (c), 0, 0, 0)

constexpr int MTOK = 32768;
constexpr int SEQ = 4096;
constexpr int DM = 1024;
constexpr int INW = 3840;
constexpr float Q_PRESCALE = 0.125f * 1.4426950408889634f;
constexpr float HQ_SCALE = 0.08838834764831845f;
constexpr float DN_ALPHA = 1.189207115002721f;

struct Params {
  const float* x; const float* w_in; const float* q_norm_w; const float* k_norm_w;
  const float* attn_norm_w; const float* lb_logits; const float* hg_norm_w; const float* w_out;
  const float* ln_w; const float* ln_b;
  float* out;
  u16* xb;
  u16* winT;
  u16* woutT;
  float2* rope;
  float* lbv;
  u16* q;
  u16* k;
  u16* vT;
  u16* ga;
  u16* hq;
  u16* hi;
  u16* lff;
  u16* lfb;
  u16* gh;
  u16* attn;
  u16* of;
  u16* ob;
  int* ctr;
  unsigned* bar;
  u16* mix;
  float* z;
};

DI u16 f2bf(float x) { uint32_t u = __float_as_uint(x); u += 0x7fffu + ((u >> 16) & 1u); return (u16)(u >> 16); }
DI float bf2f(u16 v) { return __uint_as_float(((uint32_t)v) << 16); }
typedef __attribute__((ext_vector_type(2))) float f32x2_t;
typedef __attribute__((ext_vector_type(2))) __bf16 bf16x2_t;
DI uint32_t pack2(float a, float b) { f32x2_t v = {a, b}; bf16x2_t r = __builtin_convertvector(v, bf16x2_t); return __builtin_bit_cast(uint32_t, r); }
typedef __attribute__((ext_vector_type(2))) _Float16 f16x2_t;
DI uint32_t pack2h(float a, float b) { f16x2_t r = {(_Float16)a, (_Float16)b}; return __builtin_bit_cast(uint32_t, r); }
DI float h2f_lo(uint32_t u) { return (float)__builtin_bit_cast(f16x2_t, u)[0]; }
DI float h2f_hi(uint32_t u) { return (float)__builtin_bit_cast(f16x2_t, u)[1]; }
DI int crow(int i, int h) { return (i & 3) + 8 * (i >> 2) + 4 * h; }
DI float silu_f(float v) { return v * __builtin_amdgcn_rcpf(1.f + __expf(-v)); }

__device__ void phase0(const Params& p, char* smem, int bid, int nblk) {
  const int tid = threadIdx.x;
  {
    const size_t nvec = (size_t)MTOK * DM / 8;
    const size_t T = (size_t)nblk * 256;
    for (size_t i = (size_t)bid * 256 + tid; i < nvec; i += 4 * T) {
      float4 a[4], b[4];
#pragma unroll
      for (int u = 0; u < 4; ++u) {
        const size_t ii = i + u * T;
        if (ii < nvec) { a[u] = ((const float4*)p.x)[2 * ii]; b[u] = ((const float4*)p.x)[2 * ii + 1]; }
      }
#pragma unroll
      for (int u = 0; u < 4; ++u) {
        const size_t ii = i + u * T;
        if (ii < nvec) {
          uint4 o; o.x = pack2(a[u].x, a[u].y); o.y = pack2(a[u].z, a[u].w); o.z = pack2(b[u].x, b[u].y); o.w = pack2(b[u].z, b[u].w);
          ((uint4*)p.xb)[ii] = o;
        }
      }
    }
  }
  {
    float* t = (float*)smem;
    const int ntile_in = 16 * 60, ntile_all = ntile_in + 16 * 16;
    for (int tile = bid; tile < ntile_all; tile += nblk) {
      const float* src; u16* dst; int N, kt, nt;
      if (tile < ntile_in) { src = p.w_in; dst = p.winT; N = INW; kt = tile / 60; nt = tile % 60; }
      else { int tt = tile - ntile_in; src = p.w_out; dst = p.woutT; N = DM; kt = tt / 16; nt = tt % 16; }
      __syncthreads();
#pragma unroll
      for (int j = 0; j < 4; ++j) {
        const int kk = (tid >> 4) + 16 * j, nn = (tid & 15) * 4;
        const float4 v = *(const float4*)(src + (size_t)(kt * 64 + kk) * N + nt * 64 + nn);
        t[kk * 65 + nn] = v.x; t[kk * 65 + nn + 1] = v.y; t[kk * 65 + nn + 2] = v.z; t[kk * 65 + nn + 3] = v.w;
      }
      __syncthreads();
      const int n = tid >> 2, kc = (tid & 3) * 16;
      uint32_t o[8];
#pragma unroll
      for (int j = 0; j < 8; ++j) o[j] = pack2(t[(kc + 2 * j) * 65 + n], t[(kc + 2 * j + 1) * 65 + n]);
      uint4* d = (uint4*)(dst + (size_t)(nt * 64 + n) * 1024 + kt * 64 + kc);
      d[0] = make_uint4(o[0], o[1], o[2], o[3]);
      d[1] = make_uint4(o[4], o[5], o[6], o[7]);
    }
  }
  for (int i = bid * 256 + tid; i < 2048; i += nblk * 256) {
    if (i < 1024) {
      const int pos = i >> 4, j = i & 15;
      const float inv = powf(10000.f, -(float)(2 * j) / 32.f);
      const float ang = (float)pos * inv;
      p.rope[i] = make_float2(cosf(ang), sinf(ang));
    } else {
      const int ii = i - 1024, dir = ii >> 9, wcol = ii & 511;
      const float l0 = p.lb_logits[(dir * 2 + 0) * 512 + wcol], l1 = p.lb_logits[(dir * 2 + 1) * 512 + wcol];
      const float mx = fmaxf(l0, l1);
      const float e0 = expf(l0 - mx), e1 = expf(l1 - mx);
      p.lbv[ii] = e0 / (e0 + e1);
    }
  }
}

constexpr int GP = 72;
constexpr int EP = 136;
constexpr int EPF = 132;
constexpr int GEMM_LDS = 2 * 2 * 128 * GP * 2;

DI void gemm_issue(const u16* __restrict__ A, const u16* __restrict__ B, int n0, int m0,
                   u32x4 (&ra0)[4], u32x4 (&rb0)[4], u32x4 (&ra1)[4], u32x4 (&rb1)[4]) {
  const int tid = threadIdx.x;
  const int lc = tid & 7, lr = tid >> 3;
  const u16* gA = A + (size_t)(n0 + lr) * 1024 + lc * 8;
  const u16* gB = B + (size_t)(m0 + lr) * 1024 + lc * 8;
#pragma unroll
  for (int j = 0; j < 4; ++j) { ra0[j] = *(const u32x4*)(gA + (size_t)j * 32 * 1024); rb0[j] = *(const u32x4*)(gB + (size_t)j * 32 * 1024); }
#pragma unroll
  for (int j = 0; j < 4; ++j) { ra1[j] = *(const u32x4*)(gA + (size_t)j * 32 * 1024 + 64); rb1[j] = *(const u32x4*)(gB + (size_t)j * 32 * 1024 + 64); }
}
DI void gemm_run(const u16* __restrict__ A, const u16* __restrict__ B, int n0, int m0, char* smem, f32x16 (&acc)[2][2],
                 u32x4 (&ra0)[4], u32x4 (&rb0)[4], u32x4 (&ra1)[4], u32x4 (&rb1)[4]) {
  const int tid = threadIdx.x, lane = tid & 63, w = __builtin_amdgcn_readfirstlane(tid >> 6);
  const int wn = w & 1, wm = w >> 1;
  const int lc = tid & 7, lr = tid >> 3;
  u16* sm = (u16*)smem;
  const u16* gA = A + (size_t)(n0 + lr) * 1024 + lc * 8;
  const u16* gB = B + (size_t)(m0 + lr) * 1024 + lc * 8;
#pragma unroll
  for (int a = 0; a < 2; ++a)
#pragma unroll
    for (int b = 0; b < 2; ++b)
#pragma unroll
      for (int i = 0; i < 16; ++i) acc[a][b][i] = 0.f;
  __syncthreads();
#pragma unroll
  for (int j = 0; j < 4; ++j) {
    *(u32x4*)(sm + (0 * 128 + lr + 32 * j) * GP + lc * 8) = ra0[j];
    *(u32x4*)(sm + (1 * 128 + lr + 32 * j) * GP + lc * 8) = rb0[j];
  }
  __syncthreads();
  const int fr = lane & 31, fh = lane >> 5;
  const u16* fa = sm + (wn * 64 + fr) * GP + fh * 8;
  const u16* fb = sm + (128 + wm * 64 + fr) * GP + fh * 8;
#define GEMM_COMPUTE(ST)                                                                          \
  _Pragma("unroll") for (int ks = 0; ks < 4; ++ks) {                                              \
    bf16x8 af[2], bfr[2];                                                                         \
    _Pragma("unroll") for (int a = 0; a < 2; ++a) af[a] = *(const bf16x8*)(fa + ((ST) * 256 + a * 32) * GP + ks * 16);   \
    _Pragma("unroll") for (int b = 0; b < 2; ++b) bfr[b] = *(const bf16x8*)(fb + ((ST) * 256 + b * 32) * GP + ks * 16);  \
    _Pragma("unroll") for (int a = 0; a < 2; ++a)                                                 \
      _Pragma("unroll") for (int b = 0; b < 2; ++b) acc[a][b] = MFMA32(af[a], bfr[b], acc[a][b]); \
  }
  for (int kt = 0; kt < 16; kt += 2) {
    if (kt + 2 < 16) {
#pragma unroll
      for (int j = 0; j < 4; ++j) {
        ra0[j] = *(const u32x4*)(gA + (size_t)j * 32 * 1024 + (kt + 2) * 64);
        rb0[j] = *(const u32x4*)(gB + (size_t)j * 32 * 1024 + (kt + 2) * 64);
      }
    }
    __builtin_amdgcn_sched_barrier(0);
    GEMM_COMPUTE(0)
#pragma unroll
    for (int j = 0; j < 4; ++j) {
      *(u32x4*)(sm + ((2 + 0) * 128 + lr + 32 * j) * GP + lc * 8) = ra1[j];
      *(u32x4*)(sm + ((2 + 1) * 128 + lr + 32 * j) * GP + lc * 8) = rb1[j];
    }
    __syncthreads();
    if (kt + 3 < 16) {
#pragma unroll
      for (int j = 0; j < 4; ++j) {
        ra1[j] = *(const u32x4*)(gA + (size_t)j * 32 * 1024 + (kt + 3) * 64);
        rb1[j] = *(const u32x4*)(gB + (size_t)j * 32 * 1024 + (kt + 3) * 64);
      }
    }
    __builtin_amdgcn_sched_barrier(0);
    GEMM_COMPUTE(1)
    if (kt + 2 < 16) {
#pragma unroll
      for (int j = 0; j < 4; ++j) {
        *(u32x4*)(sm + (0 * 128 + lr + 32 * j) * GP + lc * 8) = ra0[j];
        *(u32x4*)(sm + (1 * 128 + lr + 32 * j) * GP + lc * 8) = rb0[j];
      }
    }
    __syncthreads();
  }
#undef GEMM_COMPUTE
}

struct XMap { int xcc, rank, nloc; };
__device__ void phase1(const Params& p, char* smem, int bid, int nblk, const XMap xm) {
  const int lane = threadIdx.x & 63, w = threadIdx.x >> 6;
  const int wn = w & 1, wm = w >> 1;
  const int r0 = lane & 31, h0 = lane >> 5;
  const int ntiles = xm.xcc >= 0 ? 960 : (MTOK / 128) * 30;
  const int tstep = xm.xcc >= 0 ? xm.nloc : nblk;
  const int tend = ntiles * (1 + PROBE_P1);
  auto coords = [&](int tile0, int& mt, int& nt) {
    const int tile = tile0 >= ntiles ? tile0 - ntiles : tile0;
    if (xm.xcc >= 0) {
      int ml;
      if (tile < 768) { const int g = tile >> 8, rem = tile & 255, c = rem >> 6, q = rem & 63; ml = c * 8 + (q >> 3); nt = g * 8 + (q & 7); }
      else { const int t2 = tile - 768, c = t2 / 48, q = t2 % 48; ml = c * 8 + q / 6; nt = 24 + q % 6; }
      mt = xm.xcc * 32 + ml;
    } else { mt = tile / 30; nt = tile % 30; }
  };
  u32x4 ra0[4], rb0[4], ra1[4], rb1[4];
  int tile0 = xm.xcc >= 0 ? xm.rank : bid;
  int mt = 0, nt = 0;
  if (tile0 < tend) { coords(tile0, mt, nt); gemm_issue(p.winT, p.xb, nt * 128, mt * 128, ra0, rb0, ra1, rb1); }
  while (tile0 < tend) {
    f32x16 acc[2][2];
    gemm_run(p.winT, p.xb, nt * 128, mt * 128, smem, acc, ra0, rb0, ra1, rb1);
    const int mt_c = mt, nt_c = nt;
    tile0 += tstep;
    if (tile0 < tend) { coords(tile0, mt, nt); gemm_issue(p.winT, p.xb, nt * 128, mt * 128, ra0, rb0, ra1, rb1); }
    {
    const int mt = mt_c, nt = nt_c;
    int r = r0, h = h0;
    asm volatile("" : "+v"(r), "+v"(h));
    u16* T = (u16*)smem;
    const int mbase = mt * 128 + wm * 64;
    if (nt <= 4) {
      const bool isq = nt < 4;
      const float* nw = isq ? p.q_norm_w : p.k_norm_w;
      const float sc = isq ? Q_PRESCALE : 1.0f;
#pragma unroll
      for (int b = 0; b < 2; ++b) {
        const int m = mbase + b * 32 + r;
        const int s = m & 4095;
        const int rp = s >> 6, cp = s & 63;
        float ss = 0.f;
#pragma unroll
        for (int a = 0; a < 2; ++a)
#pragma unroll
          for (int i = 0; i < 16; ++i) ss += acc[a][b][i] * acc[a][b][i];
        ss += __shfl_xor(ss, 32);
        const float rstd = rsqrtf(ss * (1.f / 64.f) + 1e-6f);
        u16* trow = T + (wm * 64 + b * 32 + r) * EP + wn * 64 + 4 * h;
#pragma unroll
        for (int a = 0; a < 2; ++a) {
          const int pos = a == 0 ? rp : cp;
          float y[16], o[16];
#pragma unroll
          for (int i = 0; i < 16; ++i) y[i] = acc[a][b][i] * rstd * nw[a * 32 + crow(i, h)];
#pragma unroll
          for (int i = 0; i < 8; ++i) {
            const float2 cs = p.rope[pos * 16 + crow(i, h)];
            o[i] = (y[i] * cs.x - y[i + 8] * cs.y) * sc;
            o[i + 8] = (y[i + 8] * cs.x + y[i] * cs.y) * sc;
          }
#pragma unroll
          for (int g = 0; g < 4; ++g) {
            u32x2 v; v.x = pack2(o[4 * g], o[4 * g + 1]); v.y = pack2(o[4 * g + 2], o[4 * g + 3]);
            *(u32x2*)(trow + a * 32 + 8 * g) = v;
          }
        }
      }
    } else if (nt == 5) {
#pragma unroll
      for (int b = 0; b < 2; ++b)
#pragma unroll
        for (int a = 0; a < 2; ++a)
#pragma unroll
          for (int i = 0; i < 16; ++i) T[(wn * 64 + a * 32 + crow(i, h)) * EP + wm * 64 + b * 32 + r] = f2bf(acc[a][b][i]);
    } else {
      const int gi = (nt - 6) >> 2;
      const int cb = ((nt - 6) & 3) * 128 + wn * 64;
#pragma unroll
      for (int b = 0; b < 2; ++b) {
        u16* trow = T + (wm * 64 + b * 32 + r) * EP + wn * 64 + 4 * h;
#pragma unroll
        for (int a = 0; a < 2; ++a)
#pragma unroll
          for (int g = 0; g < 4; ++g) {
            float v[4];
#pragma unroll
            for (int e = 0; e < 4; ++e) v[e] = acc[a][b][4 * g + e];
            u32x2 o;
            if (gi == 3 || gi == 4) {
              const float4 lb = *(const float4*)(p.lbv + (gi - 3) * 512 + cb + a * 32 + 8 * g + 4 * h);
              const float ox = __builtin_amdgcn_logf(lb.x + (1.f - lb.x) * __builtin_amdgcn_rcpf(1.f + __expf(-v[0])));
              const float oy = __builtin_amdgcn_logf(lb.y + (1.f - lb.y) * __builtin_amdgcn_rcpf(1.f + __expf(-v[1])));
              const float oz = __builtin_amdgcn_logf(lb.z + (1.f - lb.z) * __builtin_amdgcn_rcpf(1.f + __expf(-v[2])));
              const float ow = __builtin_amdgcn_logf(lb.w + (1.f - lb.w) * __builtin_amdgcn_rcpf(1.f + __expf(-v[3])));
              o.x = pack2h(ox, oy); o.y = pack2h(oz, ow);
            } else {
              if (gi == 0 || gi == 5) {
#pragma unroll
                for (int e = 0; e < 4; ++e) v[e] = silu_f(v[e]);
              } else if (gi == 1) {
#pragma unroll
                for (int e = 0; e < 4; ++e) v[e] = silu_f(v[e]) * HQ_SCALE;
              }
              o.x = pack2(v[0], v[1]); o.y = pack2(v[2], v[3]);
            }
            *(u32x2*)(trow + a * 32 + 8 * g) = o;
          }
      }
    }
    __syncthreads();
    {
      const int tid = threadIdx.x;
      const int ch = tid & 15, rw = tid >> 4;
      const int bi = (mt * 128) >> 12, s0 = (mt * 128) & 4095;
      u16* dbase; size_t rstride;
      if (nt < 4)       { dbase = p.q + ((size_t)(bi * 8 + nt * 2 + (ch >> 3)) * SEQ + s0) * 64 + (ch & 7) * 8; rstride = 64; }
      else if (nt == 4) { dbase = p.k + ((size_t)(bi * 2 + (ch >> 3)) * SEQ + s0) * 64 + (ch & 7) * 8; rstride = 64; }
      else if (nt == 5) { dbase = p.vT + (size_t)(bi * 2) * 64 * SEQ + s0 + ch * 8; rstride = SEQ; }
      else {
        const int gi = (nt - 6) >> 2;
        u16* gb = gi == 0 ? p.ga : gi == 1 ? p.hq : gi == 2 ? p.hi : gi == 3 ? p.lff : gi == 4 ? p.lfb : p.gh;
        dbase = gb + (size_t)(mt * 128) * 512 + ((nt - 6) & 3) * 128 + ch * 8; rstride = 512;
      }
#pragma unroll
      for (int j = 0; j < 8; ++j) {
        const int row = j * 16 + rw;
        const u32x4 v = *(const u32x4*)(T + row * EP + ch * 8);
        *(u32x4*)(dbase + (size_t)row * rstride) = v;
      }
    }
    }
  }
}

constexpr int AP = 72;
constexpr int ATT_LDS = 2 * 2 * 64 * AP * 2;
DI float fast_exp2(float x) { return __builtin_amdgcn_exp2f(x); }

__device__ void attn_item(const Params& p, char* smem, int item) {
  const int tid = threadIdx.x, lane = tid & 63, w = __builtin_amdgcn_readfirstlane(tid >> 6), r = lane & 31, h = lane >> 5;
  const int qb = item & 31, head = (item >> 5) & 7, bi = item >> 8;
  const int kvh = head >> 2;
  const int q0 = qb * 128 + w * 32;
  u16* sm = (u16*)smem;
  bf16x8 qf[4];
  {
    const u16* qp = p.q + ((size_t)(bi * 8 + head) * SEQ + q0 + r) * 64 + h * 8;
#pragma unroll
    for (int ks = 0; ks < 4; ++ks) qf[ks] = *(const bf16x8*)(qp + ks * 16);
  }
  const int lc = tid & 7, lr = tid >> 3;
  const u16* kg = p.k + (size_t)(bi * 2 + kvh) * SEQ * 64 + (size_t)lr * 64 + lc * 8;
  const u16* vg = p.vT + (size_t)(bi * 2 + kvh) * 64 * SEQ + (size_t)lr * SEQ + lc * 8;
  const int kw = lr * AP + lc * 8;
  const int vw = lr * AP + (lc >> 1) * 16 + (lc & 1) * 4;
  u32x4 rkA[2], rvA[2], rkB[2], rvB[2];
#define ATT_LOADK(RK, T) _Pragma("unroll") for (int j = 0; j < 2; ++j) RK[j] = *(const u32x4*)(kg + (size_t)((T) * 64 + j * 32) * 64);
#define ATT_LOADV(RV, T) _Pragma("unroll") for (int j = 0; j < 2; ++j) RV[j] = *(const u32x4*)(vg + (size_t)j * 32 * SEQ + (T) * 64);
#define ATT_STOREK(RK, S) _Pragma("unroll") for (int j = 0; j < 2; ++j) *(u32x4*)(sm + (S) * 64 * AP + kw + j * 32 * AP) = RK[j];
#define ATT_STOREV(RV, S) _Pragma("unroll") for (int j = 0; j < 2; ++j) { u16* vd = sm + (2 + (S)) * 64 * AP + vw + j * 32 * AP; *(u32x2*)(vd) = RV[j].xy; *(u32x2*)(vd + 8) = RV[j].zw; }
#define ATT_QK(DST, S)                                                                      \
  _Pragma("unroll") for (int kt2 = 0; kt2 < 2; ++kt2) {                                     \
    _Pragma("unroll") for (int i = 0; i < 16; ++i) DST[kt2][i] = MINIT;                     \
    _Pragma("unroll") for (int ks = 0; ks < 4; ++ks) {                                      \
      const bf16x8 kf = *(const bf16x8*)(sm + (S) * 64 * AP + (kt2 * 32 + r) * AP + ks * 16 + h * 8); \
      DST[kt2] = MFMA32(kf, qf[ks], DST[kt2]);                                              \
    }                                                                                       \
  }
  ATT_LOADK(rkA, 0) ATT_LOADV(rvA, 0)
  ATT_LOADK(rkB, 1)
  __syncthreads();
  ATT_STOREK(rkA, 0) ATT_STOREV(rvA, 0)
  ATT_STOREK(rkB, 1)
  ATT_LOADK(rkA, 2) ATT_LOADV(rvA, 1)
  __syncthreads();
  f32x16 o[2];
#pragma unroll
  for (int dt = 0; dt < 2; ++dt)
#pragma unroll
    for (int i = 0; i < 16; ++i) o[dt][i] = 0.f;
  float mrun = 0.f, lsum = 0.f;
  f32x16 sa[2], sb[2];
  { const float MINIT = 0.f; ATT_QK(sa, 0) }
  __syncthreads();
#define ATT_STEP(CUR, NXT, T, RKW, RVW, RKL, RVL)                                           \
  {                                                                                         \
    const int t_ = (T);                                                                     \
    if (t_ + 3 < 64) { ATT_LOADK(RKL, t_ + 3) }     \
    if (t_ + 2 < 64) { ATT_LOADV(RVL, t_ + 2) }                                             \
    const float mref_ = mrun;                    \
    float mx = CUR[0][0];                                                                   \
    _Pragma("unroll") for (int i = 1; i < 16; ++i) mx = fmaxf(mx, CUR[0][i]);               \
    _Pragma("unroll") for (int i = 0; i < 16; ++i) mx = fmaxf(mx, CUR[1][i]);               \
    mx = fmaxf(mx, __shfl_xor(mx, 32));                                                     \
    float shift = 0.f;                                                                      \
    if (t_ == 0 || __any(mx > 0.f)) {     \
      shift = t_ == 0 ? mx : fmaxf(mx, 0.f);                                                \
      const float al = fast_exp2(-shift);                                                   \
      lsum *= al;                                                                           \
      _Pragma("unroll") for (int dt = 0; dt < 2; ++dt)                                      \
        _Pragma("unroll") for (int i = 0; i < 16; ++i) o[dt][i] *= al;                      \
      mrun = mref_ + shift;                                                                 \
      _Pragma("unroll") for (int kt2 = 0; kt2 < 2; ++kt2)                                   \
        _Pragma("unroll") for (int i = 0; i < 16; ++i) CUR[kt2][i] -= shift;                \
    }                                                                                       \
    if (t_ + 1 < 64) { const float MINIT = -mrun; ATT_QK(NXT, (t_ + 1) & 1) }               \
    _Pragma("unroll") for (int kt2 = 0; kt2 < 2; ++kt2)                                     \
      _Pragma("unroll") for (int i = 0; i < 16; ++i) { const float e = fast_exp2(CUR[kt2][i]); CUR[kt2][i] = e; lsum += e; } \
    _Pragma("unroll") for (int s2 = 0; s2 < 4; ++s2) {                                      \
      u32x4 pk;                                                                             \
      pk.x = pack2(CUR[s2 >> 1][8 * (s2 & 1) + 0], CUR[s2 >> 1][8 * (s2 & 1) + 1]);         \
      pk.y = pack2(CUR[s2 >> 1][8 * (s2 & 1) + 2], CUR[s2 >> 1][8 * (s2 & 1) + 3]);         \
      pk.z = pack2(CUR[s2 >> 1][8 * (s2 & 1) + 4], CUR[s2 >> 1][8 * (s2 & 1) + 5]);         \
      pk.w = pack2(CUR[s2 >> 1][8 * (s2 & 1) + 6], CUR[s2 >> 1][8 * (s2 & 1) + 7]);         \
      const bf16x8 pf = __builtin_bit_cast(bf16x8, pk);                                     \
      _Pragma("unroll") for (int dt = 0; dt < 2; ++dt) {                                    \
        const bf16x8 vf = *(const bf16x8*)(sm + (2 + (t_ & 1)) * 64 * AP + (dt * 32 + r) * AP + s2 * 16 + h * 8); \
        o[dt] = MFMA32(vf, pf, o[dt]);                                                      \
      }                                                                                     \
    }                                                                                       \
    if (t_ + 2 < 64) { ATT_STOREK(RKW, t_ & 1) }                                            \
    if (t_ + 1 < 64) { ATT_STOREV(RVW, (t_ + 1) & 1) }                                      \
    __syncthreads();                                                                        \
  }
  for (int t = 0; t < 64; t += 2) {
    ATT_STEP(sa, sb, t, rkA, rvA, rkB, rvB)
    ATT_STEP(sb, sa, t + 1, rkB, rvB, rkA, rvA)
  }
#undef ATT_STEP
#undef ATT_QK
#undef ATT_LOADK
#undef ATT_LOADV
#undef ATT_STOREK
#undef ATT_STOREV
  lsum += __shfl_xor(lsum, 32);
  const float il = 1.f / lsum;
  u16* op = p.attn + ((size_t)bi * SEQ + q0 + r) * 512 + head * 64 + 4 * h;
#pragma unroll
  for (int dt = 0; dt < 2; ++dt)
#pragma unroll
    for (int g = 0; g < 4; ++g) {
      u32x2 v; v.x = pack2(o[dt][4 * g] * il, o[dt][4 * g + 1] * il); v.y = pack2(o[dt][4 * g + 2] * il, o[dt][4 * g + 3] * il);
      *(u32x2*)(op + dt * 32 + 8 * g) = v;
    }
}

constexpr int HQP = 136;
constexpr int HSP = 72;
constexpr int H_QM = 0;
constexpr int H_KM = H_QM + 64 * HQP * 2;
constexpr int H_KUT = H_KM + 64 * HQP * 2;
constexpr int H_IT = H_KUT + 128 * HSP * 2;
constexpr int H_F32 = H_IT + 128 * HSP * 2;
constexpr int HG_LDS = H_F32 + 7 * 128 * 4;

__device__ void hgrn_item(const Params& p, char* smem, int item) {
  const int tid = threadIdx.x, lane = tid & 63, w = __builtin_amdgcn_readfirstlane(tid >> 6), r = lane & 31, h = lane >> 5;
  const int dir = item & 1, hh = (item >> 1) & 3, bi = item >> 3;
  u16* QM = (u16*)(smem + H_QM);
  u16* KM = (u16*)(smem + H_KM);
  u16* AM = (u16*)(smem + H_KM);
  u16* KUT = (u16*)(smem + H_KUT);
  u16* IT = (u16*)(smem + H_IT);
  float* tot = (float*)(smem + H_F32);
  float* first2 = tot + 512;
  float* emid = tot + 640;
  float* dec = tot + 768;
  const u16* lf = dir ? p.lfb : p.lff;
  u16* og = dir ? p.ob : p.of;
  const int kp = lane;
  const int k16 = (2 * kp) & 15, grp = k16 >> 2;
  const int pk0 = ((2 * kp) & ~15) | ((grp == 1 ? 2 : grp == 2 ? 1 : grp) << 2) | ((2 * kp) & 3);
  const int tp = tid & 31, vc = (tid >> 5) * 16;
  f32x16 S[4];
#pragma unroll
  for (int a = 0; a < 4; ++a)
#pragma unroll
    for (int i = 0; i < 16; ++i) S[a][i] = 0.f;
  const size_t colb = (size_t)hh * 128;
  const unsigned olane = (unsigned)((dir ? 4 - 4 * h : 4 * h) * 1024 + (hh * 128 + w * 32 + r) * 2);
  uint32_t lgv[16], qv[16];
#define HG_LOAD(C)                                                                                   \
  {                                                                                                  \
    const int s0_ = dir ? SEQ - 64 * ((C) + 1) : 64 * (C);                                           \
    const size_t tb_ = (size_t)bi * SEQ + s0_;                                                       \
    _Pragma("unroll") for (int e = 0; e < 16; ++e) {                                                 \
      const int tau = 16 * w + e;                                                                    \
      const size_t tok = tb_ + (dir ? 63 - tau : tau);                                               \
      lgv[e] = *(const uint32_t*)((const char*)(lf + tok * 512 + colb) + (unsigned)(kp * 4));        \
      qv[e] = *(const uint32_t*)((const char*)(p.hq + tok * 512 + colb) + (unsigned)(kp * 4));       \
    }                                                                                                \
  }
  HG_LOAD(0)
  __syncthreads();
  for (int c0 = 0; c0 < 64 * (1 + PROBE_HG); ++c0) {
    const int c = c0 & 63;
#if PROBE_HG
    if (c0 == 64) {
#pragma unroll
      for (int a = 0; a < 4; ++a)
#pragma unroll
        for (int i = 0; i < 16; ++i) S[a][i] = 0.f;
    }
#endif
    const int s0 = dir ? SEQ - 64 * (c + 1) : 64 * c;
    const size_t tb = (size_t)bi * SEQ + s0;
    const size_t tok0 = tb + (dir ? 63 - 2 * tp : 2 * tp), tok1 = tb + (dir ? 62 - 2 * tp : 2 * tp + 1);
    const u32x4 ia0 = *(const u32x4*)(p.hi + tok0 * 512 + colb + vc), ia1 = *(const u32x4*)(p.hi + tok0 * 512 + colb + vc + 8);
    const u32x4 ib0 = *(const u32x4*)(p.hi + tok1 * 512 + colb + vc), ib1 = *(const u32x4*)(p.hi + tok1 * 512 + colb + vc + 8);
    {
      float2 run = make_float2(0.f, 0.f);
#pragma unroll
      for (int e = 0; e < 16; ++e) { run.x += h2f_lo(lgv[e]); run.y += h2f_hi(lgv[e]); }
      *(float2*)(tot + w * 128 + 2 * kp) = run;
      if (w == 2) *(float2*)(first2 + 2 * kp) = make_float2(h2f_lo(lgv[0]), h2f_hi(lgv[0]));
    }
    __syncthreads();
    {
      const float2 t0 = *(const float2*)(tot + 2 * kp), t1 = *(const float2*)(tot + 128 + 2 * kp);
      const float2 t2 = *(const float2*)(tot + 256 + 2 * kp), t3 = *(const float2*)(tot + 384 + 2 * kp);
      const float2 f2 = *(const float2*)(first2 + 2 * kp);
      float2 pre = make_float2(0.f, 0.f);
      if (w > 0) { pre.x += t0.x; pre.y += t0.y; }
      if (w > 1) { pre.x += t1.x; pre.y += t1.y; }
      if (w > 2) { pre.x += t2.x; pre.y += t2.y; }
      const float2 bmid = make_float2(t0.x + t1.x + f2.x, t0.y + t1.y + f2.y);
      const float2 blast = make_float2(t0.x + t1.x + t2.x + t3.x, t0.y + t1.y + t2.y + t3.y);
      const float ccx = fast_exp2(blast.x - bmid.x), ccy = fast_exp2(blast.y - bmid.y);
      uint32_t kux[8], kuy[8];
      float pkx = 0.f, pky = 0.f;
      float2 run = make_float2(pre.x - bmid.x, pre.y - bmid.y);
#pragma unroll
      for (int e = 0; e < 16; ++e) {
        const float lgx = h2f_lo(lgv[e]), lgy = h2f_hi(lgv[e]);
        run.x += lgx; run.y += lgy;
        const float rx = run.x, ry = run.y;
        const float e1x = fast_exp2(rx), e1y = fast_exp2(ry), e2x = fast_exp2(-rx), e2y = fast_exp2(-ry);
        const float gx = 1.f - fast_exp2(lgx), gy = 1.f - fast_exp2(lgy);
        const float qx = __uint_as_float(qv[e] << 16), qy = __uint_as_float(qv[e] & 0xffff0000u);
        const float kmx = gx * e2x, kmy = gy * e2y;
        const int t = 16 * w + e;
        *(uint32_t*)(QM + t * HQP + pk0) = pack2(qx * e1x, qy * e1y);
        *(uint32_t*)(KM + t * HQP + pk0) = pack2(kmx, kmy);
        if (e & 1) { kux[e >> 1] = pack2(pkx, kmx * ccx); kuy[e >> 1] = pack2(pky, kmy * ccy); }
        else { pkx = kmx * ccx; pky = kmy * ccy; }
      }
      u32x4* d0 = (u32x4*)(KUT + (2 * kp) * HSP + 16 * w);
      u32x4* d1 = (u32x4*)(KUT + (2 * kp + 1) * HSP + 16 * w);
      u32x4 v;
      v.x = kux[0]; v.y = kux[1]; v.z = kux[2]; v.w = kux[3]; d0[0] = v;
      v.x = kux[4]; v.y = kux[5]; v.z = kux[6]; v.w = kux[7]; d0[1] = v;
      v.x = kuy[0]; v.y = kuy[1]; v.z = kuy[2]; v.w = kuy[3]; d1[0] = v;
      v.x = kuy[4]; v.y = kuy[5]; v.z = kuy[6]; v.w = kuy[7]; d1[1] = v;
      if (w == 0) {
        *(float2*)(emid + 2 * kp) = make_float2(fast_exp2(bmid.x), fast_exp2(bmid.y));
        *(float2*)(dec + 2 * kp) = make_float2(fast_exp2(blast.x), fast_exp2(blast.y));
      }
    }
    {
      uint32_t* d = (uint32_t*)(IT + vc * HSP + 2 * tp);
#pragma unroll
      for (int j = 0; j < 4; ++j) {
        d[(2 * j) * (HSP / 2)] = (ia0[j] & 0xffffu) | (ib0[j] << 16);
        d[(2 * j + 1) * (HSP / 2)] = (ia0[j] >> 16) | (ib0[j] & 0xffff0000u);
        d[(8 + 2 * j) * (HSP / 2)] = (ia1[j] & 0xffffu) | (ib1[j] << 16);
        d[(8 + 2 * j + 1) * (HSP / 2)] = (ia1[j] >> 16) | (ib1[j] & 0xffff0000u);
      }
    }
    __syncthreads();
    if (c0 + 1 < 64 * (1 + PROBE_HG)) HG_LOAD((c + 1) & 63)
    {
      const int ti = w >> 1, si = w & 1;
      f32x16 d;
#pragma unroll
      for (int i = 0; i < 16; ++i) d[i] = 0.f;
      if (w != 1) {
#pragma unroll
        for (int ks = 0; ks < 8; ++ks) {
          const bf16x8 af = *(const bf16x8*)(KM + (si * 32 + r) * HQP + ks * 16 + h * 8);
          const bf16x8 bf = *(const bf16x8*)(QM + (ti * 32 + r) * HQP + ks * 16 + h * 8);
          d = MFMA32(af, bf, d);
        }
      }
      __syncthreads();
      const int t = ti * 32 + r;
#pragma unroll
      for (int g = 0; g < 4; ++g) {
        const int sb = si * 32 + 8 * g + 4 * h;
        u32x2 v;
        v.x = pack2(sb + 0 <= t ? d[4 * g + 0] : 0.f, sb + 1 <= t ? d[4 * g + 1] : 0.f);
        v.y = pack2(sb + 2 <= t ? d[4 * g + 2] : 0.f, sb + 3 <= t ? d[4 * g + 3] : 0.f);
        *(u32x2*)(AM + t * HSP + sb) = v;
      }
    }
    __syncthreads();
    {
      f32x16 oa0, oa1;
#pragma unroll
      for (int i = 0; i < 16; ++i) { oa0[i] = 0.f; oa1[i] = 0.f; }
#pragma unroll
      for (int s4 = 0; s4 < 4; ++s4) {
        const bf16x8 ifr = *(const bf16x8*)(IT + (w * 32 + r) * HSP + 16 * s4 + 8 * h);
        const bf16x8 am1 = *(const bf16x8*)(AM + (32 + r) * HSP + 16 * s4 + 8 * h);
        oa1 = MFMA32(am1, ifr, oa1);
        if (s4 < 2) {
          const bf16x8 am0 = *(const bf16x8*)(AM + r * HSP + 16 * s4 + 8 * h);
          oa0 = MFMA32(am0, ifr, oa0);
        }
      }
#pragma unroll
      for (int ks = 0; ks < 8; ++ks) {
        const int kt4 = ks >> 1, hf = ks & 1;
        const float4 ea = *(const float4*)(emid + kt4 * 32 + 16 * hf + 4 * h);
        const float4 eb = *(const float4*)(emid + kt4 * 32 + 16 * hf + 8 + 4 * h);
        u32x4 pk;
        pk.x = pack2(S[kt4][8 * hf + 0] * ea.x, S[kt4][8 * hf + 1] * ea.y);
        pk.y = pack2(S[kt4][8 * hf + 2] * ea.z, S[kt4][8 * hf + 3] * ea.w);
        pk.z = pack2(S[kt4][8 * hf + 4] * eb.x, S[kt4][8 * hf + 5] * eb.y);
        pk.w = pack2(S[kt4][8 * hf + 6] * eb.z, S[kt4][8 * hf + 7] * eb.w);
        const bf16x8 sp = __builtin_bit_cast(bf16x8, pk);
        const bf16x8 qf0 = *(const bf16x8*)(QM + r * HQP + ks * 16 + 8 * h);
        const bf16x8 qf1 = *(const bf16x8*)(QM + (32 + r) * HQP + ks * 16 + 8 * h);
        oa0 = MFMA32(qf0, sp, oa0);
        oa1 = MFMA32(qf1, sp, oa1);
      }
      char* ogb = (char*)og + olane;
#pragma unroll
      for (int i = 0; i < 16; ++i) {
        const int ci = (i & 3) + 8 * (i >> 2);
        const size_t r0 = dir ? tb + 59 - ci : tb + ci;
        const size_t r1 = dir ? tb + 27 - ci : tb + 32 + ci;
        *(u16*)(ogb + r0 * 1024) = f2bf(oa0[i]);
        *(u16*)(ogb + r1 * 1024) = f2bf(oa1[i]);
      }
    }
#pragma unroll
    for (int kt4 = 0; kt4 < 4; ++kt4) {
#pragma unroll
      for (int g = 0; g < 4; ++g) {
        const float4 dd = *(const float4*)(dec + kt4 * 32 + 8 * g + 4 * h);
        S[kt4][4 * g + 0] *= dd.x; S[kt4][4 * g + 1] *= dd.y; S[kt4][4 * g + 2] *= dd.z; S[kt4][4 * g + 3] *= dd.w;
      }
    }
#pragma unroll
    for (int s4 = 0; s4 < 4; ++s4) {
      const bf16x8 ifr = *(const bf16x8*)(IT + (w * 32 + r) * HSP + 16 * s4 + 8 * h);
#pragma unroll
      for (int kt4 = 0; kt4 < 4; ++kt4) {
        const bf16x8 kf = *(const bf16x8*)(KUT + (kt4 * 32 + r) * HSP + 16 * s4 + 8 * h);
        S[kt4] = MFMA32(kf, ifr, S[kt4]);
      }
    }
    __syncthreads();
  }
#undef HG_LOAD
}

__global__ __launch_bounds__(256) void naive_attn(Params p) {
  const int gid = blockIdx.x * 256 + threadIdx.x;
  const int s = gid & 4095, bh = gid >> 12, head = bh & 7, bi = bh >> 3, kvh = head >> 2;
  float qv[64], acc[64];
  const u16* qp = p.q + ((size_t)(bi * 8 + head) * SEQ + s) * 64;
#pragma unroll
  for (int d = 0; d < 64; ++d) { qv[d] = bf2f(qp[d]); acc[d] = 0.f; }
  float mx = -INFINITY, l = 0.f;
  const u16* kp = p.k + (size_t)(bi * 2 + kvh) * SEQ * 64;
  const u16* vp = p.vT + (size_t)(bi * 2 + kvh) * 64 * SEQ;
  for (int key = 0; key < SEQ; ++key) {
    float sc = 0.f;
#pragma unroll
    for (int d = 0; d < 64; ++d) sc += qv[d] * bf2f(kp[(size_t)key * 64 + d]);
    const float mn = fmaxf(mx, sc);
    const float al = exp2f(mx - mn), pp = exp2f(sc - mn);
    l = l * al + pp;
#pragma unroll
    for (int d = 0; d < 64; ++d) acc[d] = acc[d] * al + pp * bf2f(vp[(size_t)d * SEQ + key]);
    mx = mn;
  }
  const float il = 1.f / l;
  u16* op = p.attn + ((size_t)bi * SEQ + s) * 512 + head * 64;
#pragma unroll
  for (int d = 0; d < 64; ++d) op[d] = f2bf(acc[d] * il);
}

__global__ __launch_bounds__(1024) void naive_hgrn(Params p) {
  __shared__ float red[8][128];
  const int dir = blockIdx.x & 1, hh = (blockIdx.x >> 1) & 3, bi = blockIdx.x >> 3;
  const int v = threadIdx.x & 127, kq = threadIdx.x >> 7;
  float S[16];
#pragma unroll
  for (int i = 0; i < 16; ++i) S[i] = 0.f;
  const u16* lf = dir ? p.lfb : p.lff;
  u16* o = dir ? p.ob : p.of;
  for (int step = 0; step < SEQ; ++step) {
    const int s = dir ? SEQ - 1 - step : step;
    const size_t base = ((size_t)bi * SEQ + s) * 512 + hh * 128;
    const float iv = bf2f(p.hi[base + v]);
    float part = 0.f;
#pragma unroll
    for (int kk = 0; kk < 16; ++kk) {
      const int k = kq * 16 + kk;
      const float lg = (float)__builtin_bit_cast(_Float16, lf[base + k]);
      const float f = exp2f(lg), g = 1.f - f;
      const float qk = bf2f(p.hq[base + k]);
      S[kk] = f * S[kk] + g * iv;
      part += S[kk] * qk;
    }
    red[kq][v] = part;
    __syncthreads();
    if (kq == 0) {
      float t = 0.f;
#pragma unroll
      for (int j = 0; j < 8; ++j) t += red[j][v];
      o[base + v] = f2bf(t);
    }
    __syncthreads();
  }
}

DI void unpack8(const uint4 u, float (&v)[8]) {
  v[0] = __uint_as_float(u.x << 16); v[1] = __uint_as_float(u.x & 0xffff0000u);
  v[2] = __uint_as_float(u.y << 16); v[3] = __uint_as_float(u.y & 0xffff0000u);
  v[4] = __uint_as_float(u.z << 16); v[5] = __uint_as_float(u.z & 0xffff0000u);
  v[6] = __uint_as_float(u.w << 16); v[7] = __uint_as_float(u.w & 0xffff0000u);
}
__device__ void phase_mix(const Params& p, int bid, int nblk) {
  const int lane = threadIdx.x & 63, w = threadIdx.x >> 6;
  u16* mix = p.mix;
  float wa[8], wh[8];
#pragma unroll
  for (int e = 0; e < 8; ++e) { wa[e] = p.attn_norm_w[lane * 8 + e]; wh[e] = p.hg_norm_w[(lane & 15) * 8 + e]; }
  const int stride = nblk * 4;
  for (int m0 = bid * 4 + w; m0 < MTOK; m0 += 4 * stride) {
    uint4 ua[4], ug[4], u1[4], u2[4], uh[4];
#pragma unroll
    for (int u = 0; u < 4; ++u) {
      const int m = m0 + u * stride;
      if (m < MTOK) {
        const size_t rb = (size_t)m * 512 + lane * 8;
        ua[u] = *(const uint4*)(p.attn + rb); ug[u] = *(const uint4*)(p.ga + rb);
        u1[u] = *(const uint4*)(p.of + rb); u2[u] = *(const uint4*)(p.ob + rb); uh[u] = *(const uint4*)(p.gh + rb);
      }
    }
#pragma unroll
    for (int u = 0; u < 4; ++u) {
      const int m = m0 + u * stride;
      if (m < MTOK) {
        float a[8], g[8], f1[8], f2[8];
        unpack8(ua[u], a); unpack8(ug[u], g);
        float ss = 0.f;
#pragma unroll
        for (int e = 0; e < 8; ++e) ss += a[e] * a[e];
#pragma unroll
        for (int o = 32; o >= 1; o >>= 1) ss += __shfl_xor(ss, o);
        float rstd = rsqrtf(ss * (1.f / 512.f) + 1e-6f);
        float r[8];
#pragma unroll
        for (int e = 0; e < 8; ++e) r[e] = a[e] * rstd * wa[e] * g[e];
        uint4 o1; o1.x = pack2(r[0], r[1]); o1.y = pack2(r[2], r[3]); o1.z = pack2(r[4], r[5]); o1.w = pack2(r[6], r[7]);
        *(uint4*)(mix + (size_t)m * 1024 + lane * 8) = o1;
        unpack8(u1[u], f1); unpack8(u2[u], f2); unpack8(uh[u], g);
        ss = 0.f;
#pragma unroll
        for (int e = 0; e < 8; ++e) { a[e] = f1[e] + f2[e]; ss += a[e] * a[e]; }
#pragma unroll
        for (int o = 8; o >= 1; o >>= 1) ss += __shfl_xor(ss, o);
        rstd = rsqrtf(ss * (1.f / 128.f) + 1e-6f);
#pragma unroll
        for (int e = 0; e < 8; ++e) r[e] = a[e] * rstd * wh[e] * g[e];
        o1.x = pack2(r[0], r[1]); o1.y = pack2(r[2], r[3]); o1.z = pack2(r[4], r[5]); o1.w = pack2(r[6], r[7]);
        *(uint4*)(mix + (size_t)m * 1024 + 512 + lane * 8) = o1;
      }
    }
  }
}

__device__ void phase3(const Params& p, char* smem, int bid, int nblk, const XMap xm) {
  const int lane = threadIdx.x & 63, w = threadIdx.x >> 6;
  const int wn = w & 1, wm = w >> 1;
  const int r0 = lane & 31, h0 = lane >> 5;
  const int ntiles = xm.xcc >= 0 ? 256 : (MTOK / 128) * 8;
  const int tstep = xm.xcc >= 0 ? xm.nloc : nblk;
  const int tend = ntiles * (1 + PROBE_P3);
  auto coords = [&](int tile0, int& mt, int& nt) {
    const int tile = tile0 >= ntiles ? tile0 - ntiles : tile0;
    if (xm.xcc >= 0) { const int c = tile >> 6, q = tile & 63; mt = xm.xcc * 32 + c * 8 + (q >> 3); nt = q & 7; }
    else { mt = tile >> 3; nt = tile & 7; }
  };
  u32x4 ra0[4], rb0[4], ra1[4], rb1[4];
  int tile0 = xm.xcc >= 0 ? xm.rank : bid;
  int mt = 0, nt = 0;
  if (tile0 < tend) { coords(tile0, mt, nt); gemm_issue(p.woutT, p.mix, nt * 128, mt * 128, ra0, rb0, ra1, rb1); }
  while (tile0 < tend) {
    f32x16 acc[2][2];
    gemm_run(p.woutT, p.mix, nt * 128, mt * 128, smem, acc, ra0, rb0, ra1, rb1);
    const int mt_c = mt, nt_c = nt;
    tile0 += tstep;
    if (tile0 < tend) { coords(tile0, mt, nt); gemm_issue(p.woutT, p.mix, nt * 128, mt * 128, ra0, rb0, ra1, rb1); }
    {
    const int mt = mt_c, nt = nt_c;
    int r = r0, h = h0;
    asm volatile("" : "+v"(r), "+v"(h));
    float* T = (float*)smem;
#pragma unroll
    for (int b = 0; b < 2; ++b) {
      float* trow = T + (wm * 64 + b * 32 + r) * EPF + wn * 64 + 4 * h;
#pragma unroll
      for (int a = 0; a < 2; ++a)
#pragma unroll
        for (int g = 0; g < 4; ++g) {
          float4 o;
          o.x = acc[a][b][4 * g + 0]; o.y = acc[a][b][4 * g + 1]; o.z = acc[a][b][4 * g + 2]; o.w = acc[a][b][4 * g + 3];
          *(float4*)(trow + a * 32 + 8 * g) = o;
        }
    }
    __syncthreads();
    {
      const int tid = threadIdx.x;
      const int ch = tid & 31, rw = tid >> 5;
      const size_t gofs = (size_t)(mt * 128) * 1024 + nt * 128 + ch * 4;
#pragma unroll
      for (int j0 = 0; j0 < 16; j0 += 4) {
        float4 xv[4];
#pragma unroll
        for (int u = 0; u < 4; ++u) xv[u] = *(const float4*)(p.x + gofs + (size_t)((j0 + u) * 8 + rw) * 1024);
#pragma unroll
        for (int u = 0; u < 4; ++u) {
          const int row = (j0 + u) * 8 + rw;
          const float4 y = *(const float4*)(T + row * EPF + ch * 4);
          float4 o;
          o.x = DN_ALPHA * xv[u].x + y.x; o.y = DN_ALPHA * xv[u].y + y.y; o.z = DN_ALPHA * xv[u].z + y.z; o.w = DN_ALPHA * xv[u].w + y.w;
          *(float4*)(p.z + gofs + (size_t)row * 1024) = o;
        }
      }
    }
    }
  }
}

__device__ void phase4(const Params& p, int bid, int nblk) {
  const int lane = threadIdx.x & 63, w = threadIdx.x >> 6;
  const int stride = nblk * 4;
  for (int m0 = bid * 4 + w; m0 < MTOK; m0 += 4 * stride) {
    float4 v[4][4];
#pragma unroll
    for (int u = 0; u < 4; ++u) {
      const int m = m0 + u * stride;
      if (m < MTOK) {
        const float4* row = (const float4*)(p.z + (size_t)m * 1024);
#pragma unroll
        for (int j = 0; j < 4; ++j) v[u][j] = row[lane + 64 * j];
      }
    }
#pragma unroll
    for (int u = 0; u < 4; ++u) {
      const int m = m0 + u * stride;
      if (m < MTOK) {
        float4* row = (float4*)(p.out + (size_t)m * 1024);
        float s = 0.f;
#pragma unroll
        for (int j = 0; j < 4; ++j) s += v[u][j].x + v[u][j].y + v[u][j].z + v[u][j].w;
#pragma unroll
        for (int o = 32; o >= 1; o >>= 1) s += __shfl_xor(s, o);
        const float mu = s * (1.f / 1024.f);
        float q = 0.f;
#pragma unroll
        for (int j = 0; j < 4; ++j) {
          v[u][j].x -= mu; v[u][j].y -= mu; v[u][j].z -= mu; v[u][j].w -= mu;
          q += v[u][j].x * v[u][j].x + v[u][j].y * v[u][j].y + v[u][j].z * v[u][j].z + v[u][j].w * v[u][j].w;
        }
#pragma unroll
        for (int o = 32; o >= 1; o >>= 1) q += __shfl_xor(q, o);
        const float rstd = rsqrtf(q * (1.f / 1024.f) + 1e-5f);
#pragma unroll
        for (int j = 0; j < 4; ++j) {
          const float4 wv = ((const float4*)p.ln_w)[lane + 64 * j], bv = ((const float4*)p.ln_b)[lane + 64 * j];
          float4 o;
          o.x = v[u][j].x * rstd * wv.x + bv.x; o.y = v[u][j].y * rstd * wv.y + bv.y;
          o.z = v[u][j].z * rstd * wv.z + bv.z; o.w = v[u][j].w * rstd * wv.w + bv.w;
          row[lane + 64 * j] = o;
        }
      }
    }
  }
}


#define XB_TMO      128
#define XB_XCNT(j)  (256  + 64 * (j))
#define XB_XSUB(j)  (1280 + 64 * (j))
#define XB_XGEN(j)  (2304 + 64 * (j))
#define XB_TOP      3328
#define XB_TOPGEN   3392
#define XCD_BAR_WORDS 3456
#define XB_SPIN_CAP (1u << 18)
#define LAS __attribute__((address_space(3)))
DI unsigned xb_ld(unsigned* p) { return __hip_atomic_load(p, __ATOMIC_RELAXED, __HIP_MEMORY_SCOPE_AGENT); }
DI unsigned xb_add(unsigned* p, unsigned v) { return __hip_atomic_fetch_add(p, v, __ATOMIC_RELAXED, __HIP_MEMORY_SCOPE_AGENT); }
DI unsigned xb_xcc_id() { return (unsigned)__builtin_amdgcn_s_getreg((3 << 11) | 20) & 0xFu; }
#define XB_SPIN(cond, bar) do { unsigned _sp = 0; while (cond) { __builtin_amdgcn_s_sleep(1); \
    if ((++_sp & 255u) == 0u) { if (xb_ld(&(bar)[XB_TMO])) break; if (_sp > XB_SPIN_CAP) { atomicAdd(&(bar)[XB_TMO], 1u); break; } } } } while (0)
struct XcdBarrier { unsigned* bar; unsigned x; volatile LAS unsigned* st; };
DI XcdBarrier xcd_barrier_post(unsigned* bar, volatile LAS unsigned* st, unsigned& rank) {
  XcdBarrier b; b.bar = bar; b.x = xb_xcc_id(); b.st = st;
  rank = 0u;
  if (threadIdx.x == 0) rank = xb_add(&bar[XB_XCNT(b.x)], 1u);
  return b;
}
DI void xcd_barrier_complete(unsigned* bar, unsigned x, unsigned& nloc, unsigned& nx) {
  const unsigned G = gridDim.x * gridDim.y * gridDim.z;
  unsigned sum, cnt, mine, sp = 0u;
  for (;;) {
    sum = 0u; cnt = 0u; mine = 0u;
#pragma unroll
    for (unsigned j = 0; j < 16; ++j) { const unsigned c = xb_ld(&bar[XB_XCNT(j)]); sum += c; cnt += (c > 0u) ? 1u : 0u; mine = (j == x) ? c : mine; }
    if (sum == G) break;
    __builtin_amdgcn_s_sleep(1);
    if ((++sp & 255u) == 0u) { if (xb_ld(&bar[XB_TMO])) break; if (sp > XB_SPIN_CAP) { atomicAdd(&bar[XB_TMO], 1u); break; } }
  }
  nloc = mine > 0u ? mine : 1u; nx = cnt > 0u ? cnt : 1u;
}
DI void xcd_barrier(const XcdBarrier& b) {
  asm volatile("s_waitcnt vmcnt(0)" ::: "memory");
  __syncthreads();
  if (threadIdx.x == 0) {
    unsigned* bar = b.bar;
    __builtin_amdgcn_s_waitcnt(0);
    unsigned nloc = b.st[0], nx = b.st[1];
    if (nloc == 0u) { xcd_barrier_complete(bar, b.x, nloc, nx); b.st[0] = nloc; b.st[1] = nx; }
    const unsigned old = xb_add(&bar[XB_XSUB(b.x)], 1u);
    const unsigned gen = old / nloc;
    if (old + 1u == (gen + 1u) * nloc) {
      __builtin_amdgcn_fence(__ATOMIC_RELEASE, "agent");
      asm volatile("s_waitcnt vmcnt(0)" ::: "memory");
      const unsigned og = xb_add(&bar[XB_TOP], 1u);
      const unsigned tg = og / nx;
      if (og + 1u == (tg + 1u) * nx) xb_add(&bar[XB_TOPGEN], 1u);
      else XB_SPIN(xb_ld(&bar[XB_TOPGEN]) == tg, bar);
      __builtin_amdgcn_fence(__ATOMIC_ACQUIRE, "agent");
      xb_add(&bar[XB_XGEN(b.x)], 1u);
      asm volatile("s_waitcnt vmcnt(0)" ::: "memory");
    } else {
      XB_SPIN(xb_ld(&bar[XB_XGEN(b.x)]) == gen, bar);
      __builtin_amdgcn_fence(__ATOMIC_ACQUIRE, "agent");
      asm volatile("s_waitcnt vmcnt(0)" ::: "memory");
    }
  }
  __syncthreads();
}

constexpr int MEGA_LDS = HG_LDS > GEMM_LDS ? HG_LDS : GEMM_LDS;
__global__ void __launch_bounds__(256, 2) mega_kernel(Params p) {
  __shared__ __attribute__((aligned(16))) char smem[MEGA_LDS];
  __shared__ uint4 xb_words;
  __shared__ int s_item;
  __shared__ int s_xm[4];
  cg::grid_group grid = cg::this_grid();
  const int bid = blockIdx.x, nblk = gridDim.x;
  if (threadIdx.x == 0) xb_words = make_uint4(0u, 0u, 0u, 0u);
  __syncthreads();
  unsigned my_rank;
  XcdBarrier xb = xcd_barrier_post(p.bar, (volatile LAS unsigned*)&xb_words, my_rank);
  if (p.out == nullptr) grid.sync();
  phase0(p, smem, bid, nblk);
#if PROBE_P0
  phase0(p, smem, bid, nblk);
#endif
  xcd_barrier(xb);
  if (threadIdx.x == 0) {
    unsigned sum = 0;
#pragma unroll
    for (int j = 0; j < 8; ++j) sum += xb_ld(&p.bar[XB_XCNT(j)]);
    const bool ok = sum == (unsigned)nblk && xb.x < 8u && xb_words.y == 8u;
    s_xm[0] = ok ? (int)xb.x : -1; s_xm[1] = (int)my_rank; s_xm[2] = (int)xb_words.x;
  }
  __syncthreads();
  XMap xm; xm.xcc = s_xm[0]; xm.rank = s_xm[1]; xm.nloc = s_xm[2];
  phase1(p, smem, bid, nblk, xm);
  xcd_barrier(xb);
  for (int it = bid; it < 64; it += nblk) hgrn_item(p, smem, it);
  for (;;) {
    __syncthreads();
    if (threadIdx.x == 0) s_item = atomicAdd(p.ctr, 1);
    __syncthreads();
    const int it = __builtin_amdgcn_readfirstlane(s_item);
    if (it >= 2048 * (1 + PROBE_AT)) break;
    attn_item(p, smem, it & 2047);
  }
  xcd_barrier(xb);
  phase_mix(p, bid, nblk);
#if PROBE_MIX
  phase_mix(p, bid, nblk);
#endif
  xcd_barrier(xb);
  phase3(p, smem, bid, nblk, xm);
  xcd_barrier(xb);
  phase4(p, bid, nblk);
}

__global__ __launch_bounds__(256) void k_phase0(Params p) { __shared__ __attribute__((aligned(16))) char smem[64 * 65 * 4]; phase0(p, smem, blockIdx.x, gridDim.x); }
__global__ __launch_bounds__(256) void k_phase1(Params p) { __shared__ __attribute__((aligned(16))) char smem[GEMM_LDS]; XMap xm; xm.xcc = -1; xm.rank = 0; xm.nloc = 1; phase1(p, smem, blockIdx.x, gridDim.x, xm); }
__global__ __launch_bounds__(256) void k_attn(Params p) { __shared__ __attribute__((aligned(16))) char smem[ATT_LDS]; for (int it = blockIdx.x; it < 2048; it += gridDim.x) attn_item(p, smem, it); }
__global__ __launch_bounds__(256) void k_hgrn(Params p) { __shared__ __attribute__((aligned(16))) char smem[HG_LDS]; for (int it = blockIdx.x; it < 64; it += gridDim.x) hgrn_item(p, smem, it); }
__global__ __launch_bounds__(256) void k_mix(Params p) { phase_mix(p, blockIdx.x, gridDim.x); }
__global__ __launch_bounds__(256) void k_phase3(Params p) { __shared__ __attribute__((aligned(16))) char smem[GEMM_LDS]; XMap xm; xm.xcc = -1; xm.rank = 0; xm.nloc = 1; phase3(p, smem, blockIdx.x, gridDim.x, xm); }
__global__ __launch_bounds__(256) void k_phase4(Params p) { phase4(p, blockIdx.x, gridDim.x); }

extern "C" void kernel_launch(void* const* d_in, const int* in_sizes, int n_in, void* d_out, int out_size, void* d_ws, size_t ws_size,
                              hipStream_t stream) {
  Params p{};
  p.x = (const float*)d_in[0]; p.w_in = (const float*)d_in[1]; p.q_norm_w = (const float*)d_in[2]; p.k_norm_w = (const float*)d_in[3];
  p.attn_norm_w = (const float*)d_in[4]; p.lb_logits = (const float*)d_in[5]; p.hg_norm_w = (const float*)d_in[6];
  p.w_out = (const float*)d_in[7]; p.ln_w = (const float*)d_in[8]; p.ln_b = (const float*)d_in[9];
  p.out = (float*)d_out;
  char* ws = (char*)d_ws;
  size_t off = 0;
  auto take = [&](size_t bytes) { char* r = ws + off; off += (bytes + 255) & ~(size_t)255; return r; };
  p.xb = (u16*)take((size_t)MTOK * 1024 * 2);
  p.winT = (u16*)take((size_t)INW * 1024 * 2);
  p.woutT = (u16*)take((size_t)1024 * 1024 * 2);
  p.rope = (float2*)take(1024 * 8);
  p.lbv = (float*)take(1024 * 4);
  p.q = (u16*)take((size_t)MTOK * 512 * 2);
  p.k = (u16*)take((size_t)MTOK * 128 * 2);
  p.vT = (u16*)take((size_t)MTOK * 128 * 2);
  p.ga = (u16*)take((size_t)MTOK * 512 * 2);
  p.hq = (u16*)take((size_t)MTOK * 512 * 2);
  p.hi = (u16*)take((size_t)MTOK * 512 * 2);
  p.lff = (u16*)take((size_t)MTOK * 512 * 4);
  p.lfb = (u16*)take((size_t)MTOK * 512 * 4);
  p.gh = (u16*)take((size_t)MTOK * 512 * 2);
  p.attn = (u16*)take((size_t)MTOK * 512 * 2);
  p.of = (u16*)take((size_t)MTOK * 512 * 2);
  p.ob = (u16*)take((size_t)MTOK * 512 * 2);
  p.ctr = (int*)take(256);
  p.bar = (unsigned*)take(XCD_BAR_WORDS * 4);
  p.mix = p.hq;
  p.z = (float*)p.lff;
  if (off > ws_size) { fprintf(stderr, "workspace too small: need %zu have %zu\n", off, ws_size); return; }
#if ONE_LAUNCH
  static int grid_blocks = 0;
  if (!grid_blocks) {
    int dev = 0, cus = 0, per_cu = 0;
    hipGetDevice(&dev);
    hipDeviceGetAttribute(&cus, hipDeviceAttributeMultiprocessorCount, dev);
    hipOccupancyMaxActiveBlocksPerMultiprocessor(&per_cu, mega_kernel, 256, 0);
    if (per_cu > 2) per_cu = 2;
    grid_blocks = cus * per_cu;
    if (grid_blocks < 64) fprintf(stderr, "grid too small: %d\n", grid_blocks);
  }
  hipMemsetAsync(p.ctr, 0, 256 + ((XCD_BAR_WORDS * 4 + 255) & ~255), stream);
  void* args[] = {&p};
  hipError_t e = hipLaunchCooperativeKernel((void*)mega_kernel, dim3(grid_blocks), dim3(256), args, 0, stream);
  if (e != hipSuccess) fprintf(stderr, "cooperative launch failed: %s (grid %d)\n", hipGetErrorString(e), grid_blocks);
#else
  k_phase0<<<1024, 256, 0, stream>>>(p);
  k_phase1<<<512, 256, 0, stream>>>(p);
  k_attn<<<2048, 256, 0, stream>>>(p);
  k_hgrn<<<64, 256, 0, stream>>>(p);
  k_mix<<<2048, 256, 0, stream>>>(p);
  k_phase3<<<512, 256, 0, stream>>>(p);
  k_phase4<<<2048, 256, 0, stream>>>(p);
#endif
}
```

```cpp
#include <hip/hip_runtime.h>
#include <hip/hip_cooperative_groups.h>
#include <stdint.h>
#include <stdio.h>

namespace cg = cooperative_groups;

#ifndef ONE_LAUNCH
#define ONE_LAUNCH 1
#endif
#ifndef PROBE_P0
#define PROBE_P0 0
#endif
#ifndef PROBE_MIX
#define PROBE_MIX 0
#endif
#ifndef PROBE_P1
#define PROBE_P1 0
#endif
#ifndef PROBE_HG
#define PROBE_HG 0
#endif
#ifndef PROBE_AT
#define PROBE_AT 0
#endif
#ifndef PROBE_P3
#define PROBE_P3 0
#endif

typedef __attribute__((ext_vector_type(8))) short bf16x8;
typedef __attribute__((ext_vector_type(4))) short s16x4;
typedef __attribute__((ext_vector_type(16))) float f32x16;
typedef unsigned short u16;
typedef __attribute__((ext_vector_type(4))) unsigned u32x4;
typedef __attribute__((ext_vector_type(2))) unsigned u32x2;

#define DI __device__ __forceinline__
#define MFMA32(a, b, c) __builtin_amdgcn_mfma_f32_32x32x16_bf16((a), (b), (c), 0, 0, 0)

constexpr int MTOK = 32768;
constexpr int SEQ = 4096;
constexpr int DM = 1024;
constexpr int INW = 3840;
constexpr float Q_PRESCALE = 0.125f * 1.4426950408889634f;
constexpr float HQ_SCALE = 0.08838834764831845f;
constexpr float DN_ALPHA = 1.189207115002721f;

struct Params {
  const float* x; const float* w_in; const float* q_norm_w; const float* k_norm_w;
  const float* attn_norm_w; const float* lb_logits; const float* hg_norm_w; const float* w_out;
  const float* ln_w; const float* ln_b;
  float* out;
  u16* xb;
  u16* winT;
  u16* woutT;
  float2* rope;
  float* lbv;
  u16* q;
  u16* k;
  u16* vT;
  u16* ga;
  u16* hq;
  u16* hi;
  u16* lff;
  u16* lfb;
  u16* gh;
  u16* attn;
  u16* of;
  u16* ob;
  int* ctr;
  unsigned* bar;
  u16* mix;
  float* z;
};

DI u16 f2bf(float x) { uint32_t u = __float_as_uint(x); u += 0x7fffu + ((u >> 16) & 1u); return (u16)(u >> 16); }
DI float bf2f(u16 v) { return __uint_as_float(((uint32_t)v) << 16); }
typedef __attribute__((ext_vector_type(2))) float f32x2_t;
typedef __attribute__((ext_vector_type(2))) __bf16 bf16x2_t;
DI uint32_t pack2(float a, float b) { f32x2_t v = {a, b}; bf16x2_t r = __builtin_convertvector(v, bf16x2_t); return __builtin_bit_cast(uint32_t, r); }
typedef __attribute__((ext_vector_type(2))) _Float16 f16x2_t;
DI uint32_t pack2h(float a, float b) { f16x2_t r = {(_Float16)a, (_Float16)b}; return __builtin_bit_cast(uint32_t, r); }
DI float h2f_lo(uint32_t u) { return (float)__builtin_bit_cast(f16x2_t, u)[0]; }
DI float h2f_hi(uint32_t u) { return (float)__builtin_bit_cast(f16x2_t, u)[1]; }
DI int crow(int i, int h) { return (i & 3) + 8 * (i >> 2) + 4 * h; }
DI float silu_f(float v) { return v * __builtin_amdgcn_rcpf(1.f + __expf(-v)); }

__device__ void phase0(const Params& p, char* smem, int bid, int nblk) {
  const int tid = threadIdx.x;
  {
    const size_t nvec = (size_t)MTOK * DM / 8;
    const size_t T = (size_t)nblk * 256;
    for (size_t i = (size_t)bid * 256 + tid; i < nvec; i += 4 * T) {
      float4 a[4], b[4];
#pragma unroll
      for (int u = 0; u < 4; ++u) {
        const size_t ii = i + u * T;
        if (ii < nvec) { a[u] = ((const float4*)p.x)[2 * ii]; b[u] = ((const float4*)p.x)[2 * ii + 1]; }
      }
#pragma unroll
      for (int u = 0; u < 4; ++u) {
        const size_t ii = i + u * T;
        if (ii < nvec) {
          uint4 o; o.x = pack2(a[u].x, a[u].y); o.y = pack2(a[u].z, a[u].w); o.z = pack2(b[u].x, b[u].y); o.w = pack2(b[u].z, b[u].w);
          ((uint4*)p.xb)[ii] = o;
        }
      }
    }
  }
  {
    float* t = (float*)smem;
    const int ntile_in = 16 * 60, ntile_all = ntile_in + 16 * 16;
    for (int tile = bid; tile < ntile_all; tile += nblk) {
      const float* src; u16* dst; int N, kt, nt;
      if (tile < ntile_in) { src = p.w_in; dst = p.winT; N = INW; kt = tile / 60; nt = tile % 60; }
      else { int tt = tile - ntile_in; src = p.w_out; dst = p.woutT; N = DM; kt = tt / 16; nt = tt % 16; }
      __syncthreads();
#pragma unroll
      for (int j = 0; j < 4; ++j) {
        const int kk = (tid >> 4) + 16 * j, nn = (tid & 15) * 4;
        const float4 v = *(const float4*)(src + (size_t)(kt * 64 + kk) * N + nt * 64 + nn);
        t[kk * 65 + nn] = v.x; t[kk * 65 + nn + 1] = v.y; t[kk * 65 + nn + 2] = v.z; t[kk * 65 + nn + 3] = v.w;
      }
      __syncthreads();
      const int n = tid >> 2, kc = (tid & 3) * 16;
      uint32_t o[8];
#pragma unroll
      for (int j = 0; j < 8; ++j) o[j] = pack2(t[(kc + 2 * j) * 65 + n], t[(kc + 2 * j + 1) * 65 + n]);
      uint4* d = (uint4*)(dst + (size_t)(nt * 64 + n) * 1024 + kt * 64 + kc);
      d[0] = make_uint4(o[0], o[1], o[2], o[3]);
      d[1] = make_uint4(o[4], o[5], o[6], o[7]);
    }
  }
  for (int i = bid * 256 + tid; i < 2048; i += nblk * 256) {
    if (i < 1024) {
      const int pos = i >> 4, j = i & 15;
      const float inv = powf(10000.f, -(float)(2 * j) / 32.f);
      const float ang = (float)pos * inv;
      p.rope[i] = make_float2(cosf(ang), sinf(ang));
    } else {
      const int ii = i - 1024, dir = ii >> 9, wcol = ii & 511;
      const float l0 = p.lb_logits[(dir * 2 + 0) * 512 + wcol], l1 = p.lb_logits[(dir * 2 + 1) * 512 + wcol];
      const float mx = fmaxf(l0, l1);
      const float e0 = expf(l0 - mx), e1 = expf(l1 - mx);
      p.lbv[ii] = e0 / (e0 + e1);
    }
  }
}

constexpr int GP = 72;
constexpr int EP = 136;
constexpr int EPF = 132;
constexpr int GEMM_LDS = 2 * 2 * 128 * GP * 2;

DI void gemm_issue(const u16* __restrict__ A, const u16* __restrict__ B, int n0, int m0,
                   u32x4 (&ra0)[4], u32x4 (&rb0)[4], u32x4 (&ra1)[4], u32x4 (&rb1)[4]) {
  const int tid = threadIdx.x;
  const int lc = tid & 7, lr = tid >> 3;
  const u16* gA = A + (size_t)(n0 + lr) * 1024 + lc * 8;
  const u16* gB = B + (size_t)(m0 + lr) * 1024 + lc * 8;
#pragma unroll
  for (int j = 0; j < 4; ++j) { ra0[j] = *(const u32x4*)(gA + (size_t)j * 32 * 1024); rb0[j] = *(const u32x4*)(gB + (size_t)j * 32 * 1024); }
#pragma unroll
  for (int j = 0; j < 4; ++j) { ra1[j] = *(const u32x4*)(gA + (size_t)j * 32 * 1024 + 64); rb1[j] = *(const u32x4*)(gB + (size_t)j * 32 * 1024 + 64); }
}
DI void gemm_run(const u16* __restrict__ A, const u16* __restrict__ B, int n0, int m0, char* smem, f32x16 (&acc)[2][2],
                 u32x4 (&ra0)[4], u32x4 (&rb0)[4], u32x4 (&ra1)[4], u32x4 (&rb1)[4]) {
  const int tid = threadIdx.x, lane = tid & 63, w = __builtin_amdgcn_readfirstlane(tid >> 6);
  const int wn = w & 1, wm = w >> 1;
  const int lc = tid & 7, lr = tid >> 3;
  u16* sm = (u16*)smem;
  const u16* gA = A + (size_t)(n0 + lr) * 1024 + lc * 8;
  const u16* gB = B + (size_t)(m0 + lr) * 1024 + lc * 8;
#pragma unroll
  for (int a = 0; a < 2; ++a)
#pragma unroll
    for (int b = 0; b < 2; ++b)
#pragma unroll
      for (int i = 0; i < 16; ++i) acc[a][b][i] = 0.f;
  u32x4 ra2[4], rb2[4];
#define GEMM_LOAD(RA, RB, KT) _Pragma("unroll") for (int j = 0; j < 4; ++j) { \
    RA[j] = *(const u32x4*)(gA + (size_t)j * 32 * 1024 + (KT) * 64); RB[j] = *(const u32x4*)(gB + (size_t)j * 32 * 1024 + (KT) * 64); }
#define GEMM_STORE(RA, RB, ST) _Pragma("unroll") for (int j = 0; j < 4; ++j) { \
    *(u32x4*)(sm + (((ST) * 2 + 0) * 128 + lr + 32 * j) * GP + lc * 8) = RA[j]; *(u32x4*)(sm + (((ST) * 2 + 1) * 128 + lr + 32 * j) * GP + lc * 8) = RB[j]; }
  GEMM_LOAD(ra2, rb2, 2)
  __syncthreads();
  GEMM_STORE(ra0, rb0, 0)
  __syncthreads();
  const int fr = lane & 31, fh = lane >> 5;
  const u16* fa = sm + (wn * 64 + fr) * GP + fh * 8;
  const u16* fb = sm + (128 + wm * 64 + fr) * GP + fh * 8;
#define GEMM_COMPUTE(ST)                                                                          \
  _Pragma("unroll") for (int ks = 0; ks < 4; ++ks) {                                              \
    bf16x8 af[2], bfr[2];                                                                         \
    _Pragma("unroll") for (int a = 0; a < 2; ++a) af[a] = *(const bf16x8*)(fa + ((ST) * 256 + a * 32) * GP + ks * 16);   \
    _Pragma("unroll") for (int b = 0; b < 2; ++b) bfr[b] = *(const bf16x8*)(fb + ((ST) * 256 + b * 32) * GP + ks * 16);  \
    _Pragma("unroll") for (int a = 0; a < 2; ++a)                                                 \
      _Pragma("unroll") for (int b = 0; b < 2; ++b) acc[a][b] = MFMA32(af[a], bfr[b], acc[a][b]); \
  }
#define GEMM_SUB(K, RAL, RBL, RAW, RBW)                                   \
  {                                                                       \
    if ((K) + 3 < 16) { GEMM_LOAD(RAL, RBL, (K) + 3) }                    \
    GEMM_COMPUTE((K) & 1)                                                 \
    if ((K) + 1 < 16) { GEMM_STORE(RAW, RBW, ((K) + 1) & 1) }             \
    __syncthreads();                                                      \
  }
  GEMM_SUB(0, ra0, rb0, ra1, rb1)
  GEMM_SUB(1, ra1, rb1, ra2, rb2)
  GEMM_SUB(2, ra2, rb2, ra0, rb0)
  GEMM_SUB(3, ra0, rb0, ra1, rb1)
  GEMM_SUB(4, ra1, rb1, ra2, rb2)
  GEMM_SUB(5, ra2, rb2, ra0, rb0)
  GEMM_SUB(6, ra0, rb0, ra1, rb1)
  GEMM_SUB(7, ra1, rb1, ra2, rb2)
  GEMM_SUB(8, ra2, rb2, ra0, rb0)
  GEMM_SUB(9, ra0, rb0, ra1, rb1)
  GEMM_SUB(10, ra1, rb1, ra2, rb2)
  GEMM_SUB(11, ra2, rb2, ra0, rb0)
  GEMM_SUB(12, ra0, rb0, ra1, rb1)
  GEMM_SUB(13, ra1, rb1, ra2, rb2)
  GEMM_SUB(14, ra2, rb2, ra0, rb0)
  GEMM_SUB(15, ra0, rb0, ra1, rb1)
#undef GEMM_SUB
#undef GEMM_COMPUTE
#undef GEMM_LOAD
#undef GEMM_STORE
}

struct XMap { int xcc, rank, nloc; };
__device__ void phase1(const Params& p, char* smem, int bid, int nblk, const XMap xm) {
  const int lane = threadIdx.x & 63, w = threadIdx.x >> 6;
  const int wn = w & 1, wm = w >> 1;
  const int r0 = lane & 31, h0 = lane >> 5;
  const int ntiles = xm.xcc >= 0 ? 960 : (MTOK / 128) * 30;
  const int tstep = xm.xcc >= 0 ? xm.nloc : nblk;
  const int tend = ntiles * (1 + PROBE_P1);
  auto coords = [&](int tile0, int& mt, int& nt) {
    const int tile = tile0 >= ntiles ? tile0 - ntiles : tile0;
    if (xm.xcc >= 0) {
      int ml;
      if (tile < 768) { const int g = tile >> 8, rem = tile & 255, c = rem >> 6, q = rem & 63; ml = c * 8 + (q >> 3); nt = g * 8 + (q & 7); }
      else { const int t2 = tile - 768, c = t2 / 48, q = t2 % 48; ml = c * 8 + q / 6; nt = 24 + q % 6; }
      mt = xm.xcc * 32 + ml;
    } else { mt = tile / 30; nt = tile % 30; }
  };
  int tile0 = xm.xcc >= 0 ? xm.rank : bid;
  while (tile0 < tend) {
    int mt_c, nt_c;
    coords(tile0, mt_c, nt_c);
    f32x16 acc[2][2];
    {
      u32x4 ra0[4], rb0[4], ra1[4], rb1[4];
      gemm_issue(p.winT, p.xb, nt_c * 128, mt_c * 128, ra0, rb0, ra1, rb1);
      gemm_run(p.winT, p.xb, nt_c * 128, mt_c * 128, smem, acc, ra0, rb0, ra1, rb1);
    }
    tile0 += tstep;
    {
    const int mt = mt_c, nt = nt_c;
    int r = r0, h = h0;
    asm volatile("" : "+v"(r), "+v"(h));
    u16* T = (u16*)smem;
    const int mbase = mt * 128 + wm * 64;
    if (nt <= 4) {
      const bool isq = nt < 4;
      const float* nw = isq ? p.q_norm_w : p.k_norm_w;
      const float sc = isq ? Q_PRESCALE : 1.0f;
#pragma unroll
      for (int b = 0; b < 2; ++b) {
        const int m = mbase + b * 32 + r;
        const int s = m & 4095;
        const int rp = s >> 6, cp = s & 63;
        float ss = 0.f;
#pragma unroll
        for (int a = 0; a < 2; ++a)
#pragma unroll
          for (int i = 0; i < 16; ++i) ss += acc[a][b][i] * acc[a][b][i];
        ss += __shfl_xor(ss, 32);
        const float rstd = rsqrtf(ss * (1.f / 64.f) + 1e-6f);
        u16* trow = T + (wm * 64 + b * 32 + r) * EP + wn * 64 + 4 * h;
#pragma unroll
        for (int a = 0; a < 2; ++a) {
          const int pos = a == 0 ? rp : cp;
          float y[16], o[16];
#pragma unroll
          for (int i = 0; i < 16; ++i) y[i] = acc[a][b][i] * rstd * nw[a * 32 + crow(i, h)];
#pragma unroll
          for (int i = 0; i < 8; ++i) {
            const float2 cs = p.rope[pos * 16 + crow(i, h)];
            o[i] = (y[i] * cs.x - y[i + 8] * cs.y) * sc;
            o[i + 8] = (y[i + 8] * cs.x + y[i] * cs.y) * sc;
          }
#pragma unroll
          for (int g = 0; g < 4; ++g) {
            u32x2 v; v.x = pack2(o[4 * g], o[4 * g + 1]); v.y = pack2(o[4 * g + 2], o[4 * g + 3]);
            *(u32x2*)(trow + a * 32 + 8 * g) = v;
          }
        }
      }
    } else if (nt == 5) {
#pragma unroll
      for (int b = 0; b < 2; ++b)
#pragma unroll
        for (int a = 0; a < 2; ++a)
#pragma unroll
          for (int i = 0; i < 16; ++i) T[(wn * 64 + a * 32 + crow(i, h)) * EP + wm * 64 + b * 32 + r] = f2bf(acc[a][b][i]);
    } else {
      const int gi = (nt - 6) >> 2;
      const int cb = ((nt - 6) & 3) * 128 + wn * 64;
#pragma unroll
      for (int b = 0; b < 2; ++b) {
        u16* trow = T + (wm * 64 + b * 32 + r) * EP + wn * 64 + 4 * h;
#pragma unroll
        for (int a = 0; a < 2; ++a)
#pragma unroll
          for (int g = 0; g < 4; ++g) {
            float v[4];
#pragma unroll
            for (int e = 0; e < 4; ++e) v[e] = acc[a][b][4 * g + e];
            u32x2 o;
            if (gi == 3 || gi == 4) {
              const float4 lb = *(const float4*)(p.lbv + (gi - 3) * 512 + cb + a * 32 + 8 * g + 4 * h);
              const float ox = __builtin_amdgcn_logf(lb.x + (1.f - lb.x) * __builtin_amdgcn_rcpf(1.f + __expf(-v[0])));
              const float oy = __builtin_amdgcn_logf(lb.y + (1.f - lb.y) * __builtin_amdgcn_rcpf(1.f + __expf(-v[1])));
              const float oz = __builtin_amdgcn_logf(lb.z + (1.f - lb.z) * __builtin_amdgcn_rcpf(1.f + __expf(-v[2])));
              const float ow = __builtin_amdgcn_logf(lb.w + (1.f - lb.w) * __builtin_amdgcn_rcpf(1.f + __expf(-v[3])));
              o.x = pack2h(ox, oy); o.y = pack2h(oz, ow);
            } else {
              if (gi == 0 || gi == 5) {
#pragma unroll
                for (int e = 0; e < 4; ++e) v[e] = silu_f(v[e]);
              } else if (gi == 1) {
#pragma unroll
                for (int e = 0; e < 4; ++e) v[e] = silu_f(v[e]) * HQ_SCALE;
              }
              o.x = pack2(v[0], v[1]); o.y = pack2(v[2], v[3]);
            }
            *(u32x2*)(trow + a * 32 + 8 * g) = o;
          }
      }
    }
    __syncthreads();
    {
      const int tid = threadIdx.x;
      const int ch = tid & 15, rw = tid >> 4;
      const int bi = (mt * 128) >> 12, s0 = (mt * 128) & 4095;
      u16* dbase; size_t rstride;
      if (nt < 4)       { dbase = p.q + ((size_t)(bi * 8 + nt * 2 + (ch >> 3)) * SEQ + s0) * 64 + (ch & 7) * 8; rstride = 64; }
      else if (nt == 4) { dbase = p.k + ((size_t)(bi * 2 + (ch >> 3)) * SEQ + s0) * 64 + (ch & 7) * 8; rstride = 64; }
      else if (nt == 5) { dbase = p.vT + (size_t)(bi * 2) * 64 * SEQ + s0 + ch * 8; rstride = SEQ; }
      else {
        const int gi = (nt - 6) >> 2;
        u16* gb = gi == 0 ? p.ga : gi == 1 ? p.hq : gi == 2 ? p.hi : gi == 3 ? p.lff : gi == 4 ? p.lfb : p.gh;
        dbase = gb + (size_t)(mt * 128) * 512 + ((nt - 6) & 3) * 128 + ch * 8; rstride = 512;
      }
#pragma unroll
      for (int j = 0; j < 8; ++j) {
        const int row = j * 16 + rw;
        const u32x4 v = *(const u32x4*)(T + row * EP + ch * 8);
        *(u32x4*)(dbase + (size_t)row * rstride) = v;
      }
    }
    }
  }
}

constexpr int AP = 72;
constexpr int ATT_LDS = 2 * 2 * 64 * AP * 2;
DI float fast_exp2(float x) { return __builtin_amdgcn_exp2f(x); }

__device__ void attn_item(const Params& p, char* smem, int item) {
  const int tid = threadIdx.x, lane = tid & 63, w = __builtin_amdgcn_readfirstlane(tid >> 6), r = lane & 31, h = lane >> 5;
  const int qb = item & 31, head = (item >> 5) & 7, bi = item >> 8;
  const int kvh = head >> 2;
  const int q0 = qb * 128 + w * 32;
  u16* sm = (u16*)smem;
  bf16x8 qf[4];
  {
    const u16* qp = p.q + ((size_t)(bi * 8 + head) * SEQ + q0 + r) * 64 + h * 8;
#pragma unroll
    for (int ks = 0; ks < 4; ++ks) qf[ks] = *(const bf16x8*)(qp + ks * 16);
  }
  const int lc = tid & 7, lr = tid >> 3;
  const u16* kg = p.k + (size_t)(bi * 2 + kvh) * SEQ * 64 + (size_t)lr * 64 + lc * 8;
  const u16* vg = p.vT + (size_t)(bi * 2 + kvh) * 64 * SEQ + (size_t)lr * SEQ + lc * 8;
  const int kw = lr * AP + lc * 8;
  const int vw = lr * AP + (lc >> 1) * 16 + (lc & 1) * 4;
  u32x4 rkA[2], rvA[2], rkB[2], rvB[2];
#define ATT_LOADK(RK, T) _Pragma("unroll") for (int j = 0; j < 2; ++j) RK[j] = *(const u32x4*)(kg + (size_t)((T) * 64 + j * 32) * 64);
#define ATT_LOADV(RV, T) _Pragma("unroll") for (int j = 0; j < 2; ++j) RV[j] = *(const u32x4*)(vg + (size_t)j * 32 * SEQ + (T) * 64);
#define ATT_STOREK(RK, S) _Pragma("unroll") for (int j = 0; j < 2; ++j) *(u32x4*)(sm + (S) * 64 * AP + kw + j * 32 * AP) = RK[j];
#define ATT_STOREV(RV, S) _Pragma("unroll") for (int j = 0; j < 2; ++j) { u16* vd = sm + (2 + (S)) * 64 * AP + vw + j * 32 * AP; *(u32x2*)(vd) = RV[j].xy; *(u32x2*)(vd + 8) = RV[j].zw; }
#define ATT_QK(DST, S)                                                                      \
  _Pragma("unroll") for (int kt2 = 0; kt2 < 2; ++kt2) {                                     \
    _Pragma("unroll") for (int i = 0; i < 16; ++i) DST[kt2][i] = MINIT;                     \
    _Pragma("unroll") for (int ks = 0; ks < 4; ++ks) {                                      \
      const bf16x8 kf = *(const bf16x8*)(sm + (S) * 64 * AP + (kt2 * 32 + r) * AP + ks * 16 + h * 8); \
      DST[kt2] = MFMA32(kf, qf[ks], DST[kt2]);                                              \
    }                                                                                       \
  }
  ATT_LOADK(rkA, 0) ATT_LOADV(rvA, 0)
  ATT_LOADK(rkB, 1)
  __syncthreads();
  ATT_STOREK(rkA, 0) ATT_STOREV(rvA, 0)
  ATT_STOREK(rkB, 1)
  ATT_LOADK(rkA, 2) ATT_LOADV(rvA, 1)
  __syncthreads();
  f32x16 o[2];
#pragma unroll
  for (int dt = 0; dt < 2; ++dt)
#pragma unroll
    for (int i = 0; i < 16; ++i) o[dt][i] = 0.f;
  float mrun = 0.f, lsum = 0.f;
  f32x16 sa[2], sb[2];
  { const float MINIT = 0.f; ATT_QK(sa, 0) }
  __syncthreads();
#define ATT_STEP(CUR, NXT, T, RKW, RVW, RKL, RVL)                                           \
  {                                                                                         \
    const int t_ = (T);                                                                     \
    if (t_ + 3 < 64) { ATT_LOADK(RKL, t_ + 3) }     \
    if (t_ + 2 < 64) { ATT_LOADV(RVL, t_ + 2) }                                             \
    const float mref_ = mrun;                    \
    float mx = CUR[0][0];                                                                   \
    _Pragma("unroll") for (int i = 1; i < 16; ++i) mx = fmaxf(mx, CUR[0][i]);               \
    _Pragma("unroll") for (int i = 0; i < 16; ++i) mx = fmaxf(mx, CUR[1][i]);               \
    mx = fmaxf(mx, __shfl_xor(mx, 32));                                                     \
    float shift = 0.f;                                                                      \
    if (t_ == 0 || __any(mx > 0.f)) {     \
      shift = t_ == 0 ? mx : fmaxf(mx, 0.f);                                                \
      const float al = fast_exp2(-shift);                                                   \
      lsum *= al;                                                                           \
      _Pragma("unroll") for (int dt = 0; dt < 2; ++dt)                                      \
        _Pragma("unroll") for (int i = 0; i < 16; ++i) o[dt][i] *= al;                      \
      mrun = mref_ + shift;                                                                 \
      _Pragma("unroll") for (int kt2 = 0; kt2 < 2; ++kt2)                                   \
        _Pragma("unroll") for (int i = 0; i < 16; ++i) CUR[kt2][i] -= shift;                \
    }                                                                                       \
    if (t_ + 1 < 64) { const float MINIT = -mrun; ATT_QK(NXT, (t_ + 1) & 1) }               \
    _Pragma("unroll") for (int kt2 = 0; kt2 < 2; ++kt2)                                     \
      _Pragma("unroll") for (int i = 0; i < 16; ++i) { const float e = fast_exp2(CUR[kt2][i]); CUR[kt2][i] = e; lsum += e; } \
    _Pragma("unroll") for (int s2 = 0; s2 < 4; ++s2) {                                      \
      u32x4 pk;                                                                             \
      pk.x = pack2(CUR[s2 >> 1][8 * (s2 & 1) + 0], CUR[s2 >> 1][8 * (s2 & 1) + 1]);         \
      pk.y = pack2(CUR[s2 >> 1][8 * (s2 & 1) + 2], CUR[s2 >> 1][8 * (s2 & 1) + 3]);         \
      pk.z = pack2(CUR[s2 >> 1][8 * (s2 & 1) + 4], CUR[s2 >> 1][8 * (s2 & 1) + 5]);         \
      pk.w = pack2(CUR[s2 >> 1][8 * (s2 & 1) + 6], CUR[s2 >> 1][8 * (s2 & 1) + 7]);         \
      const bf16x8 pf = __builtin_bit_cast(bf16x8, pk);                                     \
      _Pragma("unroll") for (int dt = 0; dt < 2; ++dt) {                                    \
        const bf16x8 vf = *(const bf16x8*)(sm + (2 + (t_ & 1)) * 64 * AP + (dt * 32 + r) * AP + s2 * 16 + h * 8); \
        o[dt] = MFMA32(vf, pf, o[dt]);                                                      \
      }                                                                                     \
    }                                                                                       \
    if (t_ + 2 < 64) { ATT_STOREK(RKW, t_ & 1) }                                            \
    if (t_ + 1 < 64) { ATT_STOREV(RVW, (t_ + 1) & 1) }                                      \
    __syncthreads();                                                                        \
  }
  for (int t = 0; t < 64; t += 2) {
    ATT_STEP(sa, sb, t, rkA, rvA, rkB, rvB)
    ATT_STEP(sb, sa, t + 1, rkB, rvB, rkA, rvA)
  }
#undef ATT_STEP
#undef ATT_QK
#undef ATT_LOADK
#undef ATT_LOADV
#undef ATT_STOREK
#undef ATT_STOREV
  lsum += __shfl_xor(lsum, 32);
  const float il = 1.f / lsum;
  u16* op = p.attn + ((size_t)bi * SEQ + q0 + r) * 512 + head * 64 + 4 * h;
#pragma unroll
  for (int dt = 0; dt < 2; ++dt)
#pragma unroll
    for (int g = 0; g < 4; ++g) {
      u32x2 v; v.x = pack2(o[dt][4 * g] * il, o[dt][4 * g + 1] * il); v.y = pack2(o[dt][4 * g + 2] * il, o[dt][4 * g + 3] * il);
      *(u32x2*)(op + dt * 32 + 8 * g) = v;
    }
}

constexpr int HQP = 136;
constexpr int HSP = 72;
constexpr int H_QM = 0;
constexpr int H_KM = H_QM + 64 * HQP * 2;
constexpr int H_KUT = H_KM + 64 * HQP * 2;
constexpr int H_IT = H_KUT + 128 * HSP * 2;
constexpr int H_F32 = H_IT + 128 * HSP * 2;
constexpr int HG_LDS = H_F32 + 7 * 128 * 4;

__device__ void hgrn_item(const Params& p, char* smem, int item) {
  const int tid = threadIdx.x, lane = tid & 63, w = __builtin_amdgcn_readfirstlane(tid >> 6), r = lane & 31, h = lane >> 5;
  const int dir = item & 1, hh = (item >> 1) & 3, bi = item >> 3;
  u16* QM = (u16*)(smem + H_QM);
  u16* KM = (u16*)(smem + H_KM);
  u16* AM = (u16*)(smem + H_KM);
  u16* KUT = (u16*)(smem + H_KUT);
  u16* IT = (u16*)(smem + H_IT);
  float* tot = (float*)(smem + H_F32);
  float* first2 = tot + 512;
  float* emid = tot + 640;
  float* dec = tot + 768;
  const u16* lf = dir ? p.lfb : p.lff;
  u16* og = dir ? p.ob : p.of;
  const int kp = lane;
  const int k16 = (2 * kp) & 15, grp = k16 >> 2;
  const int pk0 = ((2 * kp) & ~15) | ((grp == 1 ? 2 : grp == 2 ? 1 : grp) << 2) | ((2 * kp) & 3);
  const int tp = tid & 31, vc = (tid >> 5) * 16;
  f32x16 S[4];
#pragma unroll
  for (int a = 0; a < 4; ++a)
#pragma unroll
    for (int i = 0; i < 16; ++i) S[a][i] = 0.f;
  const size_t colb = (size_t)hh * 128;
  const unsigned olane = (unsigned)((dir ? 4 - 4 * h : 4 * h) * 1024 + (hh * 128 + w * 32 + r) * 2);
  uint32_t lgv[16], qv[16];
#define HG_LOAD(C)                                                                                   \
  {                                                                                                  \
    const int s0_ = dir ? SEQ - 64 * ((C) + 1) : 64 * (C);                                           \
    const size_t tb_ = (size_t)bi * SEQ + s0_;                                                       \
    _Pragma("unroll") for (int e = 0; e < 16; ++e) {                                                 \
      const int tau = 16 * w + e;                                                                    \
      const size_t tok = tb_ + (dir ? 63 - tau : tau);                                               \
      lgv[e] = *(const uint32_t*)((const char*)(lf + tok * 512 + colb) + (unsigned)(kp * 4));        \
      qv[e] = *(const uint32_t*)((const char*)(p.hq + tok * 512 + colb) + (unsigned)(kp * 4));       \
    }                                                                                                \
  }
  HG_LOAD(0)
  __syncthreads();
  for (int c0 = 0; c0 < 64 * (1 + PROBE_HG); ++c0) {
    const int c = c0 & 63;
#if PROBE_HG
    if (c0 == 64) {
#pragma unroll
      for (int a = 0; a < 4; ++a)
#pragma unroll
        for (int i = 0; i < 16; ++i) S[a][i] = 0.f;
    }
#endif
    const int s0 = dir ? SEQ - 64 * (c + 1) : 64 * c;
    const size_t tb = (size_t)bi * SEQ + s0;
    const size_t tok0 = tb + (dir ? 63 - 2 * tp : 2 * tp), tok1 = tb + (dir ? 62 - 2 * tp : 2 * tp + 1);
    const u32x4 ia0 = *(const u32x4*)(p.hi + tok0 * 512 + colb + vc), ia1 = *(const u32x4*)(p.hi + tok0 * 512 + colb + vc + 8);
    const u32x4 ib0 = *(const u32x4*)(p.hi + tok1 * 512 + colb + vc), ib1 = *(const u32x4*)(p.hi + tok1 * 512 + colb + vc + 8);
    {
      float2 run = make_float2(0.f, 0.f);
#pragma unroll
      for (int e = 0; e < 16; ++e) { run.x += h2f_lo(lgv[e]); run.y += h2f_hi(lgv[e]); }
      *(float2*)(tot + w * 128 + 2 * kp) = run;
      if (w == 2) *(float2*)(first2 + 2 * kp) = make_float2(h2f_lo(lgv[0]), h2f_hi(lgv[0]));
    }
    __syncthreads();
    {
      const float2 t0 = *(const float2*)(tot + 2 * kp), t1 = *(const float2*)(tot + 128 + 2 * kp);
      const float2 t2 = *(const float2*)(tot + 256 + 2 * kp), t3 = *(const float2*)(tot + 384 + 2 * kp);
      const float2 f2 = *(const float2*)(first2 + 2 * kp);
      float2 pre = make_float2(0.f, 0.f);
      if (w > 0) { pre.x += t0.x; pre.y += t0.y; }
      if (w > 1) { pre.x += t1.x; pre.y += t1.y; }
      if (w > 2) { pre.x += t2.x; pre.y += t2.y; }
      const float2 bmid = make_float2(t0.x + t1.x + f2.x, t0.y + t1.y + f2.y);
      const float2 blast = make_float2(t0.x + t1.x + t2.x + t3.x, t0.y + t1.y + t2.y + t3.y);
      const float ccx = fast_exp2(blast.x - bmid.x), ccy = fast_exp2(blast.y - bmid.y);
      uint32_t kux[8], kuy[8];
      float pkx = 0.f, pky = 0.f;
      float2 run = make_float2(pre.x - bmid.x, pre.y - bmid.y);
#pragma unroll
      for (int e = 0; e < 16; ++e) {
        const float lgx = h2f_lo(lgv[e]), lgy = h2f_hi(lgv[e]);
        run.x += lgx; run.y += lgy;
        const float rx = run.x, ry = run.y;
        const float e1x = fast_exp2(rx), e1y = fast_exp2(ry), e2x = fast_exp2(-rx), e2y = fast_exp2(-ry);
        const float gx = 1.f - fast_exp2(lgx), gy = 1.f - fast_exp2(lgy);
        const float qx = __uint_as_float(qv[e] << 16), qy = __uint_as_float(qv[e] & 0xffff0000u);
        const float kmx = gx * e2x, kmy = gy * e2y;
        const int t = 16 * w + e;
        *(uint32_t*)(QM + t * HQP + pk0) = pack2(qx * e1x, qy * e1y);
        *(uint32_t*)(KM + t * HQP + pk0) = pack2(kmx, kmy);
        if (e & 1) { kux[e >> 1] = pack2(pkx, kmx * ccx); kuy[e >> 1] = pack2(pky, kmy * ccy); }
        else { pkx = kmx * ccx; pky = kmy * ccy; }
      }
      u32x4* d0 = (u32x4*)(KUT + (2 * kp) * HSP + 16 * w);
      u32x4* d1 = (u32x4*)(KUT + (2 * kp + 1) * HSP + 16 * w);
      u32x4 v;
      v.x = kux[0]; v.y = kux[1]; v.z = kux[2]; v.w = kux[3]; d0[0] = v;
      v.x = kux[4]; v.y = kux[5]; v.z = kux[6]; v.w = kux[7]; d0[1] = v;
      v.x = kuy[0]; v.y = kuy[1]; v.z = kuy[2]; v.w = kuy[3]; d1[0] = v;
      v.x = kuy[4]; v.y = kuy[5]; v.z = kuy[6]; v.w = kuy[7]; d1[1] = v;
      if (w == 0) {
        *(float2*)(emid + 2 * kp) = make_float2(fast_exp2(bmid.x), fast_exp2(bmid.y));
        *(float2*)(dec + 2 * kp) = make_float2(fast_exp2(blast.x), fast_exp2(blast.y));
      }
    }
    {
      uint32_t* d = (uint32_t*)(IT + vc * HSP + 2 * tp);
#pragma unroll
      for (int j = 0; j < 4; ++j) {
        d[(2 * j) * (HSP / 2)] = (ia0[j] & 0xffffu) | (ib0[j] << 16);
        d[(2 * j + 1) * (HSP / 2)] = (ia0[j] >> 16) | (ib0[j] & 0xffff0000u);
        d[(8 + 2 * j) * (HSP / 2)] = (ia1[j] & 0xffffu) | (ib1[j] << 16);
        d[(8 + 2 * j + 1) * (HSP / 2)] = (ia1[j] >> 16) | (ib1[j] & 0xffff0000u);
      }
    }
    __syncthreads();
    if (c0 + 1 < 64 * (1 + PROBE_HG)) HG_LOAD((c + 1) & 63)
    {
      const int ti = w >> 1, si = w & 1;
      f32x16 d;
#pragma unroll
      for (int i = 0; i < 16; ++i) d[i] = 0.f;
      if (w != 1) {
#pragma unroll
        for (int ks = 0; ks < 8; ++ks) {
          const bf16x8 af = *(const bf16x8*)(KM + (si * 32 + r) * HQP + ks * 16 + h * 8);
          const bf16x8 bf = *(const bf16x8*)(QM + (ti * 32 + r) * HQP + ks * 16 + h * 8);
          d = MFMA32(af, bf, d);
        }
      }
      __syncthreads();
      const int t = ti * 32 + r;
#pragma unroll
      for (int g = 0; g < 4; ++g) {
        const int sb = si * 32 + 8 * g + 4 * h;
        u32x2 v;
        v.x = pack2(sb + 0 <= t ? d[4 * g + 0] : 0.f, sb + 1 <= t ? d[4 * g + 1] : 0.f);
        v.y = pack2(sb + 2 <= t ? d[4 * g + 2] : 0.f, sb + 3 <= t ? d[4 * g + 3] : 0.f);
        *(u32x2*)(AM + t * HSP + sb) = v;
      }
    }
    __syncthreads();
    {
      f32x16 oa0, oa1;
#pragma unroll
      for (int i = 0; i < 16; ++i) { oa0[i] = 0.f; oa1[i] = 0.f; }
#pragma unroll
      for (int s4 = 0; s4 < 4; ++s4) {
        const bf16x8 ifr = *(const bf16x8*)(IT + (w * 32 + r) * HSP + 16 * s4 + 8 * h);
        const bf16x8 am1 = *(const bf16x8*)(AM + (32 + r) * HSP + 16 * s4 + 8 * h);
        oa1 = MFMA32(am1, ifr, oa1);
        if (s4 < 2) {
          const bf16x8 am0 = *(const bf16x8*)(AM + r * HSP + 16 * s4 + 8 * h);
          oa0 = MFMA32(am0, ifr, oa0);
        }
      }
#pragma unroll
      for (int ks = 0; ks < 8; ++ks) {
        const int kt4 = ks >> 1, hf = ks & 1;
        const float4 ea = *(const float4*)(emid + kt4 * 32 + 16 * hf + 4 * h);
        const float4 eb = *(const float4*)(emid + kt4 * 32 + 16 * hf + 8 + 4 * h);
        u32x4 pk;
        pk.x = pack2(S[kt4][8 * hf + 0] * ea.x, S[kt4][8 * hf + 1] * ea.y);
        pk.y = pack2(S[kt4][8 * hf + 2] * ea.z, S[kt4][8 * hf + 3] * ea.w);
        pk.z = pack2(S[kt4][8 * hf + 4] * eb.x, S[kt4][8 * hf + 5] * eb.y);
        pk.w = pack2(S[kt4][8 * hf + 6] * eb.z, S[kt4][8 * hf + 7] * eb.w);
        const bf16x8 sp = __builtin_bit_cast(bf16x8, pk);
        const bf16x8 qf0 = *(const bf16x8*)(QM + r * HQP + ks * 16 + 8 * h);
        const bf16x8 qf1 = *(const bf16x8*)(QM + (32 + r) * HQP + ks * 16 + 8 * h);
        oa0 = MFMA32(qf0, sp, oa0);
        oa1 = MFMA32(qf1, sp, oa1);
      }
      char* ogb = (char*)og + olane;
#pragma unroll
      for (int i = 0; i < 16; ++i) {
        const int ci = (i & 3) + 8 * (i >> 2);
        const size_t r0 = dir ? tb + 59 - ci : tb + ci;
        const size_t r1 = dir ? tb + 27 - ci : tb + 32 + ci;
        *(u16*)(ogb + r0 * 1024) = f2bf(oa0[i]);
        *(u16*)(ogb + r1 * 1024) = f2bf(oa1[i]);
      }
    }
#pragma unroll
    for (int kt4 = 0; kt4 < 4; ++kt4) {
#pragma unroll
      for (int g = 0; g < 4; ++g) {
        const float4 dd = *(const float4*)(dec + kt4 * 32 + 8 * g + 4 * h);
        S[kt4][4 * g + 0] *= dd.x; S[kt4][4 * g + 1] *= dd.y; S[kt4][4 * g + 2] *= dd.z; S[kt4][4 * g + 3] *= dd.w;
      }
    }
#pragma unroll
    for (int s4 = 0; s4 < 4; ++s4) {
      const bf16x8 ifr = *(const bf16x8*)(IT + (w * 32 + r) * HSP + 16 * s4 + 8 * h);
#pragma unroll
      for (int kt4 = 0; kt4 < 4; ++kt4) {
        const bf16x8 kf = *(const bf16x8*)(KUT + (kt4 * 32 + r) * HSP + 16 * s4 + 8 * h);
        S[kt4] = MFMA32(kf, ifr, S[kt4]);
      }
    }
    __syncthreads();
  }
#undef HG_LOAD
}

__global__ __launch_bounds__(256) void naive_attn(Params p) {
  const int gid = blockIdx.x * 256 + threadIdx.x;
  const int s = gid & 4095, bh = gid >> 12, head = bh & 7, bi = bh >> 3, kvh = head >> 2;
  float qv[64], acc[64];
  const u16* qp = p.q + ((size_t)(bi * 8 + head) * SEQ + s) * 64;
#pragma unroll
  for (int d = 0; d < 64; ++d) { qv[d] = bf2f(qp[d]); acc[d] = 0.f; }
  float mx = -INFINITY, l = 0.f;
  const u16* kp = p.k + (size_t)(bi * 2 + kvh) * SEQ * 64;
  const u16* vp = p.vT + (size_t)(bi * 2 + kvh) * 64 * SEQ;
  for (int key = 0; key < SEQ; ++key) {
    float sc = 0.f;
#pragma unroll
    for (int d = 0; d < 64; ++d) sc += qv[d] * bf2f(kp[(size_t)key * 64 + d]);
    const float mn = fmaxf(mx, sc);
    const float al = exp2f(mx - mn), pp = exp2f(sc - mn);
    l = l * al + pp;
#pragma unroll
    for (int d = 0; d < 64; ++d) acc[d] = acc[d] * al + pp * bf2f(vp[(size_t)d * SEQ + key]);
    mx = mn;
  }
  const float il = 1.f / l;
  u16* op = p.attn + ((size_t)bi * SEQ + s) * 512 + head * 64;
#pragma unroll
  for (int d = 0; d < 64; ++d) op[d] = f2bf(acc[d] * il);
}

__global__ __launch_bounds__(1024) void naive_hgrn(Params p) {
  __shared__ float red[8][128];
  const int dir = blockIdx.x & 1, hh = (blockIdx.x >> 1) & 3, bi = blockIdx.x >> 3;
  const int v = threadIdx.x & 127, kq = threadIdx.x >> 7;
  float S[16];
#pragma unroll
  for (int i = 0; i < 16; ++i) S[i] = 0.f;
  const u16* lf = dir ? p.lfb : p.lff;
  u16* o = dir ? p.ob : p.of;
  for (int step = 0; step < SEQ; ++step) {
    const int s = dir ? SEQ - 1 - step : step;
    const size_t base = ((size_t)bi * SEQ + s) * 512 + hh * 128;
    const float iv = bf2f(p.hi[base + v]);
    float part = 0.f;
#pragma unroll
    for (int kk = 0; kk < 16; ++kk) {
      const int k = kq * 16 + kk;
      const float lg = (float)__builtin_bit_cast(_Float16, lf[base + k]);
      const float f = exp2f(lg), g = 1.f - f;
      const float qk = bf2f(p.hq[base + k]);
      S[kk] = f * S[kk] + g * iv;
      part += S[kk] * qk;
    }
    red[kq][v] = part;
    __syncthreads();
    if (kq == 0) {
      float t = 0.f;
#pragma unroll
      for (int j = 0; j < 8; ++j) t += red[j][v];
      o[base + v] = f2bf(t);
    }
    __syncthreads();
  }
}

DI void unpack8(const uint4 u, float (&v)[8]) {
  v[0] = __uint_as_float(u.x << 16); v[1] = __uint_as_float(u.x & 0xffff0000u);
  v[2] = __uint_as_float(u.y << 16); v[3] = __uint_as_float(u.y & 0xffff0000u);
  v[4] = __uint_as_float(u.z << 16); v[5] = __uint_as_float(u.z & 0xffff0000u);
  v[6] = __uint_as_float(u.w << 16); v[7] = __uint_as_float(u.w & 0xffff0000u);
}
__device__ void phase_mix(const Params& p, int bid, int nblk) {
  const int lane = threadIdx.x & 63, w = threadIdx.x >> 6;
  u16* mix = p.mix;
  float wa[8], wh[8];
#pragma unroll
  for (int e = 0; e < 8; ++e) { wa[e] = p.attn_norm_w[lane * 8 + e]; wh[e] = p.hg_norm_w[(lane & 15) * 8 + e]; }
  const int stride = nblk * 4;
  for (int m0 = bid * 4 + w; m0 < MTOK; m0 += 4 * stride) {
    uint4 ua[4], ug[4], u1[4], u2[4], uh[4];
#pragma unroll
    for (int u = 0; u < 4; ++u) {
      const int m = m0 + u * stride;
      if (m < MTOK) {
        const size_t rb = (size_t)m * 512 + lane * 8;
        ua[u] = *(const uint4*)(p.attn + rb); ug[u] = *(const uint4*)(p.ga + rb);
        u1[u] = *(const uint4*)(p.of + rb); u2[u] = *(const uint4*)(p.ob + rb); uh[u] = *(const uint4*)(p.gh + rb);
      }
    }
#pragma unroll
    for (int u = 0; u < 4; ++u) {
      const int m = m0 + u * stride;
      if (m < MTOK) {
        float a[8], g[8], f1[8], f2[8];
        unpack8(ua[u], a); unpack8(ug[u], g);
        float ss = 0.f;
#pragma unroll
        for (int e = 0; e < 8; ++e) ss += a[e] * a[e];
#pragma unroll
        for (int o = 32; o >= 1; o >>= 1) ss += __shfl_xor(ss, o);
        float rstd = rsqrtf(ss * (1.f / 512.f) + 1e-6f);
        float r[8];
#pragma unroll
        for (int e = 0; e < 8; ++e) r[e] = a[e] * rstd * wa[e] * g[e];
        uint4 o1; o1.x = pack2(r[0], r[1]); o1.y = pack2(r[2], r[3]); o1.z = pack2(r[4], r[5]); o1.w = pack2(r[6], r[7]);
        *(uint4*)(mix + (size_t)m * 1024 + lane * 8) = o1;
        unpack8(u1[u], f1); unpack8(u2[u], f2); unpack8(uh[u], g);
        ss = 0.f;
#pragma unroll
        for (int e = 0; e < 8; ++e) { a[e] = f1[e] + f2[e]; ss += a[e] * a[e]; }
#pragma unroll
        for (int o = 8; o >= 1; o >>= 1) ss += __shfl_xor(ss, o);
        rstd = rsqrtf(ss * (1.f / 128.f) + 1e-6f);
#pragma unroll
        for (int e = 0; e < 8; ++e) r[e] = a[e] * rstd * wh[e] * g[e];
        o1.x = pack2(r[0], r[1]); o1.y = pack2(r[2], r[3]); o1.z = pack2(r[4], r[5]); o1.w = pack2(r[6], r[7]);
        *(uint4*)(mix + (size_t)m * 1024 + 512 + lane * 8) = o1;
      }
    }
  }
}

__device__ void phase3(const Params& p, char* smem, int bid, int nblk, const XMap xm) {
  const int lane = threadIdx.x & 63, w = threadIdx.x >> 6;
  const int wn = w & 1, wm = w >> 1;
  const int r0 = lane & 31, h0 = lane >> 5;
  const int ntiles = xm.xcc >= 0 ? 256 : (MTOK / 128) * 8;
  const int tstep = xm.xcc >= 0 ? xm.nloc : nblk;
  const int tend = ntiles * (1 + PROBE_P3);
  auto coords = [&](int tile0, int& mt, int& nt) {
    const int tile = tile0 >= ntiles ? tile0 - ntiles : tile0;
    if (xm.xcc >= 0) { const int c = tile >> 6, q = tile & 63; mt = xm.xcc * 32 + c * 8 + (q >> 3); nt = q & 7; }
    else { mt = tile >> 3; nt = tile & 7; }
  };
  int tile0 = xm.xcc >= 0 ? xm.rank : bid;
  while (tile0 < tend) {
    int mt_c, nt_c;
    coords(tile0, mt_c, nt_c);
    f32x16 acc[2][2];
    {
      u32x4 ra0[4], rb0[4], ra1[4], rb1[4];
      gemm_issue(p.woutT, p.mix, nt_c * 128, mt_c * 128, ra0, rb0, ra1, rb1);
      gemm_run(p.woutT, p.mix, nt_c * 128, mt_c * 128, smem, acc, ra0, rb0, ra1, rb1);
    }
    tile0 += tstep;
    {
    const int mt = mt_c, nt = nt_c;
    int r = r0, h = h0;
    asm volatile("" : "+v"(r), "+v"(h));
    float* T = (float*)smem;
#pragma unroll
    for (int b = 0; b < 2; ++b) {
      float* trow = T + (wm * 64 + b * 32 + r) * EPF + wn * 64 + 4 * h;
#pragma unroll
      for (int a = 0; a < 2; ++a)
#pragma unroll
        for (int g = 0; g < 4; ++g) {
          float4 o;
          o.x = acc[a][b][4 * g + 0]; o.y = acc[a][b][4 * g + 1]; o.z = acc[a][b][4 * g + 2]; o.w = acc[a][b][4 * g + 3];
          *(float4*)(trow + a * 32 + 8 * g) = o;
        }
    }
    __syncthreads();
    {
      const int tid = threadIdx.x;
      const int ch = tid & 31, rw = tid >> 5;
      const size_t gofs = (size_t)(mt * 128) * 1024 + nt * 128 + ch * 4;
#pragma unroll
      for (int j0 = 0; j0 < 16; j0 += 4) {
        float4 xv[4];
#pragma unroll
        for (int u = 0; u < 4; ++u) xv[u] = *(const float4*)(p.x + gofs + (size_t)((j0 + u) * 8 + rw) * 1024);
#pragma unroll
        for (int u = 0; u < 4; ++u) {
          const int row = (j0 + u) * 8 + rw;
          const float4 y = *(const float4*)(T + row * EPF + ch * 4);
          float4 o;
          o.x = DN_ALPHA * xv[u].x + y.x; o.y = DN_ALPHA * xv[u].y + y.y; o.z = DN_ALPHA * xv[u].z + y.z; o.w = DN_ALPHA * xv[u].w + y.w;
          *(float4*)(p.z + gofs + (size_t)row * 1024) = o;
        }
      }
    }
    }
  }
}

__device__ void phase4(const Params& p, int bid, int nblk) {
  const int lane = threadIdx.x & 63, w = threadIdx.x >> 6;
  const int stride = nblk * 4;
  for (int m0 = bid * 4 + w; m0 < MTOK; m0 += 4 * stride) {
    float4 v[4][4];
#pragma unroll
    for (int u = 0; u < 4; ++u) {
      const int m = m0 + u * stride;
      if (m < MTOK) {
        const float4* row = (const float4*)(p.z + (size_t)m * 1024);
#pragma unroll
        for (int j = 0; j < 4; ++j) v[u][j] = row[lane + 64 * j];
      }
    }
#pragma unroll
    for (int u = 0; u < 4; ++u) {
      const int m = m0 + u * stride;
      if (m < MTOK) {
        float4* row = (float4*)(p.out + (size_t)m * 1024);
        float s = 0.f;
#pragma unroll
        for (int j = 0; j < 4; ++j) s += v[u][j].x + v[u][j].y + v[u][j].z + v[u][j].w;
#pragma unroll
        for (int o = 32; o >= 1; o >>= 1) s += __shfl_xor(s, o);
        const float mu = s * (1.f / 1024.f);
        float q = 0.f;
#pragma unroll
        for (int j = 0; j < 4; ++j) {
          v[u][j].x -= mu; v[u][j].y -= mu; v[u][j].z -= mu; v[u][j].w -= mu;
          q += v[u][j].x * v[u][j].x + v[u][j].y * v[u][j].y + v[u][j].z * v[u][j].z + v[u][j].w * v[u][j].w;
        }
#pragma unroll
        for (int o = 32; o >= 1; o >>= 1) q += __shfl_xor(q, o);
        const float rstd = rsqrtf(q * (1.f / 1024.f) + 1e-5f);
#pragma unroll
        for (int j = 0; j < 4; ++j) {
          const float4 wv = ((const float4*)p.ln_w)[lane + 64 * j], bv = ((const float4*)p.ln_b)[lane + 64 * j];
          float4 o;
          o.x = v[u][j].x * rstd * wv.x + bv.x; o.y = v[u][j].y * rstd * wv.y + bv.y;
          o.z = v[u][j].z * rstd * wv.z + bv.z; o.w = v[u][j].w * rstd * wv.w + bv.w;
          row[lane + 64 * j] = o;
        }
      }
    }
  }
}


#define XB_TMO      128
#define XB_XCNT(j)  (256  + 64 * (j))
#define XB_XSUB(j)  (1280 + 64 * (j))
#define XB_XGEN(j)  (2304 + 64 * (j))
#define XB_TOP      3328
#define XB_TOPGEN   3392
#define XCD_BAR_WORDS 3456
#define XB_SPIN_CAP (1u << 18)
#define LAS __attribute__((address_space(3)))
DI unsigned xb_ld(unsigned* p) { return __hip_atomic_load(p, __ATOMIC_RELAXED, __HIP_MEMORY_SCOPE_AGENT); }
DI unsigned xb_add(unsigned* p, unsigned v) { return __hip_atomic_fetch_add(p, v, __ATOMIC_RELAXED, __HIP_MEMORY_SCOPE_AGENT); }
DI unsigned xb_xcc_id() { return (unsigned)__builtin_amdgcn_s_getreg((3 << 11) | 20) & 0xFu; }
#define XB_SPIN(cond, bar) do { unsigned _sp = 0; while (cond) { __builtin_amdgcn_s_sleep(1); \
    if ((++_sp & 255u) == 0u) { if (xb_ld(&(bar)[XB_TMO])) break; if (_sp > XB_SPIN_CAP) { atomicAdd(&(bar)[XB_TMO], 1u); break; } } } } while (0)
struct XcdBarrier { unsigned* bar; unsigned x; volatile LAS unsigned* st; };
DI XcdBarrier xcd_barrier_post(unsigned* bar, volatile LAS unsigned* st, unsigned& rank) {
  XcdBarrier b; b.bar = bar; b.x = xb_xcc_id(); b.st = st;
  rank = 0u;
  if (threadIdx.x == 0) rank = xb_add(&bar[XB_XCNT(b.x)], 1u);
  return b;
}
DI void xcd_barrier_complete(unsigned* bar, unsigned x, unsigned& nloc, unsigned& nx) {
  const unsigned G = gridDim.x * gridDim.y * gridDim.z;
  unsigned sum, cnt, mine, sp = 0u;
  for (;;) {
    sum = 0u; cnt = 0u; mine = 0u;
#pragma unroll
    for (unsigned j = 0; j < 16; ++j) { const unsigned c = xb_ld(&bar[XB_XCNT(j)]); sum += c; cnt += (c > 0u) ? 1u : 0u; mine = (j == x) ? c : mine; }
    if (sum == G) break;
    __builtin_amdgcn_s_sleep(1);
    if ((++sp & 255u) == 0u) { if (xb_ld(&bar[XB_TMO])) break; if (sp > XB_SPIN_CAP) { atomicAdd(&bar[XB_TMO], 1u); break; } }
  }
  nloc = mine > 0u ? mine : 1u; nx = cnt > 0u ? cnt : 1u;
}
DI void xcd_barrier(const XcdBarrier& b) {
  asm volatile("s_waitcnt vmcnt(0)" ::: "memory");
  __syncthreads();
  if (threadIdx.x == 0) {
    unsigned* bar = b.bar;
    __builtin_amdgcn_s_waitcnt(0);
    unsigned nloc = b.st[0], nx = b.st[1];
    if (nloc == 0u) { xcd_barrier_complete(bar, b.x, nloc, nx); b.st[0] = nloc; b.st[1] = nx; }
    const unsigned old = xb_add(&bar[XB_XSUB(b.x)], 1u);
    const unsigned gen = old / nloc;
    if (old + 1u == (gen + 1u) * nloc) {
      __builtin_amdgcn_fence(__ATOMIC_RELEASE, "agent");
      asm volatile("s_waitcnt vmcnt(0)" ::: "memory");
      const unsigned og = xb_add(&bar[XB_TOP], 1u);
      const unsigned tg = og / nx;
      if (og + 1u == (tg + 1u) * nx) xb_add(&bar[XB_TOPGEN], 1u);
      else XB_SPIN(xb_ld(&bar[XB_TOPGEN]) == tg, bar);
      __builtin_amdgcn_fence(__ATOMIC_ACQUIRE, "agent");
      xb_add(&bar[XB_XGEN(b.x)], 1u);
      asm volatile("s_waitcnt vmcnt(0)" ::: "memory");
    } else {
      XB_SPIN(xb_ld(&bar[XB_XGEN(b.x)]) == gen, bar);
      __builtin_amdgcn_fence(__ATOMIC_ACQUIRE, "agent");
      asm volatile("s_waitcnt vmcnt(0)" ::: "memory");
    }
  }
  __syncthreads();
}

constexpr int MEGA_LDS = HG_LDS > GEMM_LDS ? HG_LDS : GEMM_LDS;
__global__ void __launch_bounds__(256, 2) mega_kernel(Params p) {
  __shared__ __attribute__((aligned(16))) char smem[MEGA_LDS];
  __shared__ uint4 xb_words;
  __shared__ int s_item;
  __shared__ int s_xm[4];
  cg::grid_group grid = cg::this_grid();
  const int bid = blockIdx.x, nblk = gridDim.x;
  if (threadIdx.x == 0) xb_words = make_uint4(0u, 0u, 0u, 0u);
  __syncthreads();
  unsigned my_rank;
  XcdBarrier xb = xcd_barrier_post(p.bar, (volatile LAS unsigned*)&xb_words, my_rank);
  if (p.out == nullptr) grid.sync();
  phase0(p, smem, bid, nblk);
#if PROBE_P0
  phase0(p, smem, bid, nblk);
#endif
  xcd_barrier(xb);
  if (threadIdx.x == 0) {
    unsigned sum = 0;
#pragma unroll
    for (int j = 0; j < 8; ++j) sum += xb_ld(&p.bar[XB_XCNT(j)]);
    const bool ok = sum == (unsigned)nblk && xb.x < 8u && xb_words.y == 8u;
    s_xm[0] = ok ? (int)xb.x : -1; s_xm[1] = (int)my_rank; s_xm[2] = (int)xb_words.x;
  }
  __syncthreads();
  XMap xm; xm.xcc = s_xm[0]; xm.rank = s_xm[1]; xm.nloc = s_xm[2];
  phase1(p, smem, bid, nblk, xm);
  xcd_barrier(xb);
  for (int it = bid; it < 64; it += nblk) hgrn_item(p, smem, it);
  for (;;) {
    __syncthreads();
    if (threadIdx.x == 0) s_item = atomicAdd(p.ctr, 1);
    __syncthreads();
    const int it = __builtin_amdgcn_readfirstlane(s_item);
    if (it >= 2048 * (1 + PROBE_AT)) break;
    attn_item(p, smem, it & 2047);
  }
  xcd_barrier(xb);
  phase_mix(p, bid, nblk);
#if PROBE_MIX
  phase_mix(p, bid, nblk);
#endif
  xcd_barrier(xb);
  phase3(p, smem, bid, nblk, xm);
  xcd_barrier(xb);
  phase4(p, bid, nblk);
}

__global__ __launch_bounds__(256) void k_phase0(Params p) { __shared__ __attribute__((aligned(16))) char smem[64 * 65 * 4]; phase0(p, smem, blockIdx.x, gridDim.x); }
__global__ __launch_bounds__(256) void k_phase1(Params p) { __shared__ __attribute__((aligned(16))) char smem[GEMM_LDS]; XMap xm; xm.xcc = -1; xm.rank = 0; xm.nloc = 1; phase1(p, smem, blockIdx.x, gridDim.x, xm); }
__global__ __launch_bounds__(256) void k_attn(Params p) { __shared__ __attribute__((aligned(16))) char smem[ATT_LDS]; for (int it = blockIdx.x; it < 2048; it += gridDim.x) attn_item(p, smem, it); }
__global__ __launch_bounds__(256) void k_hgrn(Params p) { __shared__ __attribute__((aligned(16))) char smem[HG_LDS]; for (int it = blockIdx.x; it < 64; it += gridDim.x) hgrn_item(p, smem, it); }
__global__ __launch_bounds__(256) void k_mix(Params p) { phase_mix(p, blockIdx.x, gridDim.x); }
__global__ __launch_bounds__(256) void k_phase3(Params p) { __shared__ __attribute__((aligned(16))) char smem[GEMM_LDS]; XMap xm; xm.xcc = -1; xm.rank = 0; xm.nloc = 1; phase3(p, smem, blockIdx.x, gridDim.x, xm); }
__global__ __launch_bounds__(256) void k_phase4(Params p) { phase4(p, blockIdx.x, gridDim.x); }

extern "C" void kernel_launch(void* const* d_in, const int* in_sizes, int n_in, void* d_out, int out_size, void* d_ws, size_t ws_size,
                              hipStream_t stream) {
  Params p{};
  p.x = (const float*)d_in[0]; p.w_in = (const float*)d_in[1]; p.q_norm_w = (const float*)d_in[2]; p.k_norm_w = (const float*)d_in[3];
  p.attn_norm_w = (const float*)d_in[4]; p.lb_logits = (const float*)d_in[5]; p.hg_norm_w = (const float*)d_in[6];
  p.w_out = (const float*)d_in[7]; p.ln_w = (const float*)d_in[8]; p.ln_b = (const float*)d_in[9];
  p.out = (float*)d_out;
  char* ws = (char*)d_ws;
  size_t off = 0;
  auto take = [&](size_t bytes) { char* r = ws + off; off += (bytes + 255) & ~(size_t)255; return r; };
  p.xb = (u16*)take((size_t)MTOK * 1024 * 2);
  p.winT = (u16*)take((size_t)INW * 1024 * 2);
  p.woutT = (u16*)take((size_t)1024 * 1024 * 2);
  p.rope = (float2*)take(1024 * 8);
  p.lbv = (float*)take(1024 * 4);
  p.q = (u16*)take((size_t)MTOK * 512 * 2);
  p.k = (u16*)take((size_t)MTOK * 128 * 2);
  p.vT = (u16*)take((size_t)MTOK * 128 * 2);
  p.ga = (u16*)take((size_t)MTOK * 512 * 2);
  p.hq = (u16*)take((size_t)MTOK * 512 * 2);
  p.hi = (u16*)take((size_t)MTOK * 512 * 2);
  p.lff = (u16*)take((size_t)MTOK * 512 * 4);
  p.lfb = (u16*)take((size_t)MTOK * 512 * 4);
  p.gh = (u16*)take((size_t)MTOK * 512 * 2);
  p.attn = (u16*)take((size_t)MTOK * 512 * 2);
  p.of = (u16*)take((size_t)MTOK * 512 * 2);
  p.ob = (u16*)take((size_t)MTOK * 512 * 2);
  p.ctr = (int*)take(256);
  p.bar = (unsigned*)take(XCD_BAR_WORDS * 4);
  p.mix = p.hq;
  p.z = (float*)p.lff;
  if (off > ws_size) { fprintf(stderr, "workspace too small: need %zu have %zu\n", off, ws_size); return; }
#if ONE_LAUNCH
  static int grid_blocks = 0;
  if (!grid_blocks) {
    int dev = 0, cus = 0, per_cu = 0;
    hipGetDevice(&dev);
    hipDeviceGetAttribute(&cus, hipDeviceAttributeMultiprocessorCount, dev);
    hipOccupancyMaxActiveBlocksPerMultiprocessor(&per_cu, mega_kernel, 256, 0);
    if (per_cu > 2) per_cu = 2;
    grid_blocks = cus * per_cu;
    if (grid_blocks < 64) fprintf(stderr, "grid too small: %d\n", grid_blocks);
  }
  hipMemsetAsync(p.ctr, 0, 256 + ((XCD_BAR_WORDS * 4 + 255) & ~255), stream);
  void* args[] = {&p};
  hipError_t e = hipLaunchCooperativeKernel((void*)mega_kernel, dim3(grid_blocks), dim3(256), args, 0, stream);
  if (e != hipSuccess) fprintf(stderr, "cooperative launch failed: %s (grid %d)\n", hipGetErrorString(e), grid_blocks);
#else
  k_phase0<<<1024, 256, 0, stream>>>(p);
  k_phase1<<<512, 256, 0, stream>>>(p);
  k_attn<<<2048, 256, 0, stream>>>(p);
  k_hgrn<<<64, 256, 0, stream>>>(p);
  k_mix<<<2048, 256, 0, stream>>>(p);
  k_phase3<<<512, 256, 0, stream>>>(p);
  k_phase4<<<2048, 256, 0, stream>>>(p);
#endif
}
```

```cpp
#include <hip/hip_runtime.h>
#include <hip/hip_cooperative_groups.h>
#include <stdint.h>
#include <stdio.h>

namespace cg = cooperative_groups;

#ifndef ONE_LAUNCH
#define ONE_LAUNCH 1
#endif
#ifndef PROBE_P0
#define PROBE_P0 0
#endif
#ifndef PROBE_MIX
#define PROBE_MIX 0
#endif
#ifndef PROBE_P1
#define PROBE_P1 0
#endif
#ifndef PROBE_HG
#define PROBE_HG 0
#endif
#ifndef PROBE_AT
#define PROBE_AT 0
#endif
#ifndef PROBE_P3
#define PROBE_P3 0
#endif

typedef __attribute__((ext_vector_type(8))) short bf16x8;
typedef __attribute__((ext_vector_type(4))) short s16x4;
typedef __attribute__((ext_vector_type(16))) float f32x16;
typedef unsigned short u16;
typedef __attribute__((ext_vector_type(4))) unsigned u32x4;
typedef __attribute__((ext_vector_type(2))) unsigned u32x2;

#define DI __device__ __forceinline__
#define MFMA32(a, b, c) __builtin_amdgcn_mfma_f32_32x32x16_bf16((a), (b), (c), 0, 0, 0)

constexpr int MTOK = 32768;
constexpr int SEQ = 4096;
constexpr int DM = 1024;
constexpr int INW = 3840;
constexpr float Q_PRESCALE = 0.125f * 1.4426950408889634f;
constexpr float HQ_SCALE = 0.08838834764831845f;
constexpr float DN_ALPHA = 1.189207115002721f;

struct Params {
  const float* x; const float* w_in; const float* q_norm_w; const float* k_norm_w;
  const float* attn_norm_w; const float* lb_logits; const float* hg_norm_w; const float* w_out;
  const float* ln_w; const float* ln_b;
  float* out;
  u16* xb;
  u16* winT;
  u16* woutT;
  float2* rope;
  float* lbv;
  u16* q;
  u16* k;
  u16* vT;
  u16* ga;
  u16* hq;
  u16* hi;
  u16* lff;
  u16* lfb;
  u16* gh;
  u16* attn;
  u16* of;
  u16* ob;
  int* ctr;
  unsigned* bar;
  u16* mix;
  float* z;
};

DI u16 f2bf(float x) { uint32_t u = __float_as_uint(x); u += 0x7fffu + ((u >> 16) & 1u); return (u16)(u >> 16); }
DI float bf2f(u16 v) { return __uint_as_float(((uint32_t)v) << 16); }
typedef __attribute__((ext_vector_type(2))) float f32x2_t;
typedef __attribute__((ext_vector_type(2))) __bf16 bf16x2_t;
DI uint32_t pack2(float a, float b) { f32x2_t v = {a, b}; bf16x2_t r = __builtin_convertvector(v, bf16x2_t); return __builtin_bit_cast(uint32_t, r); }
typedef __attribute__((ext_vector_type(2))) _Float16 f16x2_t;
DI uint32_t pack2h(float a, float b) { f16x2_t r = {(_Float16)a, (_Float16)b}; return __builtin_bit_cast(uint32_t, r); }
DI float h2f_lo(uint32_t u) { return (float)__builtin_bit_cast(f16x2_t, u)[0]; }
DI float h2f_hi(uint32_t u) { return (float)__builtin_bit_cast(f16x2_t, u)[1]; }
DI int crow(int i, int h) { return (i & 3) + 8 * (i >> 2) + 4 * h; }
DI float silu_f(float v) { return v * __builtin_amdgcn_rcpf(1.f + __expf(-v)); }

__device__ void phase0(const Params& p, char* smem, int bid, int nblk) {
  const int tid = threadIdx.x;
  {
    const size_t nvec = (size_t)MTOK * DM / 8;
    const size_t T = (size_t)nblk * 256;
    for (size_t i = (size_t)bid * 256 + tid; i < nvec; i += 4 * T) {
      float4 a[4], b[4];
#pragma unroll
      for (int u = 0; u < 4; ++u) {
        const size_t ii = i + u * T;
        if (ii < nvec) { a[u] = ((const float4*)p.x)[2 * ii]; b[u] = ((const float4*)p.x)[2 * ii + 1]; }
      }
#pragma unroll
      for (int u = 0; u < 4; ++u) {
        const size_t ii = i + u * T;
        if (ii < nvec) {
          uint4 o; o.x = pack2(a[u].x, a[u].y); o.y = pack2(a[u].z, a[u].w); o.z = pack2(b[u].x, b[u].y); o.w = pack2(b[u].z, b[u].w);
          ((uint4*)p.xb)[ii] = o;
        }
      }
    }
  }
  {
    float* t = (float*)smem;
    const int ntile_in = 16 * 60, ntile_all = ntile_in + 16 * 16;
    for (int tile = bid; tile < ntile_all; tile += nblk) {
      const float* src; u16* dst; int N, kt, nt;
      if (tile < ntile_in) { src = p.w_in; dst = p.winT; N = INW; kt = tile / 60; nt = tile % 60; }
      else { int tt = tile - ntile_in; src = p.w_out; dst = p.woutT; N = DM; kt = tt / 16; nt = tt % 16; }
      __syncthreads();
#pragma unroll
      for (int j = 0; j < 4; ++j) {
        const int kk = (tid >> 4) + 16 * j, nn = (tid & 15) * 4;
        const float4 v = *(const float4*)(src + (size_t)(kt * 64 + kk) * N + nt * 64 + nn);
        t[kk * 65 + nn] = v.x; t[kk * 65 + nn + 1] = v.y; t[kk * 65 + nn + 2] = v.z; t[kk * 65 + nn + 3] = v.w;
      }
      __syncthreads();
      const int n = tid >> 2, kc = (tid & 3) * 16;
      uint32_t o[8];
#pragma unroll
      for (int j = 0; j < 8; ++j) o[j] = pack2(t[(kc + 2 * j) * 65 + n], t[(kc + 2 * j + 1) * 65 + n]);
      uint4* d = (uint4*)(dst + (size_t)(nt * 64 + n) * 1024 + kt * 64 + kc);
      d[0] = make_uint4(o[0], o[1], o[2], o[3]);
      d[1] = make_uint4(o[4], o[5], o[6], o[7]);
    }
  }
  for (int i = bid * 256 + tid; i < 2048; i += nblk * 256) {
    if (i < 1024) {
      const int pos = i >> 4, j = i & 15;
      const float inv = powf(10000.f, -(float)(2 * j) / 32.f);
      const float ang = (float)pos * inv;
      p.rope[i] = make_float2(cosf(ang), sinf(ang));
    } else {
      const int ii = i - 1024, dir = ii >> 9, wcol = ii & 511;
      const float l0 = p.lb_logits[(dir * 2 + 0) * 512 + wcol], l1 = p.lb_logits[(dir * 2 + 1) * 512 + wcol];
      const float mx = fmaxf(l0, l1);
      const float e0 = expf(l0 - mx), e1 = expf(l1 - mx);
      p.lbv[ii] = e0 / (e0 + e1);
    }
  }
}

constexpr int GP = 72;
constexpr int EP = 136;
constexpr int EPF = 132;
constexpr int GEMM_LDS = 2 * 2 * 128 * GP * 2;

DI void gemm_issue(const u16* __restrict__ A, const u16* __restrict__ B, int n0, int m0,
                   u32x4 (&ra0)[4], u32x4 (&rb0)[4], u32x4 (&ra1)[4], u32x4 (&rb1)[4]) {
  const int tid = threadIdx.x;
  const int lc = tid & 7, lr = tid >> 3;
  const u16* gA = A + (size_t)(n0 + lr) * 1024 + lc * 8;
  const u16* gB = B + (size_t)(m0 + lr) * 1024 + lc * 8;
#pragma unroll
  for (int j = 0; j < 4; ++j) { ra0[j] = *(const u32x4*)(gA + (size_t)j * 32 * 1024); rb0[j] = *(const u32x4*)(gB + (size_t)j * 32 * 1024); }
#pragma unroll
  for (int j = 0; j < 4; ++j) { ra1[j] = *(const u32x4*)(gA + (size_t)j * 32 * 1024 + 64); rb1[j] = *(const u32x4*)(gB + (size_t)j * 32 * 1024 + 64); }
}
DI void gemm_run(const u16* __restrict__ A, const u16* __restrict__ B, int n0, int m0, char* smem, f32x16 (&acc)[2][2],
                 u32x4 (&ra0)[4], u32x4 (&rb0)[4], u32x4 (&ra1)[4], u32x4 (&rb1)[4]) {
  const int tid = threadIdx.x, lane = tid & 63, w = __builtin_amdgcn_readfirstlane(tid >> 6);
  const int wn = w & 1, wm = w >> 1;
  const int lc = tid & 7, lr = tid >> 3;
  u16* sm = (u16*)smem;
  const u16* gA = A + (size_t)(n0 + lr) * 1024 + lc * 8;
  const u16* gB = B + (size_t)(m0 + lr) * 1024 + lc * 8;
#pragma unroll
  for (int a = 0; a < 2; ++a)
#pragma unroll
    for (int b = 0; b < 2; ++b)
#pragma unroll
      for (int i = 0; i < 16; ++i) acc[a][b][i] = 0.f;
  u32x4 ra2[4], rb2[4];
#define GEMM_LOAD(RA, RB, KT) _Pragma("unroll") for (int j = 0; j < 4; ++j) { \
    RA[j] = *(const u32x4*)(gA + (size_t)j * 32 * 1024 + (KT) * 64); RB[j] = *(const u32x4*)(gB + (size_t)j * 32 * 1024 + (KT) * 64); }
#define GEMM_STORE(RA, RB, ST) _Pragma("unroll") for (int j = 0; j < 4; ++j) { \
    *(u32x4*)(sm + (((ST) * 2 + 0) * 128 + lr + 32 * j) * GP + lc * 8) = RA[j]; *(u32x4*)(sm + (((ST) * 2 + 1) * 128 + lr + 32 * j) * GP + lc * 8) = RB[j]; }
  GEMM_LOAD(ra2, rb2, 2)
  __syncthreads();
  GEMM_STORE(ra0, rb0, 0)
  __syncthreads();
  const int fr = lane & 31, fh = lane >> 5;
  const u16* fa = sm + (wn * 64 + fr) * GP + fh * 8;
  const u16* fb = sm + (128 + wm * 64 + fr) * GP + fh * 8;
#define GEMM_COMPUTE(ST)                                                                          \
  _Pragma("unroll") for (int ks = 0; ks < 4; ++ks) {                                              \
    bf16x8 af[2], bfr[2];                                                                         \
    _Pragma("unroll") for (int a = 0; a < 2; ++a) af[a] = *(const bf16x8*)(fa + ((ST) * 256 + a * 32) * GP + ks * 16);   \
    _Pragma("unroll") for (int b = 0; b < 2; ++b) bfr[b] = *(const bf16x8*)(fb + ((ST) * 256 + b * 32) * GP + ks * 16);  \
    _Pragma("unroll") for (int a = 0; a < 2; ++a)                                                 \
      _Pragma("unroll") for (int b = 0; b < 2; ++b) acc[a][b] = MFMA32(af[a], bfr[b], acc[a][b]); \
  }
#define GEMM_SUB(K, RAL, RBL, RAW, RBW)                                   \
  {                                                                       \
    if ((K) + 3 < 16) { GEMM_LOAD(RAL, RBL, (K) + 3) }                    \
    GEMM_COMPUTE((K) & 1)                                                 \
    if ((K) + 1 < 16) { GEMM_STORE(RAW, RBW, ((K) + 1) & 1) }             \
    __syncthreads();                                                      \
  }
  GEMM_SUB(0, ra0, rb0, ra1, rb1)
  GEMM_SUB(1, ra1, rb1, ra2, rb2)
  GEMM_SUB(2, ra2, rb2, ra0, rb0)
  GEMM_SUB(3, ra0, rb0, ra1, rb1)
  GEMM_SUB(4, ra1, rb1, ra2, rb2)
  GEMM_SUB(5, ra2, rb2, ra0, rb0)
  GEMM_SUB(6, ra0, rb0, ra1, rb1)
  GEMM_SUB(7, ra1, rb1, ra2, rb2)
  GEMM_SUB(8, ra2, rb2, ra0, rb0)
  GEMM_SUB(9, ra0, rb0, ra1, rb1)
  GEMM_SUB(10, ra1, rb1, ra2, rb2)
  GEMM_SUB(11, ra2, rb2, ra0, rb0)
  GEMM_SUB(12, ra0, rb0, ra1, rb1)
  GEMM_SUB(13, ra1, rb1, ra2, rb2)
  GEMM_SUB(14, ra2, rb2, ra0, rb0)
  GEMM_SUB(15, ra0, rb0, ra1, rb1)
#undef GEMM_SUB
#undef GEMM_COMPUTE
#undef GEMM_LOAD
#undef GEMM_STORE
}

struct XMap { int xcc, rank, nloc; };
__device__ __forceinline__ void p1_tile(const Params& p, char* smem, const int mt, const int nt) {
  const int lane = threadIdx.x & 63, w = threadIdx.x >> 6;
  const int wn = w & 1, wm = w >> 1;
  const int r0 = lane & 31, h0 = lane >> 5;
    f32x16 acc[2][2];
    {
      u32x4 ra0[4], rb0[4], ra1[4], rb1[4];
      gemm_issue(p.winT, p.xb, nt * 128, mt * 128, ra0, rb0, ra1, rb1);
      gemm_run(p.winT, p.xb, nt * 128, mt * 128, smem, acc, ra0, rb0, ra1, rb1);
    }
    {
    int r = r0, h = h0;
    asm volatile("" : "+v"(r), "+v"(h));
    u16* T = (u16*)smem;
    const int mbase = mt * 128 + wm * 64;
    if (nt <= 4) {
      const bool isq = nt < 4;
      const float* nw = isq ? p.q_norm_w : p.k_norm_w;
      const float sc = isq ? Q_PRESCALE : 1.0f;
#pragma unroll
      for (int b = 0; b < 2; ++b) {
        const int m = mbase + b * 32 + r;
        const int s = m & 4095;
        const int rp = s >> 6, cp = s & 63;
        float ss = 0.f;
#pragma unroll
        for (int a = 0; a < 2; ++a)
#pragma unroll
          for (int i = 0; i < 16; ++i) ss += acc[a][b][i] * acc[a][b][i];
        ss += __shfl_xor(ss, 32);
        const float rstd = rsqrtf(ss * (1.f / 64.f) + 1e-6f);
        u16* trow = T + (wm * 64 + b * 32 + r) * EP + wn * 64 + 4 * h;
#pragma unroll
        for (int a = 0; a < 2; ++a) {
          const int pos = a == 0 ? rp : cp;
          float y[16], o[16];
#pragma unroll
          for (int i = 0; i < 16; ++i) y[i] = acc[a][b][i] * rstd * nw[a * 32 + crow(i, h)];
#pragma unroll
          for (int i = 0; i < 8; ++i) {
            const float2 cs = p.rope[pos * 16 + crow(i, h)];
            o[i] = (y[i] * cs.x - y[i + 8] * cs.y) * sc;
            o[i + 8] = (y[i + 8] * cs.x + y[i] * cs.y) * sc;
          }
#pragma unroll
          for (int g = 0; g < 4; ++g) {
            u32x2 v; v.x = pack2(o[4 * g], o[4 * g + 1]); v.y = pack2(o[4 * g + 2], o[4 * g + 3]);
            *(u32x2*)(trow + a * 32 + 8 * g) = v;
          }
        }
      }
    } else if (nt == 5) {
#pragma unroll
      for (int b = 0; b < 2; ++b)
#pragma unroll
        for (int a = 0; a < 2; ++a)
#pragma unroll
          for (int i = 0; i < 16; ++i) T[(wn * 64 + a * 32 + crow(i, h)) * EP + wm * 64 + b * 32 + r] = f2bf(acc[a][b][i]);
    } else {
      const int gi = (nt - 6) >> 2;
      const int cb = ((nt - 6) & 3) * 128 + wn * 64;
#pragma unroll
      for (int b = 0; b < 2; ++b) {
        u16* trow = T + (wm * 64 + b * 32 + r) * EP + wn * 64 + 4 * h;
#pragma unroll
        for (int a = 0; a < 2; ++a)
#pragma unroll
          for (int g = 0; g < 4; ++g) {
            float v[4];
#pragma unroll
            for (int e = 0; e < 4; ++e) v[e] = acc[a][b][4 * g + e];
            u32x2 o;
            if (gi == 3 || gi == 4) {
              const float4 lb = *(const float4*)(p.lbv + (gi - 3) * 512 + cb + a * 32 + 8 * g + 4 * h);
              const float ox = __builtin_amdgcn_logf(lb.x + (1.f - lb.x) * __builtin_amdgcn_rcpf(1.f + __expf(-v[0])));
              const float oy = __builtin_amdgcn_logf(lb.y + (1.f - lb.y) * __builtin_amdgcn_rcpf(1.f + __expf(-v[1])));
              const float oz = __builtin_amdgcn_logf(lb.z + (1.f - lb.z) * __builtin_amdgcn_rcpf(1.f + __expf(-v[2])));
              const float ow = __builtin_amdgcn_logf(lb.w + (1.f - lb.w) * __builtin_amdgcn_rcpf(1.f + __expf(-v[3])));
              o.x = pack2h(ox, oy); o.y = pack2h(oz, ow);
            } else {
              if (gi == 0 || gi == 5) {
#pragma unroll
                for (int e = 0; e < 4; ++e) v[e] = silu_f(v[e]);
              } else if (gi == 1) {
#pragma unroll
                for (int e = 0; e < 4; ++e) v[e] = silu_f(v[e]) * HQ_SCALE;
              }
              o.x = pack2(v[0], v[1]); o.y = pack2(v[2], v[3]);
            }
            *(u32x2*)(trow + a * 32 + 8 * g) = o;
          }
      }
    }
    __syncthreads();
    {
      const int tid = threadIdx.x;
      const int ch = tid & 15, rw = tid >> 4;
      const int bi = (mt * 128) >> 12, s0 = (mt * 128) & 4095;
      u16* dbase; size_t rstride;
      if (nt < 4)       { dbase = p.q + ((size_t)(bi * 8 + nt * 2 + (ch >> 3)) * SEQ + s0) * 64 + (ch & 7) * 8; rstride = 64; }
      else if (nt == 4) { dbase = p.k + ((size_t)(bi * 2 + (ch >> 3)) * SEQ + s0) * 64 + (ch & 7) * 8; rstride = 64; }
      else if (nt == 5) { dbase = p.vT + (size_t)(bi * 2) * 64 * SEQ + s0 + ch * 8; rstride = SEQ; }
      else {
        const int gi = (nt - 6) >> 2;
        u16* gb = gi == 0 ? p.ga : gi == 1 ? p.hq : gi == 2 ? p.hi : gi == 3 ? p.lff : gi == 4 ? p.lfb : p.gh;
        dbase = gb + (size_t)(mt * 128) * 512 + ((nt - 6) & 3) * 128 + ch * 8; rstride = 512;
      }
#pragma unroll
      for (int j = 0; j < 8; ++j) {
        const int row = j * 16 + rw;
        const u32x4 v = *(const u32x4*)(T + row * EP + ch * 8);
        *(u32x4*)(dbase + (size_t)row * rstride) = v;
      }
    }
    }
}

__device__ void phase1(const Params& p, char* smem, int bid, int nblk, const XMap xm) {
  const int ntiles = xm.xcc >= 0 ? 704 : (MTOK / 128) * 22;
  const int tstep = xm.xcc >= 0 ? xm.nloc : nblk;
  for (int tile = xm.xcc >= 0 ? xm.rank : bid; tile < ntiles; tile += tstep) {
    int mt, j;
    if (xm.xcc >= 0) {
      int ml;
      if (tile < 512) { const int g = tile >> 8, rem = tile & 255, c = rem >> 6, q = rem & 63; ml = c * 8 + (q >> 3); j = g * 8 + (q & 7); }
      else { const int t2 = tile - 512, c = t2 / 48, q = t2 % 48; ml = c * 8 + q / 6; j = 16 + q % 6; }
      mt = xm.xcc * 32 + ml;
    } else { mt = tile / 22; j = tile % 22; }
    const int nt = j < 6 ? j : j + 4;
    p1_tile(p, smem, mt, nt);
  }
}

constexpr int AP = 72;
constexpr int ATT_LDS = 2 * 2 * 64 * AP * 2;
DI float fast_exp2(float x) { return __builtin_amdgcn_exp2f(x); }

__device__ void attn_item(const Params& p, char* smem, int item) {
  const int tid = threadIdx.x, lane = tid & 63, w = __builtin_amdgcn_readfirstlane(tid >> 6), r = lane & 31, h = lane >> 5;
  const int qb = item & 31, head = (item >> 5) & 7, bi = item >> 8;
  const int kvh = head >> 2;
  const int q0 = qb * 128 + w * 32;
  u16* sm = (u16*)smem;
  bf16x8 qf[4];
  {
    const u16* qp = p.q + ((size_t)(bi * 8 + head) * SEQ + q0 + r) * 64 + h * 8;
#pragma unroll
    for (int ks = 0; ks < 4; ++ks) qf[ks] = *(const bf16x8*)(qp + ks * 16);
  }
  const int lc = tid & 7, lr = tid >> 3;
  const u16* kg = p.k + (size_t)(bi * 2 + kvh) * SEQ * 64 + (size_t)lr * 64 + lc * 8;
  const u16* vg = p.vT + (size_t)(bi * 2 + kvh) * 64 * SEQ + (size_t)lr * SEQ + lc * 8;
  const int kw = lr * AP + lc * 8;
  const int vw = lr * AP + (lc >> 1) * 16 + (lc & 1) * 4;
  u32x4 rkA[2], rvA[2], rkB[2], rvB[2];
#define ATT_LOADK(RK, T) _Pragma("unroll") for (int j = 0; j < 2; ++j) RK[j] = *(const u32x4*)(kg + (size_t)((T) * 64 + j * 32) * 64);
#define ATT_LOADV(RV, T) _Pragma("unroll") for (int j = 0; j < 2; ++j) RV[j] = *(const u32x4*)(vg + (size_t)j * 32 * SEQ + (T) * 64);
#define ATT_STOREK(RK, S) _Pragma("unroll") for (int j = 0; j < 2; ++j) *(u32x4*)(sm + (S) * 64 * AP + kw + j * 32 * AP) = RK[j];
#define ATT_STOREV(RV, S) _Pragma("unroll") for (int j = 0; j < 2; ++j) { u16* vd = sm + (2 + (S)) * 64 * AP + vw + j * 32 * AP; *(u32x2*)(vd) = RV[j].xy; *(u32x2*)(vd + 8) = RV[j].zw; }
#define ATT_QK(DST, S)                                                                      \
  _Pragma("unroll") for (int kt2 = 0; kt2 < 2; ++kt2) {                                     \
    _Pragma("unroll") for (int i = 0; i < 16; ++i) DST[kt2][i] = MINIT;                     \
    _Pragma("unroll") for (int ks = 0; ks < 4; ++ks) {                                      \
      const bf16x8 kf = *(const bf16x8*)(sm + (S) * 64 * AP + (kt2 * 32 + r) * AP + ks * 16 + h * 8); \
      DST[kt2] = MFMA32(kf, qf[ks], DST[kt2]);                                              \
    }                                                                                       \
  }
  ATT_LOADK(rkA, 0) ATT_LOADV(rvA, 0)
  ATT_LOADK(rkB, 1)
  __syncthreads();
  ATT_STOREK(rkA, 0) ATT_STOREV(rvA, 0)
  ATT_STOREK(rkB, 1)
  ATT_LOADK(rkA, 2) ATT_LOADV(rvA, 1)
  __syncthreads();
  f32x16 o[2];
#pragma unroll
  for (int dt = 0; dt < 2; ++dt)
#pragma unroll
    for (int i = 0; i < 16; ++i) o[dt][i] = 0.f;
  float mrun = 0.f, lsum = 0.f;
  f32x16 sa[2], sb[2];
  { const float MINIT = 0.f; ATT_QK(sa, 0) }
  __syncthreads();
#define ATT_STEP(CUR, NXT, T, RKW, RVW, RKL, RVL)                                           \
  {                                                                                         \
    const int t_ = (T);                                                                     \
    if (t_ + 3 < 64) { ATT_LOADK(RKL, t_ + 3) }     \
    if (t_ + 2 < 64) { ATT_LOADV(RVL, t_ + 2) }                                             \
    const float mref_ = mrun;                    \
    float mx = CUR[0][0];                                                                   \
    _Pragma("unroll") for (int i = 1; i < 16; ++i) mx = fmaxf(mx, CUR[0][i]);               \
    _Pragma("unroll") for (int i = 0; i < 16; ++i) mx = fmaxf(mx, CUR[1][i]);               \
    mx = fmaxf(mx, __shfl_xor(mx, 32));                                                     \
    float shift = 0.f;                                                                      \
    if (t_ == 0 || __any(mx > 0.f)) {     \
      shift = t_ == 0 ? mx : fmaxf(mx, 0.f);                                                \
      const float al = fast_exp2(-shift);                                                   \
      lsum *= al;                                                                           \
      _Pragma("unroll") for (int dt = 0; dt < 2; ++dt)                                      \
        _Pragma("unroll") for (int i = 0; i < 16; ++i) o[dt][i] *= al;                      \
      mrun = mref_ + shift;                                                                 \
      _Pragma("unroll") for (int kt2 = 0; kt2 < 2; ++kt2)                                   \
        _Pragma("unroll") for (int i = 0; i < 16; ++i) CUR[kt2][i] -= shift;                \
    }                                                                                       \
    if (t_ + 1 < 64) { const float MINIT = -mrun; ATT_QK(NXT, (t_ + 1) & 1) }               \
    _Pragma("unroll") for (int kt2 = 0; kt2 < 2; ++kt2)                                     \
      _Pragma("unroll") for (int i = 0; i < 16; ++i) { const float e = fast_exp2(CUR[kt2][i]); CUR[kt2][i] = e; lsum += e; } \
    _Pragma("unroll") for (int s2 = 0; s2 < 4; ++s2) {                                      \
      u32x4 pk;                                                                             \
      pk.x = pack2(CUR[s2 >> 1][8 * (s2 & 1) + 0], CUR[s2 >> 1][8 * (s2 & 1) + 1]);         \
      pk.y = pack2(CUR[s2 >> 1][8 * (s2 & 1) + 2], CUR[s2 >> 1][8 * (s2 & 1) + 3]);         \
      pk.z = pack2(CUR[s2 >> 1][8 * (s2 & 1) + 4], CUR[s2 >> 1][8 * (s2 & 1) + 5]);         \
      pk.w = pack2(CUR[s2 >> 1][8 * (s2 & 1) + 6], CUR[s2 >> 1][8 * (s2 & 1) + 7]);         \
      const bf16x8 pf = __builtin_bit_cast(bf16x8, pk);                                     \
      _Pragma("unroll") for (int dt = 0; dt < 2; ++dt) {                                    \
        const bf16x8 vf = *(const bf16x8*)(sm + (2 + (t_ & 1)) * 64 * AP + (dt * 32 + r) * AP + s2 * 16 + h * 8); \
        o[dt] = MFMA32(vf, pf, o[dt]);                                                      \
      }                                                                                     \
    }                                                                                       \
    if (t_ + 2 < 64) { ATT_STOREK(RKW, t_ & 1) }                                            \
    if (t_ + 1 < 64) { ATT_STOREV(RVW, (t_ + 1) & 1) }                                      \
    __syncthreads();                                                                        \
  }
  for (int t = 0; t < 64; t += 2) {
    ATT_STEP(sa, sb, t, rkA, rvA, rkB, rvB)
    ATT_STEP(sb, sa, t + 1, rkB, rvB, rkA, rvA)
  }
#undef ATT_STEP
#undef ATT_QK
#undef ATT_LOADK
#undef ATT_LOADV
#undef ATT_STOREK
#undef ATT_STOREV
  lsum += __shfl_xor(lsum, 32);
  const float il = 1.f / lsum;
  u16* op = p.attn + ((size_t)bi * SEQ + q0 + r) * 512 + head * 64 + 4 * h;
#pragma unroll
  for (int dt = 0; dt < 2; ++dt)
#pragma unroll
    for (int g = 0; g < 4; ++g) {
      u32x2 v; v.x = pack2(o[dt][4 * g] * il, o[dt][4 * g + 1] * il); v.y = pack2(o[dt][4 * g + 2] * il, o[dt][4 * g + 3] * il);
      *(u32x2*)(op + dt * 32 + 8 * g) = v;
    }
}

constexpr int HQP = 136;
constexpr int HSP = 72;
constexpr int H_QM = 0;
constexpr int H_KM = H_QM + 64 * HQP * 2;
constexpr int H_KUT = H_KM + 64 * HQP * 2;
constexpr int H_IT = H_KUT + 128 * HSP * 2;
constexpr int H_F32 = H_IT + 128 * HSP * 2;
constexpr int HG_LDS = H_F32 + 7 * 128 * 4;

__device__ void hgrn_item(const Params& p, char* smem, int item) {
  const int tid = threadIdx.x, lane = tid & 63, w = __builtin_amdgcn_readfirstlane(tid >> 6), r = lane & 31, h = lane >> 5;
  const int dir = item & 1, hh = (item >> 1) & 3, bi = item >> 3;
  u16* QM = (u16*)(smem + H_QM);
  u16* KM = (u16*)(smem + H_KM);
  u16* AM = (u16*)(smem + H_KM);
  u16* KUT = (u16*)(smem + H_KUT);
  u16* IT = (u16*)(smem + H_IT);
  float* tot = (float*)(smem + H_F32);
  float* first2 = tot + 512;
  float* emid = tot + 640;
  float* dec = tot + 768;
  const u16* lf = dir ? p.lfb : p.lff;
  u16* og = dir ? p.ob : p.of;
  const int kp = lane;
  const int k16 = (2 * kp) & 15, grp = k16 >> 2;
  const int pk0 = ((2 * kp) & ~15) | ((grp == 1 ? 2 : grp == 2 ? 1 : grp) << 2) | ((2 * kp) & 3);
  const int tp = tid & 31, vc = (tid >> 5) * 16;
  f32x16 S[4];
#pragma unroll
  for (int a = 0; a < 4; ++a)
#pragma unroll
    for (int i = 0; i < 16; ++i) S[a][i] = 0.f;
  const size_t colb = (size_t)hh * 128;
  const unsigned olane = (unsigned)((dir ? 4 - 4 * h : 4 * h) * 1024 + (hh * 128 + w * 32 + r) * 2);
  uint32_t lgv[16], qv[16];
#define HG_LOAD(C)                                                                                   \
  {                                                                                                  \
    const int s0_ = dir ? SEQ - 64 * ((C) + 1) : 64 * (C);                                           \
    const size_t tb_ = (size_t)bi * SEQ + s0_;                                                       \
    _Pragma("unroll") for (int e = 0; e < 16; ++e) {                                                 \
      const int tau = 16 * w + e;                                                                    \
      const size_t tok = tb_ + (dir ? 63 - tau : tau);                                               \
      lgv[e] = *(const uint32_t*)((const char*)(lf + tok * 512 + colb) + (unsigned)(kp * 4));        \
      qv[e] = *(const uint32_t*)((const char*)(p.hq + tok * 512 + colb) + (unsigned)(kp * 4));       \
    }                                                                                                \
  }
  HG_LOAD(0)
  __syncthreads();
  for (int c0 = 0; c0 < 64 * (1 + PROBE_HG); ++c0) {
    const int c = c0 & 63;
#if PROBE_HG
    if (c0 == 64) {
#pragma unroll
      for (int a = 0; a < 4; ++a)
#pragma unroll
        for (int i = 0; i < 16; ++i) S[a][i] = 0.f;
    }
#endif
    const int s0 = dir ? SEQ - 64 * (c + 1) : 64 * c;
    const size_t tb = (size_t)bi * SEQ + s0;
    const size_t tok0 = tb + (dir ? 63 - 2 * tp : 2 * tp), tok1 = tb + (dir ? 62 - 2 * tp : 2 * tp + 1);
    const u32x4 ia0 = *(const u32x4*)(p.hi + tok0 * 512 + colb + vc), ia1 = *(const u32x4*)(p.hi + tok0 * 512 + colb + vc + 8);
    const u32x4 ib0 = *(const u32x4*)(p.hi + tok1 * 512 + colb + vc), ib1 = *(const u32x4*)(p.hi + tok1 * 512 + colb + vc + 8);
    {
      float2 run = make_float2(0.f, 0.f);
#pragma unroll
      for (int e = 0; e < 16; ++e) { run.x += h2f_lo(lgv[e]); run.y += h2f_hi(lgv[e]); }
      *(float2*)(tot + w * 128 + 2 * kp) = run;
      if (w == 2) *(float2*)(first2 + 2 * kp) = make_float2(h2f_lo(lgv[0]), h2f_hi(lgv[0]));
    }
    __syncthreads();
    {
      const float2 t0 = *(const float2*)(tot + 2 * kp), t1 = *(const float2*)(tot + 128 + 2 * kp);
      const float2 t2 = *(const float2*)(tot + 256 + 2 * kp), t3 = *(const float2*)(tot + 384 + 2 * kp);
      const float2 f2 = *(const float2*)(first2 + 2 * kp);
      float2 pre = make_float2(0.f, 0.f);
      if (w > 0) { pre.x += t0.x; pre.y += t0.y; }
      if (w > 1) { pre.x += t1.x; pre.y += t1.y; }
      if (w > 2) { pre.x += t2.x; pre.y += t2.y; }
      const float2 bmid = make_float2(t0.x + t1.x + f2.x, t0.y + t1.y + f2.y);
      const float2 blast = make_float2(t0.x + t1.x + t2.x + t3.x, t0.y + t1.y + t2.y + t3.y);
      const float ccx = fast_exp2(blast.x - bmid.x), ccy = fast_exp2(blast.y - bmid.y);
      uint32_t kux[8], kuy[8];
      float pkx = 0.f, pky = 0.f;
      float2 run = make_float2(pre.x - bmid.x, pre.y - bmid.y);
#pragma unroll
      for (int e = 0; e < 16; ++e) {
        const float lgx = h2f_lo(lgv[e]), lgy = h2f_hi(lgv[e]);
        run.x += lgx; run.y += lgy;
        const float rx = run.x, ry = run.y;
        const float e1x = fast_exp2(rx), e1y = fast_exp2(ry), e2x = fast_exp2(-rx), e2y = fast_exp2(-ry);
        const float gx = 1.f - fast_exp2(lgx), gy = 1.f - fast_exp2(lgy);
        const float qx = __uint_as_float(qv[e] << 16), qy = __uint_as_float(qv[e] & 0xffff0000u);
        const float kmx = gx * e2x, kmy = gy * e2y;
        const int t = 16 * w + e;
        *(uint32_t*)(QM + t * HQP + pk0) = pack2(qx * e1x, qy * e1y);
        *(uint32_t*)(KM + t * HQP + pk0) = pack2(kmx, kmy);
        if (e & 1) { kux[e >> 1] = pack2(pkx, kmx * ccx); kuy[e >> 1] = pack2(pky, kmy * ccy); }
        else { pkx = kmx * ccx; pky = kmy * ccy; }
      }
      u32x4* d0 = (u32x4*)(KUT + (2 * kp) * HSP + 16 * w);
      u32x4* d1 = (u32x4*)(KUT + (2 * kp + 1) * HSP + 16 * w);
      u32x4 v;
      v.x = kux[0]; v.y = kux[1]; v.z = kux[2]; v.w = kux[3]; d0[0] = v;
      v.x = kux[4]; v.y = kux[5]; v.z = kux[6]; v.w = kux[7]; d0[1] = v;
      v.x = kuy[0]; v.y = kuy[1]; v.z = kuy[2]; v.w = kuy[3]; d1[0] = v;
      v.x = kuy[4]; v.y = kuy[5]; v.z = kuy[6]; v.w = kuy[7]; d1[1] = v;
      if (w == 0) {
        *(float2*)(emid + 2 * kp) = make_float2(fast_exp2(bmid.x), fast_exp2(bmid.y));
        *(float2*)(dec + 2 * kp) = make_float2(fast_exp2(blast.x), fast_exp2(blast.y));
      }
    }
    {
      uint32_t* d = (uint32_t*)(IT + vc * HSP + 2 * tp);
#pragma unroll
      for (int j = 0; j < 4; ++j) {
        d[(2 * j) * (HSP / 2)] = (ia0[j] & 0xffffu) | (ib0[j] << 16);
        d[(2 * j + 1) * (HSP / 2)] = (ia0[j] >> 16) | (ib0[j] & 0xffff0000u);
        d[(8 + 2 * j) * (HSP / 2)] = (ia1[j] & 0xffffu) | (ib1[j] << 16);
        d[(8 + 2 * j + 1) * (HSP / 2)] = (ia1[j] >> 16) | (ib1[j] & 0xffff0000u);
      }
    }
    __syncthreads();
    if (c0 + 1 < 64 * (1 + PROBE_HG)) HG_LOAD((c + 1) & 63)
    {
      const int ti = w >> 1, si = w & 1;
      f32x16 d;
#pragma unroll
      for (int i = 0; i < 16; ++i) d[i] = 0.f;
      if (w != 1) {
#pragma unroll
        for (int ks = 0; ks < 8; ++ks) {
          const bf16x8 af = *(const bf16x8*)(KM + (si * 32 + r) * HQP + ks * 16 + h * 8);
          const bf16x8 bf = *(const bf16x8*)(QM + (ti * 32 + r) * HQP + ks * 16 + h * 8);
          d = MFMA32(af, bf, d);
        }
      }
      __syncthreads();
      const int t = ti * 32 + r;
#pragma unroll
      for (int g = 0; g < 4; ++g) {
        const int sb = si * 32 + 8 * g + 4 * h;
        u32x2 v;
        v.x = pack2(sb + 0 <= t ? d[4 * g + 0] : 0.f, sb + 1 <= t ? d[4 * g + 1] : 0.f);
        v.y = pack2(sb + 2 <= t ? d[4 * g + 2] : 0.f, sb + 3 <= t ? d[4 * g + 3] : 0.f);
        *(u32x2*)(AM + t * HSP + sb) = v;
      }
    }
    __syncthreads();
    {
      f32x16 oa0, oa1;
#pragma unroll
      for (int i = 0; i < 16; ++i) { oa0[i] = 0.f; oa1[i] = 0.f; }
#pragma unroll
      for (int s4 = 0; s4 < 4; ++s4) {
        const bf16x8 ifr = *(const bf16x8*)(IT + (w * 32 + r) * HSP + 16 * s4 + 8 * h);
        const bf16x8 am1 = *(const bf16x8*)(AM + (32 + r) * HSP + 16 * s4 + 8 * h);
        oa1 = MFMA32(am1, ifr, oa1);
        if (s4 < 2) {
          const bf16x8 am0 = *(const bf16x8*)(AM + r * HSP + 16 * s4 + 8 * h);
          oa0 = MFMA32(am0, ifr, oa0);
        }
      }
#pragma unroll
      for (int ks = 0; ks < 8; ++ks) {
        const int kt4 = ks >> 1, hf = ks & 1;
        const float4 ea = *(const float4*)(emid + kt4 * 32 + 16 * hf + 4 * h);
        const float4 eb = *(const float4*)(emid + kt4 * 32 + 16 * hf + 8 + 4 * h);
        u32x4 pk;
        pk.x = pack2(S[kt4][8 * hf + 0] * ea.x, S[kt4][8 * hf + 1] * ea.y);
        pk.y = pack2(S[kt4][8 * hf + 2] * ea.z, S[kt4][8 * hf + 3] * ea.w);
        pk.z = pack2(S[kt4][8 * hf + 4] * eb.x, S[kt4][8 * hf + 5] * eb.y);
        pk.w = pack2(S[kt4][8 * hf + 6] * eb.z, S[kt4][8 * hf + 7] * eb.w);
        const bf16x8 sp = __builtin_bit_cast(bf16x8, pk);
        const bf16x8 qf0 = *(const bf16x8*)(QM + r * HQP + ks * 16 + 8 * h);
        const bf16x8 qf1 = *(const bf16x8*)(QM + (32 + r) * HQP + ks * 16 + 8 * h);
        oa0 = MFMA32(qf0, sp, oa0);
        oa1 = MFMA32(qf1, sp, oa1);
      }
      char* ogb = (char*)og + olane;
#pragma unroll
      for (int i = 0; i < 16; ++i) {
        const int ci = (i & 3) + 8 * (i >> 2);
        const size_t r0 = dir ? tb + 59 - ci : tb + ci;
        const size_t r1 = dir ? tb + 27 - ci : tb + 32 + ci;
        *(u16*)(ogb + r0 * 1024) = f2bf(oa0[i]);
        *(u16*)(ogb + r1 * 1024) = f2bf(oa1[i]);
      }
    }
#pragma unroll
    for (int kt4 = 0; kt4 < 4; ++kt4) {
#pragma unroll
      for (int g = 0; g < 4; ++g) {
        const float4 dd = *(const float4*)(dec + kt4 * 32 + 8 * g + 4 * h);
        S[kt4][4 * g + 0] *= dd.x; S[kt4][4 * g + 1] *= dd.y; S[kt4][4 * g + 2] *= dd.z; S[kt4][4 * g + 3] *= dd.w;
      }
    }
#pragma unroll
    for (int s4 = 0; s4 < 4; ++s4) {
      const bf16x8 ifr = *(const bf16x8*)(IT + (w * 32 + r) * HSP + 16 * s4 + 8 * h);
#pragma unroll
      for (int kt4 = 0; kt4 < 4; ++kt4) {
        const bf16x8 kf = *(const bf16x8*)(KUT + (kt4 * 32 + r) * HSP + 16 * s4 + 8 * h);
        S[kt4] = MFMA32(kf, ifr, S[kt4]);
      }
    }
    __syncthreads();
  }
#undef HG_LOAD
}

__global__ __launch_bounds__(256) void naive_attn(Params p) {
  const int gid = blockIdx.x * 256 + threadIdx.x;
  const int s = gid & 4095, bh = gid >> 12, head = bh & 7, bi = bh >> 3, kvh = head >> 2;
  float qv[64], acc[64];
  const u16* qp = p.q + ((size_t)(bi * 8 + head) * SEQ + s) * 64;
#pragma unroll
  for (int d = 0; d < 64; ++d) { qv[d] = bf2f(qp[d]); acc[d] = 0.f; }
  float mx = -INFINITY, l = 0.f;
  const u16* kp = p.k + (size_t)(bi * 2 + kvh) * SEQ * 64;
  const u16* vp = p.vT + (size_t)(bi * 2 + kvh) * 64 * SEQ;
  for (int key = 0; key < SEQ; ++key) {
    float sc = 0.f;
#pragma unroll
    for (int d = 0; d < 64; ++d) sc += qv[d] * bf2f(kp[(size_t)key * 64 + d]);
    const float mn = fmaxf(mx, sc);
    const float al = exp2f(mx - mn), pp = exp2f(sc - mn);
    l = l * al + pp;
#pragma unroll
    for (int d = 0; d < 64; ++d) acc[d] = acc[d] * al + pp * bf2f(vp[(size_t)d * SEQ + key]);
    mx = mn;
  }
  const float il = 1.f / l;
  u16* op = p.attn + ((size_t)bi * SEQ + s) * 512 + head * 64;
#pragma unroll
  for (int d = 0; d < 64; ++d) op[d] = f2bf(acc[d] * il);
}

__global__ __launch_bounds__(1024) void naive_hgrn(Params p) {
  __shared__ float red[8][128];
  const int dir = blockIdx.x & 1, hh = (blockIdx.x >> 1) & 3, bi = blockIdx.x >> 3;
  const int v = threadIdx.x & 127, kq = threadIdx.x >> 7;
  float S[16];
#pragma unroll
  for (int i = 0; i < 16; ++i) S[i] = 0.f;
  const u16* lf = dir ? p.lfb : p.lff;
  u16* o = dir ? p.ob : p.of;
  for (int step = 0; step < SEQ; ++step) {
    const int s = dir ? SEQ - 1 - step : step;
    const size_t base = ((size_t)bi * SEQ + s) * 512 + hh * 128;
    const float iv = bf2f(p.hi[base + v]);
    float part = 0.f;
#pragma unroll
    for (int kk = 0; kk < 16; ++kk) {
      const int k = kq * 16 + kk;
      const float lg = (float)__builtin_bit_cast(_Float16, lf[base + k]);
      const float f = exp2f(lg), g = 1.f - f;
      const float qk = bf2f(p.hq[base + k]);
      S[kk] = f * S[kk] + g * iv;
      part += S[kk] * qk;
    }
    red[kq][v] = part;
    __syncthreads();
    if (kq == 0) {
      float t = 0.f;
#pragma unroll
      for (int j = 0; j < 8; ++j) t += red[j][v];
      o[base + v] = f2bf(t);
    }
    __syncthreads();
  }
}

DI void unpack8(const uint4 u, float (&v)[8]) {
  v[0] = __uint_as_float(u.x << 16); v[1] = __uint_as_float(u.x & 0xffff0000u);
  v[2] = __uint_as_float(u.y << 16); v[3] = __uint_as_float(u.y & 0xffff0000u);
  v[4] = __uint_as_float(u.z << 16); v[5] = __uint_as_float(u.z & 0xffff0000u);
  v[6] = __uint_as_float(u.w << 16); v[7] = __uint_as_float(u.w & 0xffff0000u);
}
__device__ void phase_mix(const Params& p, int bid, int nblk) {
  const int lane = threadIdx.x & 63, w = threadIdx.x >> 6;
  u16* mix = p.mix;
  float wa[8], wh[8];
#pragma unroll
  for (int e = 0; e < 8; ++e) { wa[e] = p.attn_norm_w[lane * 8 + e]; wh[e] = p.hg_norm_w[(lane & 15) * 8 + e]; }
  const int stride = nblk * 4;
  for (int m0 = bid * 4 + w; m0 < MTOK; m0 += 4 * stride) {
    uint4 ua[4], ug[4], u1[4], u2[4], uh[4];
#pragma unroll
    for (int u = 0; u < 4; ++u) {
      const int m = m0 + u * stride;
      if (m < MTOK) {
        const size_t rb = (size_t)m * 512 + lane * 8;
        ua[u] = *(const uint4*)(p.attn + rb); ug[u] = *(const uint4*)(p.ga + rb);
        u1[u] = *(const uint4*)(p.of + rb); u2[u] = *(const uint4*)(p.ob + rb); uh[u] = *(const uint4*)(p.gh + rb);
      }
    }
#pragma unroll
    for (int u = 0; u < 4; ++u) {
      const int m = m0 + u * stride;
      if (m < MTOK) {
        float a[8], g[8], f1[8], f2[8];
        unpack8(ua[u], a); unpack8(ug[u], g);
        float ss = 0.f;
#pragma unroll
        for (int e = 0; e < 8; ++e) ss += a[e] * a[e];
#pragma unroll
        for (int o = 32; o >= 1; o >>= 1) ss += __shfl_xor(ss, o);
        float rstd = rsqrtf(ss * (1.f / 512.f) + 1e-6f);
        float r[8];
#pragma unroll
        for (int e = 0; e < 8; ++e) r[e] = a[e] * rstd * wa[e] * g[e];
        uint4 o1; o1.x = pack2(r[0], r[1]); o1.y = pack2(r[2], r[3]); o1.z = pack2(r[4], r[5]); o1.w = pack2(r[6], r[7]);
        *(uint4*)(mix + (size_t)m * 1024 + lane * 8) = o1;
        unpack8(u1[u], f1); unpack8(u2[u], f2); unpack8(uh[u], g);
        ss = 0.f;
#pragma unroll
        for (int e = 0; e < 8; ++e) { a[e] = f1[e] + f2[e]; ss += a[e] * a[e]; }
#pragma unroll
        for (int o = 8; o >= 1; o >>= 1) ss += __shfl_xor(ss, o);
        rstd = rsqrtf(ss * (1.f / 128.f) + 1e-6f);
#pragma unroll
        for (int e = 0; e < 8; ++e) r[e] = a[e] * rstd * wh[e] * g[e];
        o1.x = pack2(r[0], r[1]); o1.y = pack2(r[2], r[3]); o1.z = pack2(r[4], r[5]); o1.w = pack2(r[6], r[7]);
        *(uint4*)(mix + (size_t)m * 1024 + 512 + lane * 8) = o1;
      }
    }
  }
}

__device__ void phase3(const Params& p, char* smem, int bid, int nblk, const XMap xm) {
  const int lane = threadIdx.x & 63, w = threadIdx.x >> 6;
  const int wn = w & 1, wm = w >> 1;
  const int r0 = lane & 31, h0 = lane >> 5;
  const int ntiles = xm.xcc >= 0 ? 256 : (MTOK / 128) * 8;
  const int tstep = xm.xcc >= 0 ? xm.nloc : nblk;
  const int tend = ntiles * (1 + PROBE_P3);
  auto coords = [&](int tile0, int& mt, int& nt) {
    const int tile = tile0 >= ntiles ? tile0 - ntiles : tile0;
    if (xm.xcc >= 0) { const int c = tile >> 6, q = tile & 63; mt = xm.xcc * 32 + c * 8 + (q >> 3); nt = q & 7; }
    else { mt = tile >> 3; nt = tile & 7; }
  };
  int tile0 = xm.xcc >= 0 ? xm.rank : bid;
  while (tile0 < tend) {
    int mt_c, nt_c;
    coords(tile0, mt_c, nt_c);
    f32x16 acc[2][2];
    {
      u32x4 ra0[4], rb0[4], ra1[4], rb1[4];
      gemm_issue(p.woutT, p.mix, nt_c * 128, mt_c * 128, ra0, rb0, ra1, rb1);
      gemm_run(p.woutT, p.mix, nt_c * 128, mt_c * 128, smem, acc, ra0, rb0, ra1, rb1);
    }
    tile0 += tstep;
    {
    const int mt = mt_c, nt = nt_c;
    int r = r0, h = h0;
    asm volatile("" : "+v"(r), "+v"(h));
    float* T = (float*)smem;
#pragma unroll
    for (int b = 0; b < 2; ++b) {
      float* trow = T + (wm * 64 + b * 32 + r) * EPF + wn * 64 + 4 * h;
#pragma unroll
      for (int a = 0; a < 2; ++a)
#pragma unroll
        for (int g = 0; g < 4; ++g) {
          float4 o;
          o.x = acc[a][b][4 * g + 0]; o.y = acc[a][b][4 * g + 1]; o.z = acc[a][b][4 * g + 2]; o.w = acc[a][b][4 * g + 3];
          *(float4*)(trow + a * 32 + 8 * g) = o;
        }
    }
    __syncthreads();
    {
      const int tid = threadIdx.x;
      const int ch = tid & 31, rw = tid >> 5;
      const size_t gofs = (size_t)(mt * 128) * 1024 + nt * 128 + ch * 4;
#pragma unroll
      for (int j0 = 0; j0 < 16; j0 += 4) {
        float4 xv[4];
#pragma unroll
        for (int u = 0; u < 4; ++u) xv[u] = *(const float4*)(p.x + gofs + (size_t)((j0 + u) * 8 + rw) * 1024);
#pragma unroll
        for (int u = 0; u < 4; ++u) {
          const int row = (j0 + u) * 8 + rw;
          const float4 y = *(const float4*)(T + row * EPF + ch * 4);
          float4 o;
          o.x = DN_ALPHA * xv[u].x + y.x; o.y = DN_ALPHA * xv[u].y + y.y; o.z = DN_ALPHA * xv[u].z + y.z; o.w = DN_ALPHA * xv[u].w + y.w;
          *(float4*)(p.z + gofs + (size_t)row * 1024) = o;
        }
      }
    }
    }
  }
}

__device__ void phase4(const Params& p, int bid, int nblk) {
  const int lane = threadIdx.x & 63, w = threadIdx.x >> 6;
  const int stride = nblk * 4;
  for (int m0 = bid * 4 + w; m0 < MTOK; m0 += 4 * stride) {
    float4 v[4][4];
#pragma unroll
    for (int u = 0; u < 4; ++u) {
      const int m = m0 + u * stride;
      if (m < MTOK) {
        const float4* row = (const float4*)(p.z + (size_t)m * 1024);
#pragma unroll
        for (int j = 0; j < 4; ++j) v[u][j] = row[lane + 64 * j];
      }
    }
#pragma unroll
    for (int u = 0; u < 4; ++u) {
      const int m = m0 + u * stride;
      if (m < MTOK) {
        float4* row = (float4*)(p.out + (size_t)m * 1024);
        float s = 0.f;
#pragma unroll
        for (int j = 0; j < 4; ++j) s += v[u][j].x + v[u][j].y + v[u][j].z + v[u][j].w;
#pragma unroll
        for (int o = 32; o >= 1; o >>= 1) s += __shfl_xor(s, o);
        const float mu = s * (1.f / 1024.f);
        float q = 0.f;
#pragma unroll
        for (int j = 0; j < 4; ++j) {
          v[u][j].x -= mu; v[u][j].y -= mu; v[u][j].z -= mu; v[u][j].w -= mu;
          q += v[u][j].x * v[u][j].x + v[u][j].y * v[u][j].y + v[u][j].z * v[u][j].z + v[u][j].w * v[u][j].w;
        }
#pragma unroll
        for (int o = 32; o >= 1; o >>= 1) q += __shfl_xor(q, o);
        const float rstd = rsqrtf(q * (1.f / 1024.f) + 1e-5f);
#pragma unroll
        for (int j = 0; j < 4; ++j) {
          const float4 wv = ((const float4*)p.ln_w)[lane + 64 * j], bv = ((const float4*)p.ln_b)[lane + 64 * j];
          float4 o;
          o.x = v[u][j].x * rstd * wv.x + bv.x; o.y = v[u][j].y * rstd * wv.y + bv.y;
          o.z = v[u][j].z * rstd * wv.z + bv.z; o.w = v[u][j].w * rstd * wv.w + bv.w;
          row[lane + 64 * j] = o;
        }
      }
    }
  }
}


#define XB_TMO      128
#define XB_XCNT(j)  (256  + 64 * (j))
#define XB_XSUB(j)  (1280 + 64 * (j))
#define XB_XGEN(j)  (2304 + 64 * (j))
#define XB_TOP      3328
#define XB_TOPGEN   3392
#define XCD_BAR_WORDS 3456
#define XB_SPIN_CAP (1u << 18)
#define LAS __attribute__((address_space(3)))
DI unsigned xb_ld(unsigned* p) { return __hip_atomic_load(p, __ATOMIC_RELAXED, __HIP_MEMORY_SCOPE_AGENT); }
DI unsigned xb_add(unsigned* p, unsigned v) { return __hip_atomic_fetch_add(p, v, __ATOMIC_RELAXED, __HIP_MEMORY_SCOPE_AGENT); }
DI unsigned xb_xcc_id() { return (unsigned)__builtin_amdgcn_s_getreg((3 << 11) | 20) & 0xFu; }
#define XB_SPIN(cond, bar) do { unsigned _sp = 0; while (cond) { __builtin_amdgcn_s_sleep(1); \
    if ((++_sp & 255u) == 0u) { if (xb_ld(&(bar)[XB_TMO])) break; if (_sp > XB_SPIN_CAP) { atomicAdd(&(bar)[XB_TMO], 1u); break; } } } } while (0)
struct XcdBarrier { unsigned* bar; unsigned x; volatile LAS unsigned* st; };
DI XcdBarrier xcd_barrier_post(unsigned* bar, volatile LAS unsigned* st, unsigned& rank) {
  XcdBarrier b; b.bar = bar; b.x = xb_xcc_id(); b.st = st;
  rank = 0u;
  if (threadIdx.x == 0) rank = xb_add(&bar[XB_XCNT(b.x)], 1u);
  return b;
}
DI void xcd_barrier_complete(unsigned* bar, unsigned x, unsigned& nloc, unsigned& nx) {
  const unsigned G = gridDim.x * gridDim.y * gridDim.z;
  unsigned sum, cnt, mine, sp = 0u;
  for (;;) {
    sum = 0u; cnt = 0u; mine = 0u;
#pragma unroll
    for (unsigned j = 0; j < 16; ++j) { const unsigned c = xb_ld(&bar[XB_XCNT(j)]); sum += c; cnt += (c > 0u) ? 1u : 0u; mine = (j == x) ? c : mine; }
    if (sum == G) break;
    __builtin_amdgcn_s_sleep(1);
    if ((++sp & 255u) == 0u) { if (xb_ld(&bar[XB_TMO])) break; if (sp > XB_SPIN_CAP) { atomicAdd(&bar[XB_TMO], 1u); break; } }
  }
  nloc = mine > 0u ? mine : 1u; nx = cnt > 0u ? cnt : 1u;
}
DI void xcd_barrier(const XcdBarrier& b) {
  asm volatile("s_waitcnt vmcnt(0)" ::: "memory");
  __syncthreads();
  if (threadIdx.x == 0) {
    unsigned* bar = b.bar;
    __builtin_amdgcn_s_waitcnt(0);
    unsigned nloc = b.st[0], nx = b.st[1];
    if (nloc == 0u) { xcd_barrier_complete(bar, b.x, nloc, nx); b.st[0] = nloc; b.st[1] = nx; }
    const unsigned old = xb_add(&bar[XB_XSUB(b.x)], 1u);
    const unsigned gen = old / nloc;
    if (old + 1u == (gen + 1u) * nloc) {
      __builtin_amdgcn_fence(__ATOMIC_RELEASE, "agent");
      asm volatile("s_waitcnt vmcnt(0)" ::: "memory");
      const unsigned og = xb_add(&bar[XB_TOP], 1u);
      const unsigned tg = og / nx;
      if (og + 1u == (tg + 1u) * nx) xb_add(&bar[XB_TOPGEN], 1u);
      else XB_SPIN(xb_ld(&bar[XB_TOPGEN]) == tg, bar);
      __builtin_amdgcn_fence(__ATOMIC_ACQUIRE, "agent");
      xb_add(&bar[XB_XGEN(b.x)], 1u);
      asm volatile("s_waitcnt vmcnt(0)" ::: "memory");
    } else {
      XB_SPIN(xb_ld(&bar[XB_XGEN(b.x)]) == gen, bar);
      __builtin_amdgcn_fence(__ATOMIC_ACQUIRE, "agent");
      asm volatile("s_waitcnt vmcnt(0)" ::: "memory");
    }
  }
  __syncthreads();
}

constexpr int MEGA_LDS = HG_LDS > GEMM_LDS ? HG_LDS : GEMM_LDS;
__global__ void __launch_bounds__(256, 2) mega_kernel(Params p) {
  __shared__ __attribute__((aligned(16))) char smem[MEGA_LDS];
  __shared__ uint4 xb_words;
  __shared__ int s_item;
  __shared__ int s_xm[4];
  cg::grid_group grid = cg::this_grid();
  const int bid = blockIdx.x, nblk = gridDim.x;
  if (threadIdx.x == 0) xb_words = make_uint4(0u, 0u, 0u, 0u);
  __syncthreads();
  unsigned my_rank;
  XcdBarrier xb = xcd_barrier_post(p.bar, (volatile LAS unsigned*)&xb_words, my_rank);
  if (p.out == nullptr) grid.sync();
  phase0(p, smem, bid, nblk);
#if PROBE_P0
  phase0(p, smem, bid, nblk);
#endif
  xcd_barrier(xb);
  if (threadIdx.x == 0) {
    unsigned sum = 0;
#pragma unroll
    for (int j = 0; j < 8; ++j) sum += xb_ld(&p.bar[XB_XCNT(j)]);
    const bool ok = sum == (unsigned)nblk && xb.x < 8u && xb_words.y == 8u;
    s_xm[0] = ok ? (int)xb.x : -1; s_xm[1] = (int)my_rank; s_xm[2] = (int)xb_words.x;
  }
  __syncthreads();
  XMap xm; xm.xcc = s_xm[0]; xm.rank = s_xm[1]; xm.nloc = s_xm[2];
  phase1(p, smem, bid, nblk, xm);
  xcd_barrier(xb);
  for (int it = bid; it < 64; it += nblk) hgrn_item(p, smem, it);
  for (;;) {
    __syncthreads();
    if (threadIdx.x == 0) s_item = atomicAdd(p.ctr, 1);
    __syncthreads();
    const int it = __builtin_amdgcn_readfirstlane(s_item);
    if (it >= 4096) break;
    if (it < 2048) attn_item(p, smem, it);
    else { const int g = it - 2048, jj = g & 7; p1_tile(p, smem, g >> 3, jj < 4 ? 6 + jj : 22 + jj); }
  }
  xcd_barrier(xb);
  phase_mix(p, bid, nblk);
#if PROBE_MIX
  phase_mix(p, bid, nblk);
#endif
  xcd_barrier(xb);
  phase3(p, smem, bid, nblk, xm);
  xcd_barrier(xb);
  phase4(p, bid, nblk);
}

__global__ __launch_bounds__(256) void k_phase0(Params p) { __shared__ __attribute__((aligned(16))) char smem[64 * 65 * 4]; phase0(p, smem, blockIdx.x, gridDim.x); }
__global__ __launch_bounds__(256) void k_phase1(Params p) { __shared__ __attribute__((aligned(16))) char smem[GEMM_LDS]; XMap xm; xm.xcc = -1; xm.rank = 0; xm.nloc = 1; phase1(p, smem, blockIdx.x, gridDim.x, xm); }
__global__ __launch_bounds__(256) void k_attn(Params p) { __shared__ __attribute__((aligned(16))) char smem[GEMM_LDS]; for (int it = blockIdx.x; it < 4096; it += gridDim.x) { if (it < 2048) attn_item(p, smem, it); else { const int g = it - 2048, jj = g & 7; p1_tile(p, smem, g >> 3, jj < 4 ? 6 + jj : 22 + jj); } } }
__global__ __launch_bounds__(256) void k_hgrn(Params p) { __shared__ __attribute__((aligned(16))) char smem[HG_LDS]; for (int it = blockIdx.x; it < 64; it += gridDim.x) hgrn_item(p, smem, it); }
__global__ __launch_bounds__(256) void k_mix(Params p) { phase_mix(p, blockIdx.x, gridDim.x); }
__global__ __launch_bounds__(256) void k_phase3(Params p) { __shared__ __attribute__((aligned(16))) char smem[GEMM_LDS]; XMap xm; xm.xcc = -1; xm.rank = 0; xm.nloc = 1; phase3(p, smem, blockIdx.x, gridDim.x, xm); }
__global__ __launch_bounds__(256) void k_phase4(Params p) { phase4(p, blockIdx.x, gridDim.x); }

extern "C" void kernel_launch(void* const* d_in, const int* in_sizes, int n_in, void* d_out, int out_size, void* d_ws, size_t ws_size,
                              hipStream_t stream) {
  Params p{};
  p.x = (const float*)d_in[0]; p.w_in = (const float*)d_in[1]; p.q_norm_w = (const float*)d_in[2]; p.k_norm_w = (const float*)d_in[3];
  p.attn_norm_w = (const float*)d_in[4]; p.lb_logits = (const float*)d_in[5]; p.hg_norm_w = (const float*)d_in[6];
  p.w_out = (const float*)d_in[7]; p.ln_w = (const float*)d_in[8]; p.ln_b = (const float*)d_in[9];
  p.out = (float*)d_out;
  char* ws = (char*)d_ws;
  size_t off = 0;
  auto take = [&](size_t bytes) { char* r = ws + off; off += (bytes + 255) & ~(size_t)255; return r; };
  p.xb = (u16*)take((size_t)MTOK * 1024 * 2);
  p.winT = (u16*)take((size_t)INW * 1024 * 2);
  p.woutT = (u16*)take((size_t)1024 * 1024 * 2);
  p.rope = (float2*)take(1024 * 8);
  p.lbv = (float*)take(1024 * 4);
  p.q = (u16*)take((size_t)MTOK * 512 * 2);
  p.k = (u16*)take((size_t)MTOK * 128 * 2);
  p.vT = (u16*)take((size_t)MTOK * 128 * 2);
  p.ga = (u16*)take((size_t)MTOK * 512 * 2);
  p.hq = (u16*)take((size_t)MTOK * 512 * 2);
  p.hi = (u16*)take((size_t)MTOK * 512 * 2);
  p.lff = (u16*)take((size_t)MTOK * 512 * 4);
  p.lfb = (u16*)take((size_t)MTOK * 512 * 4);
  p.gh = (u16*)take((size_t)MTOK * 512 * 2);
  p.attn = (u16*)take((size_t)MTOK * 512 * 2);
  p.of = (u16*)take((size_t)MTOK * 512 * 2);
  p.ob = (u16*)take((size_t)MTOK * 512 * 2);
  p.ctr = (int*)take(256);
  p.bar = (unsigned*)take(XCD_BAR_WORDS * 4);
  p.mix = p.hq;
  p.z = (float*)p.lff;
  if (off > ws_size) { fprintf(stderr, "workspace too small: need %zu have %zu\n", off, ws_size); return; }
#if ONE_LAUNCH
  static int grid_blocks = 0;
  if (!grid_blocks) {
    int dev = 0, cus = 0, per_cu = 0;
    hipGetDevice(&dev);
    hipDeviceGetAttribute(&cus, hipDeviceAttributeMultiprocessorCount, dev);
    hipOccupancyMaxActiveBlocksPerMultiprocessor(&per_cu, mega_kernel, 256, 0);
    if (per_cu > 2) per_cu = 2;
    grid_blocks = cus * per_cu;
    if (grid_blocks < 64) fprintf(stderr, "grid too small: %d\n", grid_blocks);
  }
  hipMemsetAsync(p.ctr, 0, 256 + ((XCD_BAR_WORDS * 4 + 255) & ~255), stream);
  void* args[] = {&p};
  hipError_t e = hipLaunchCooperativeKernel((void*)mega_kernel, dim3(grid_blocks), dim3(256), args, 0, stream);
  if (e != hipSuccess) fprintf(stderr, "cooperative launch failed: %s (grid %d)\n", hipGetErrorString(e), grid_blocks);
#else
  k_phase0<<<1024, 256, 0, stream>>>(p);
  k_phase1<<<512, 256, 0, stream>>>(p);
  k_attn<<<2048, 256, 0, stream>>>(p);
  k_hgrn<<<64, 256, 0, stream>>>(p);
  k_mix<<<2048, 256, 0, stream>>>(p);
  k_phase3<<<512, 256, 0, stream>>>(p);
  k_phase4<<<2048, 256, 0, stream>>>(p);
#endif
}
```

```cpp
#include <hip/hip_runtime.h>
#include <hip/hip_cooperative_groups.h>
#include <stdint.h>
#include <stdio.h>

namespace cg = cooperative_groups;

#ifndef ONE_LAUNCH
#define ONE_LAUNCH 1
#endif
#ifndef PROBE_P0
#define PROBE_P0 0
#endif
#ifndef PROBE_MIX
#define PROBE_MIX 0
#endif
#ifndef PROBE_P1
#define PROBE_P1 0
#endif
#ifndef PROBE_HG
#define PROBE_HG 0
#endif
#ifndef PROBE_AT
#define PROBE_AT 0
#endif
#ifndef PROBE_P3
#define PROBE_P3 0
#endif

typedef __attribute__((ext_vector_type(8))) short bf16x8;
typedef __attribute__((ext_vector_type(4))) short s16x4;
typedef __attribute__((ext_vector_type(16))) float f32x16;
typedef unsigned short u16;
typedef __attribute__((ext_vector_type(4))) unsigned u32x4;
typedef __attribute__((ext_vector_type(2))) unsigned u32x2;

#define DI __device__ __forceinline__
#define MFMA32(a, b, c) __builtin_amdgcn_mfma_f32_32x32x16_bf16((a), (b), (c), 0, 0, 0)

constexpr int MTOK = 32768;
constexpr int SEQ = 4096;
constexpr int DM = 1024;
constexpr int INW = 3840;
constexpr float Q_PRESCALE = 0.125f * 1.4426950408889634f;
constexpr float HQ_SCALE = 0.08838834764831845f;
constexpr float DN_ALPHA = 1.189207115002721f;

struct Params {
  const float* x; const float* w_in; const float* q_norm_w; const float* k_norm_w;
  const float* attn_norm_w; const float* lb_logits; const float* hg_norm_w; const float* w_out;
  const float* ln_w; const float* ln_b;
  float* out;
  u16* xb;
  u16* winT;
  u16* woutT;
  float2* rope;
  float* lbv;
  u16* q;
  u16* k;
  u16* vT;
  u16* ga;
  u16* hq;
  u16* hi;
  u16* lff;
  u16* lfb;
  u16* gh;
  u16* attn;
  u16* of;
  u16* ob;
  int* ctr;
  unsigned* bar;
  u16* mix;
  float* z;
};

DI u16 f2bf(float x) { uint32_t u = __float_as_uint(x); u += 0x7fffu + ((u >> 16) & 1u); return (u16)(u >> 16); }
DI float bf2f(u16 v) { return __uint_as_float(((uint32_t)v) << 16); }
typedef __attribute__((ext_vector_type(2))) float f32x2_t;
typedef __attribute__((ext_vector_type(2))) __bf16 bf16x2_t;
DI uint32_t pack2(float a, float b) { f32x2_t v = {a, b}; bf16x2_t r = __builtin_convertvector(v, bf16x2_t); return __builtin_bit_cast(uint32_t, r); }
typedef __attribute__((ext_vector_type(2))) _Float16 f16x2_t;
DI uint32_t pack2h(float a, float b) { f16x2_t r = {(_Float16)a, (_Float16)b}; return __builtin_bit_cast(uint32_t, r); }
DI float h2f_lo(uint32_t u) { return (float)__builtin_bit_cast(f16x2_t, u)[0]; }
DI float h2f_hi(uint32_t u) { return (float)__builtin_bit_cast(f16x2_t, u)[1]; }
DI int crow(int i, int h) { return (i & 3) + 8 * (i >> 2) + 4 * h; }
DI float silu_f(float v) { return v * __builtin_amdgcn_rcpf(1.f + __expf(-v)); }

__device__ void phase0(const Params& p, char* smem, int bid, int nblk) {
  const int tid = threadIdx.x;
  {
    const size_t nvec = (size_t)MTOK * DM / 8;
    const size_t T = (size_t)nblk * 256;
    for (size_t i = (size_t)bid * 256 + tid; i < nvec; i += 4 * T) {
      float4 a[4], b[4];
#pragma unroll
      for (int u = 0; u < 4; ++u) {
        const size_t ii = i + u * T;
        if (ii < nvec) { a[u] = ((const float4*)p.x)[2 * ii]; b[u] = ((const float4*)p.x)[2 * ii + 1]; }
      }
#pragma unroll
      for (int u = 0; u < 4; ++u) {
        const size_t ii = i + u * T;
        if (ii < nvec) {
          uint4 o; o.x = pack2(a[u].x, a[u].y); o.y = pack2(a[u].z, a[u].w); o.z = pack2(b[u].x, b[u].y); o.w = pack2(b[u].z, b[u].w);
          ((uint4*)p.xb)[ii] = o;
        }
      }
    }
  }
  {
    float* t = (float*)smem;
    const int ntile_in = 16 * 60, ntile_all = ntile_in + 16 * 16;
    for (int tile = bid; tile < ntile_all; tile += nblk) {
      const float* src; u16* dst; int N, kt, nt;
      if (tile < ntile_in) { src = p.w_in; dst = p.winT; N = INW; kt = tile / 60; nt = tile % 60; }
      else { int tt = tile - ntile_in; src = p.w_out; dst = p.woutT; N = DM; kt = tt / 16; nt = tt % 16; }
      __syncthreads();
#pragma unroll
      for (int j = 0; j < 4; ++j) {
        const int kk = (tid >> 4) + 16 * j, nn = (tid & 15) * 4;
        const float4 v = *(const float4*)(src + (size_t)(kt * 64 + kk) * N + nt * 64 + nn);
        t[kk * 65 + nn] = v.x; t[kk * 65 + nn + 1] = v.y; t[kk * 65 + nn + 2] = v.z; t[kk * 65 + nn + 3] = v.w;
      }
      __syncthreads();
      const int n = tid >> 2, kc = (tid & 3) * 16;
      uint32_t o[8];
#pragma unroll
      for (int j = 0; j < 8; ++j) o[j] = pack2(t[(kc + 2 * j) * 65 + n], t[(kc + 2 * j + 1) * 65 + n]);
      uint4* d = (uint4*)(dst + (size_t)(nt * 64 + n) * 1024 + kt * 64 + kc);
      d[0] = make_uint4(o[0], o[1], o[2], o[3]);
      d[1] = make_uint4(o[4], o[5], o[6], o[7]);
    }
  }
  for (int i = bid * 256 + tid; i < 2048; i += nblk * 256) {
    if (i < 1024) {
      const int pos = i >> 4, j = i & 15;
      const float inv = powf(10000.f, -(float)(2 * j) / 32.f);
      const float ang = (float)pos * inv;
      p.rope[i] = make_float2(cosf(ang), sinf(ang));
    } else {
      const int ii = i - 1024, dir = ii >> 9, wcol = ii & 511;
      const float l0 = p.lb_logits[(dir * 2 + 0) * 512 + wcol], l1 = p.lb_logits[(dir * 2 + 1) * 512 + wcol];
      const float mx = fmaxf(l0, l1);
      const float e0 = expf(l0 - mx), e1 = expf(l1 - mx);
      p.lbv[ii] = e0 / (e0 + e1);
    }
  }
}

constexpr int GP = 72;
constexpr int EP = 136;
constexpr int EPF = 132;
constexpr int GEMM_LDS = 2 * 2 * 128 * GP * 2;

DI void gemm_issue(const u16* __restrict__ A, const u16* __restrict__ B, int n0, int m0,
                   u32x4 (&ra0)[4], u32x4 (&rb0)[4], u32x4 (&ra1)[4], u32x4 (&rb1)[4]) {
  const int tid = threadIdx.x;
  const int lc = tid & 7, lr = tid >> 3;
  const u16* gA = A + (size_t)(n0 + lr) * 1024 + lc * 8;
  const u16* gB = B + (size_t)(m0 + lr) * 1024 + lc * 8;
#pragma unroll
  for (int j = 0; j < 4; ++j) { ra0[j] = *(const u32x4*)(gA + (size_t)j * 32 * 1024); rb0[j] = *(const u32x4*)(gB + (size_t)j * 32 * 1024); }
#pragma unroll
  for (int j = 0; j < 4; ++j) { ra1[j] = *(const u32x4*)(gA + (size_t)j * 32 * 1024 + 64); rb1[j] = *(const u32x4*)(gB + (size_t)j * 32 * 1024 + 64); }
}
DI void gemm_run(const u16* __restrict__ A, const u16* __restrict__ B, int n0, int m0, char* smem, f32x16 (&acc)[2][2],
                 u32x4 (&ra0)[4], u32x4 (&rb0)[4], u32x4 (&ra1)[4], u32x4 (&rb1)[4]) {
  const int tid = threadIdx.x, lane = tid & 63, w = __builtin_amdgcn_readfirstlane(tid >> 6);
  const int wn = w & 1, wm = w >> 1;
  const int lc = tid & 7, lr = tid >> 3;
  u16* sm = (u16*)smem;
  const u16* gA = A + (size_t)(n0 + lr) * 1024 + lc * 8;
  const u16* gB = B + (size_t)(m0 + lr) * 1024 + lc * 8;
#pragma unroll
  for (int a = 0; a < 2; ++a)
#pragma unroll
    for (int b = 0; b < 2; ++b)
#pragma unroll
      for (int i = 0; i < 16; ++i) acc[a][b][i] = 0.f;
  u32x4 ra2[4], rb2[4];
#define GEMM_LOAD(RA, RB, KT) _Pragma("unroll") for (int j = 0; j < 4; ++j) { \
    RA[j] = *(const u32x4*)(gA + (size_t)j * 32 * 1024 + (KT) * 64); RB[j] = *(const u32x4*)(gB + (size_t)j * 32 * 1024 + (KT) * 64); }
#define GEMM_STORE(RA, RB, ST) _Pragma("unroll") for (int j = 0; j < 4; ++j) { \
    *(u32x4*)(sm + (((ST) * 2 + 0) * 128 + lr + 32 * j) * GP + lc * 8) = RA[j]; *(u32x4*)(sm + (((ST) * 2 + 1) * 128 + lr + 32 * j) * GP + lc * 8) = RB[j]; }
  GEMM_LOAD(ra2, rb2, 2)
  __syncthreads();
  GEMM_STORE(ra0, rb0, 0)
  __syncthreads();
  const int fr = lane & 31, fh = lane >> 5;
  const u16* fa = sm + (wn * 64 + fr) * GP + fh * 8;
  const u16* fb = sm + (128 + wm * 64 + fr) * GP + fh * 8;
#define GEMM_COMPUTE(ST)                                                                          \
  _Pragma("unroll") for (int ks = 0; ks < 4; ++ks) {                                              \
    bf16x8 af[2], bfr[2];                                                                         \
    _Pragma("unroll") for (int a = 0; a < 2; ++a) af[a] = *(const bf16x8*)(fa + ((ST) * 256 + a * 32) * GP + ks * 16);   \
    _Pragma("unroll") for (int b = 0; b < 2; ++b) bfr[b] = *(const bf16x8*)(fb + ((ST) * 256 + b * 32) * GP + ks * 16);  \
    _Pragma("unroll") for (int a = 0; a < 2; ++a)                                                 \
      _Pragma("unroll") for (int b = 0; b < 2; ++b) acc[a][b] = MFMA32(af[a], bfr[b], acc[a][b]); \
  }
#define GEMM_SUB(K, RAL, RBL, RAW, RBW)                                   \
  {                                                                       \
    if ((K) + 3 < 16) { GEMM_LOAD(RAL, RBL, (K) + 3) }                    \
    GEMM_COMPUTE((K) & 1)                                                 \
    if ((K) + 1 < 16) { GEMM_STORE(RAW, RBW, ((K) + 1) & 1) }             \
    __syncthreads();                                                      \
  }
  GEMM_SUB(0, ra0, rb0, ra1, rb1)
  GEMM_SUB(1, ra1, rb1, ra2, rb2)
  GEMM_SUB(2, ra2, rb2, ra0, rb0)
  GEMM_SUB(3, ra0, rb0, ra1, rb1)
  GEMM_SUB(4, ra1, rb1, ra2, rb2)
  GEMM_SUB(5, ra2, rb2, ra0, rb0)
  GEMM_SUB(6, ra0, rb0, ra1, rb1)
  GEMM_SUB(7, ra1, rb1, ra2, rb2)
  GEMM_SUB(8, ra2, rb2, ra0, rb0)
  GEMM_SUB(9, ra0, rb0, ra1, rb1)
  GEMM_SUB(10, ra1, rb1, ra2, rb2)
  GEMM_SUB(11, ra2, rb2, ra0, rb0)
  GEMM_SUB(12, ra0, rb0, ra1, rb1)
  GEMM_SUB(13, ra1, rb1, ra2, rb2)
  GEMM_SUB(14, ra2, rb2, ra0, rb0)
  GEMM_SUB(15, ra0, rb0, ra1, rb1)
#undef GEMM_SUB
#undef GEMM_COMPUTE
#undef GEMM_LOAD
#undef GEMM_STORE
}

struct XMap { int xcc, rank, nloc; };
__device__ __forceinline__ void p1_tile(const Params& p, char* smem, const int mt, const int nt) {
  const int lane = threadIdx.x & 63, w = threadIdx.x >> 6;
  const int wn = w & 1, wm = w >> 1;
  const int r0 = lane & 31, h0 = lane >> 5;
    f32x16 acc[2][2];
    {
      u32x4 ra0[4], rb0[4], ra1[4], rb1[4];
      gemm_issue(p.winT, p.xb, nt * 128, mt * 128, ra0, rb0, ra1, rb1);
      gemm_run(p.winT, p.xb, nt * 128, mt * 128, smem, acc, ra0, rb0, ra1, rb1);
    }
    {
    int r = r0, h = h0;
    asm volatile("" : "+v"(r), "+v"(h));
    u16* T = (u16*)smem;
    const int mbase = mt * 128 + wm * 64;
    if (nt <= 4) {
      const bool isq = nt < 4;
      const float* nw = isq ? p.q_norm_w : p.k_norm_w;
      const float sc = isq ? Q_PRESCALE : 1.0f;
#pragma unroll
      for (int b = 0; b < 2; ++b) {
        const int m = mbase + b * 32 + r;
        const int s = m & 4095;
        const int rp = s >> 6, cp = s & 63;
        float ss = 0.f;
#pragma unroll
        for (int a = 0; a < 2; ++a)
#pragma unroll
          for (int i = 0; i < 16; ++i) ss += acc[a][b][i] * acc[a][b][i];
        ss += __shfl_xor(ss, 32);
        const float rstd = rsqrtf(ss * (1.f / 64.f) + 1e-6f);
        u16* trow = T + (wm * 64 + b * 32 + r) * EP + wn * 64 + 4 * h;
#pragma unroll
        for (int a = 0; a < 2; ++a) {
          const int pos = a == 0 ? rp : cp;
          float y[16], o[16];
#pragma unroll
          for (int i = 0; i < 16; ++i) y[i] = acc[a][b][i] * rstd * nw[a * 32 + crow(i, h)];
#pragma unroll
          for (int i = 0; i < 8; ++i) {
            const float2 cs = p.rope[pos * 16 + crow(i, h)];
            o[i] = (y[i] * cs.x - y[i + 8] * cs.y) * sc;
            o[i + 8] = (y[i + 8] * cs.x + y[i] * cs.y) * sc;
          }
#pragma unroll
          for (int g = 0; g < 4; ++g) {
            u32x2 v; v.x = pack2(o[4 * g], o[4 * g + 1]); v.y = pack2(o[4 * g + 2], o[4 * g + 3]);
            *(u32x2*)(trow + a * 32 + 8 * g) = v;
          }
        }
      }
    } else if (nt == 5) {
#pragma unroll
      for (int b = 0; b < 2; ++b)
#pragma unroll
        for (int a = 0; a < 2; ++a)
#pragma unroll
          for (int i = 0; i < 16; ++i) T[(wn * 64 + a * 32 + crow(i, h)) * EP + wm * 64 + b * 32 + r] = f2bf(acc[a][b][i]);
    } else {
      const int gi = (nt - 6) >> 2;
      const int cb = ((nt - 6) & 3) * 128 + wn * 64;
#pragma unroll
      for (int b = 0; b < 2; ++b) {
        u16* trow = T + (wm * 64 + b * 32 + r) * EP + wn * 64 + 4 * h;
#pragma unroll
        for (int a = 0; a < 2; ++a)
#pragma unroll
          for (int g = 0; g < 4; ++g) {
            float v[4];
#pragma unroll
            for (int e = 0; e < 4; ++e) v[e] = acc[a][b][4 * g + e];
            u32x2 o;
            if (gi == 3 || gi == 4) {
              const float4 lb = *(const float4*)(p.lbv + (gi - 3) * 512 + cb + a * 32 + 8 * g + 4 * h);
              const float ox = __builtin_amdgcn_logf(lb.x + (1.f - lb.x) * __builtin_amdgcn_rcpf(1.f + __expf(-v[0])));
              const float oy = __builtin_amdgcn_logf(lb.y + (1.f - lb.y) * __builtin_amdgcn_rcpf(1.f + __expf(-v[1])));
              const float oz = __builtin_amdgcn_logf(lb.z + (1.f - lb.z) * __builtin_amdgcn_rcpf(1.f + __expf(-v[2])));
              const float ow = __builtin_amdgcn_logf(lb.w + (1.f - lb.w) * __builtin_amdgcn_rcpf(1.f + __expf(-v[3])));
              o.x = pack2h(ox, oy); o.y = pack2h(oz, ow);
            } else {
              if (gi == 0 || gi == 5) {
#pragma unroll
                for (int e = 0; e < 4; ++e) v[e] = silu_f(v[e]);
              } else if (gi == 1) {
#pragma unroll
                for (int e = 0; e < 4; ++e) v[e] = silu_f(v[e]) * HQ_SCALE;
              }
              o.x = pack2(v[0], v[1]); o.y = pack2(v[2], v[3]);
            }
            *(u32x2*)(trow + a * 32 + 8 * g) = o;
          }
      }
    }
    __syncthreads();
    {
      const int tid = threadIdx.x;
      const int ch = tid & 15, rw = tid >> 4;
      const int bi = (mt * 128) >> 12, s0 = (mt * 128) & 4095;
      u16* dbase; size_t rstride;
      if (nt < 4)       { dbase = p.q + ((size_t)(bi * 8 + nt * 2 + (ch >> 3)) * SEQ + s0) * 64 + (ch & 7) * 8; rstride = 64; }
      else if (nt == 4) { dbase = p.k + ((size_t)(bi * 2 + (ch >> 3)) * SEQ + s0) * 64 + (ch & 7) * 8; rstride = 64; }
      else if (nt == 5) { dbase = p.vT + (size_t)(bi * 2) * 64 * SEQ + s0 + ch * 8; rstride = SEQ; }
      else {
        const int gi = (nt - 6) >> 2;
        u16* gb = gi == 0 ? p.ga : gi == 1 ? p.hq : gi == 2 ? p.hi : gi == 3 ? p.lff : gi == 4 ? p.lfb : p.gh;
        dbase = gb + (size_t)(mt * 128) * 512 + ((nt - 6) & 3) * 128 + ch * 8; rstride = 512;
      }
#pragma unroll
      for (int j = 0; j < 8; ++j) {
        const int row = j * 16 + rw;
        const u32x4 v = *(const u32x4*)(T + row * EP + ch * 8);
        *(u32x4*)(dbase + (size_t)row * rstride) = v;
      }
    }
    }
}

__device__ void phase1(const Params& p, char* smem, int bid, int nblk, const XMap xm) {
  const int ntiles = xm.xcc >= 0 ? 704 : (MTOK / 128) * 22;
  const int tstep = xm.xcc >= 0 ? xm.nloc : nblk;
  for (int tile = xm.xcc >= 0 ? xm.rank : bid; tile < ntiles; tile += tstep) {
    int mt, j;
    if (xm.xcc >= 0) {
      int ml;
      if (tile < 512) { const int g = tile >> 8, rem = tile & 255, c = rem >> 6, q = rem & 63; ml = c * 8 + (q >> 3); j = g * 8 + (q & 7); }
      else { const int t2 = tile - 512, c = t2 / 48, q = t2 % 48; ml = c * 8 + q / 6; j = 16 + q % 6; }
      mt = xm.xcc * 32 + ml;
    } else { mt = tile / 22; j = tile % 22; }
    const int nt = j < 6 ? j : j + 4;
    p1_tile(p, smem, mt, nt);
  }
}

constexpr int AP = 72;
constexpr int ATT_LDS = 2 * 2 * 64 * AP * 2;
DI float fast_exp2(float x) { return __builtin_amdgcn_exp2f(x); }

__device__ void attn_item(const Params& p, char* smem, int item) {
  const int tid = threadIdx.x, lane = tid & 63, w = __builtin_amdgcn_readfirstlane(tid >> 6), r = lane & 31, h = lane >> 5;
  const int qb = item & 31, pair = (item >> 5) & 3, bi = item >> 7;
  const int kvh = pair >> 1;
  const int q0 = qb * 128 + w * 32;
  u16* sm = (u16*)smem;
  bf16x8 qf[2][4];
#pragma unroll
  for (int hd = 0; hd < 2; ++hd) {
    const u16* qp = p.q + ((size_t)(bi * 8 + pair * 2 + hd) * SEQ + q0 + r) * 64 + h * 8;
#pragma unroll
    for (int ks = 0; ks < 4; ++ks) qf[hd][ks] = *(const bf16x8*)(qp + ks * 16);
  }
  const int lc = tid & 7, lr = tid >> 3;
  const u16* kg = p.k + (size_t)(bi * 2 + kvh) * SEQ * 64 + (size_t)lr * 64 + lc * 8;
  const u16* vg = p.vT + (size_t)(bi * 2 + kvh) * 64 * SEQ + (size_t)lr * SEQ + lc * 8;
  const int kw = lr * AP + lc * 8;
  const int vw = lr * AP + (lc >> 1) * 16 + (lc & 1) * 4;
  u32x4 rk[2], rv[2];
#pragma unroll
  for (int j = 0; j < 2; ++j) { rk[j] = *(const u32x4*)(kg + (size_t)j * 32 * 64); rv[j] = *(const u32x4*)(vg + (size_t)j * 32 * SEQ); }
  __syncthreads();
#pragma unroll
  for (int j = 0; j < 2; ++j) {
    *(u32x4*)(sm + kw + j * 32 * AP) = rk[j];
    u16* vd = sm + 64 * AP + vw + j * 32 * AP;
    *(u32x2*)(vd) = rv[j].xy; *(u32x2*)(vd + 8) = rv[j].zw;
  }
  __syncthreads();
  f32x16 o[2][2];
#pragma unroll
  for (int hd = 0; hd < 2; ++hd)
#pragma unroll
    for (int dt = 0; dt < 2; ++dt)
#pragma unroll
      for (int i = 0; i < 16; ++i) o[hd][dt][i] = 0.f;
  float mrun[2] = {-INFINITY, -INFINITY}, lsum[2] = {0.f, 0.f};
  for (int t = 0; t < 64; ++t) {
    const int st = t & 1;
    if (t + 1 < 64) {
#pragma unroll
      for (int j = 0; j < 2; ++j) {
        rk[j] = *(const u32x4*)(kg + (size_t)((t + 1) * 64 + j * 32) * 64);
        rv[j] = *(const u32x4*)(vg + (size_t)j * 32 * SEQ + (t + 1) * 64);
      }
    }
    const u16* sK = sm + (st * 2 + 0) * 64 * AP;
    const u16* sV = sm + (st * 2 + 1) * 64 * AP;
    f32x16 sc[2][2];
#pragma unroll
    for (int kt2 = 0; kt2 < 2; ++kt2) {
#pragma unroll
      for (int hd = 0; hd < 2; ++hd)
#pragma unroll
        for (int i = 0; i < 16; ++i) sc[hd][kt2][i] = 0.f;
#pragma unroll
      for (int ks = 0; ks < 4; ++ks) {
        const bf16x8 kf = *(const bf16x8*)(sK + (kt2 * 32 + r) * AP + ks * 16 + h * 8);
        sc[0][kt2] = MFMA32(kf, qf[0][ks], sc[0][kt2]);
        sc[1][kt2] = MFMA32(kf, qf[1][ks], sc[1][kt2]);
      }
    }
#pragma unroll
    for (int hd = 0; hd < 2; ++hd) {
      float mx = sc[hd][0][0];
#pragma unroll
      for (int i = 1; i < 16; ++i) mx = fmaxf(mx, sc[hd][0][i]);
#pragma unroll
      for (int i = 0; i < 16; ++i) mx = fmaxf(mx, sc[hd][1][i]);
      mx = fmaxf(mx, __shfl_xor(mx, 32));
      if (__any(mx > mrun[hd])) {
        const float mn = fmaxf(mrun[hd], mx);
        const float al = fast_exp2(mrun[hd] - mn);
        lsum[hd] *= al;
#pragma unroll
        for (int dt = 0; dt < 2; ++dt)
#pragma unroll
          for (int i = 0; i < 16; ++i) o[hd][dt][i] *= al;
        mrun[hd] = mn;
      }
#pragma unroll
      for (int kt2 = 0; kt2 < 2; ++kt2)
#pragma unroll
        for (int i = 0; i < 16; ++i) { const float e = fast_exp2(sc[hd][kt2][i] - mrun[hd]); sc[hd][kt2][i] = e; lsum[hd] += e; }
    }
#pragma unroll
    for (int s2 = 0; s2 < 4; ++s2) {
      bf16x8 pf[2];
#pragma unroll
      for (int hd = 0; hd < 2; ++hd) {
        u32x4 pk;
        pk.x = pack2(sc[hd][s2 >> 1][8 * (s2 & 1) + 0], sc[hd][s2 >> 1][8 * (s2 & 1) + 1]);
        pk.y = pack2(sc[hd][s2 >> 1][8 * (s2 & 1) + 2], sc[hd][s2 >> 1][8 * (s2 & 1) + 3]);
        pk.z = pack2(sc[hd][s2 >> 1][8 * (s2 & 1) + 4], sc[hd][s2 >> 1][8 * (s2 & 1) + 5]);
        pk.w = pack2(sc[hd][s2 >> 1][8 * (s2 & 1) + 6], sc[hd][s2 >> 1][8 * (s2 & 1) + 7]);
        pf[hd] = __builtin_bit_cast(bf16x8, pk);
      }
#pragma unroll
      for (int dt = 0; dt < 2; ++dt) {
        const bf16x8 vf = *(const bf16x8*)(sV + (dt * 32 + r) * AP + s2 * 16 + h * 8);
        o[0][dt] = MFMA32(vf, pf[0], o[0][dt]);
        o[1][dt] = MFMA32(vf, pf[1], o[1][dt]);
      }
    }
    if (t + 1 < 64) {
      const int ns = st ^ 1;
#pragma unroll
      for (int j = 0; j < 2; ++j) {
        *(u32x4*)(sm + (ns * 2 + 0) * 64 * AP + kw + j * 32 * AP) = rk[j];
        u16* vd = sm + (ns * 2 + 1) * 64 * AP + vw + j * 32 * AP;
        *(u32x2*)(vd) = rv[j].xy; *(u32x2*)(vd + 8) = rv[j].zw;
      }
    }
    __syncthreads();
  }
#pragma unroll
  for (int hd = 0; hd < 2; ++hd) {
    const float l = lsum[hd] + __shfl_xor(lsum[hd], 32);
    const float il = 1.f / l;
    u16* op = p.attn + ((size_t)bi * SEQ + q0 + r) * 512 + (pair * 2 + hd) * 64 + 4 * h;
#pragma unroll
    for (int dt = 0; dt < 2; ++dt)
#pragma unroll
      for (int g = 0; g < 4; ++g) {
        u32x2 v; v.x = pack2(o[hd][dt][4 * g] * il, o[hd][dt][4 * g + 1] * il); v.y = pack2(o[hd][dt][4 * g + 2] * il, o[hd][dt][4 * g + 3] * il);
        *(u32x2*)(op + dt * 32 + 8 * g) = v;
      }
  }
}

constexpr int HQP = 136;
constexpr int HSP = 72;
constexpr int H_QM = 0;
constexpr int H_KM = H_QM + 64 * HQP * 2;
constexpr int H_KUT = H_KM + 64 * HQP * 2;
constexpr int H_IT = H_KUT + 128 * HSP * 2;
constexpr int H_F32 = H_IT + 128 * HSP * 2;
constexpr int HG_LDS = H_F32 + 7 * 128 * 4;

__device__ void hgrn_item(const Params& p, char* smem, int item) {
  const int tid = threadIdx.x, lane = tid & 63, w = __builtin_amdgcn_readfirstlane(tid >> 6), r = lane & 31, h = lane >> 5;
  const int dir = item & 1, hh = (item >> 1) & 3, bi = item >> 3;
  u16* QM = (u16*)(smem + H_QM);
  u16* KM = (u16*)(smem + H_KM);
  u16* AM = (u16*)(smem + H_KM);
  u16* KUT = (u16*)(smem + H_KUT);
  u16* IT = (u16*)(smem + H_IT);
  float* tot = (float*)(smem + H_F32);
  float* first2 = tot + 512;
  float* emid = tot + 640;
  float* dec = tot + 768;
  const u16* lf = dir ? p.lfb : p.lff;
  u16* og = dir ? p.ob : p.of;
  const int kp = lane;
  const int k16 = (2 * kp) & 15, grp = k16 >> 2;
  const int pk0 = ((2 * kp) & ~15) | ((grp == 1 ? 2 : grp == 2 ? 1 : grp) << 2) | ((2 * kp) & 3);
  const int tp = tid & 31, vc = (tid >> 5) * 16;
  f32x16 S[4];
#pragma unroll
  for (int a = 0; a < 4; ++a)
#pragma unroll
    for (int i = 0; i < 16; ++i) S[a][i] = 0.f;
  const size_t colb = (size_t)hh * 128;
  const unsigned olane = (unsigned)((dir ? 4 - 4 * h : 4 * h) * 1024 + (hh * 128 + w * 32 + r) * 2);
  uint32_t lgv[16], qv[16];
#define HG_LOAD(C)                                                                                   \
  {                                                                                                  \
    const int s0_ = dir ? SEQ - 64 * ((C) + 1) : 64 * (C);                                           \
    const size_t tb_ = (size_t)bi * SEQ + s0_;                                                       \
    _Pragma("unroll") for (int e = 0; e < 16; ++e) {                                                 \
      const int tau = 16 * w + e;                                                                    \
      const size_t tok = tb_ + (dir ? 63 - tau : tau);                                               \
      lgv[e] = *(const uint32_t*)((const char*)(lf + tok * 512 + colb) + (unsigned)(kp * 4));        \
      qv[e] = *(const uint32_t*)((const char*)(p.hq + tok * 512 + colb) + (unsigned)(kp * 4));       \
    }                                                                                                \
  }
  HG_LOAD(0)
  __syncthreads();
  for (int c0 = 0; c0 < 64 * (1 + PROBE_HG); ++c0) {
    const int c = c0 & 63;
#if PROBE_HG
    if (c0 == 64) {
#pragma unroll
      for (int a = 0; a < 4; ++a)
#pragma unroll
        for (int i = 0; i < 16; ++i) S[a][i] = 0.f;
    }
#endif
    const int s0 = dir ? SEQ - 64 * (c + 1) : 64 * c;
    const size_t tb = (size_t)bi * SEQ + s0;
    const size_t tok0 = tb + (dir ? 63 - 2 * tp : 2 * tp), tok1 = tb + (dir ? 62 - 2 * tp : 2 * tp + 1);
    const u32x4 ia0 = *(const u32x4*)(p.hi + tok0 * 512 + colb + vc), ia1 = *(const u32x4*)(p.hi + tok0 * 512 + colb + vc + 8);
    const u32x4 ib0 = *(const u32x4*)(p.hi + tok1 * 512 + colb + vc), ib1 = *(const u32x4*)(p.hi + tok1 * 512 + colb + vc + 8);
    {
      float2 run = make_float2(0.f, 0.f);
#pragma unroll
      for (int e = 0; e < 16; ++e) { run.x += h2f_lo(lgv[e]); run.y += h2f_hi(lgv[e]); }
      *(float2*)(tot + w * 128 + 2 * kp) = run;
      if (w == 2) *(float2*)(first2 + 2 * kp) = make_float2(h2f_lo(lgv[0]), h2f_hi(lgv[0]));
    }
    __syncthreads();
    {
      const float2 t0 = *(const float2*)(tot + 2 * kp), t1 = *(const float2*)(tot + 128 + 2 * kp);
      const float2 t2 = *(const float2*)(tot + 256 + 2 * kp), t3 = *(const float2*)(tot + 384 + 2 * kp);
      const float2 f2 = *(const float2*)(first2 + 2 * kp);
      float2 pre = make_float2(0.f, 0.f);
      if (w > 0) { pre.x += t0.x; pre.y += t0.y; }
      if (w > 1) { pre.x += t1.x; pre.y += t1.y; }
      if (w > 2) { pre.x += t2.x; pre.y += t2.y; }
      const float2 bmid = make_float2(t0.x + t1.x + f2.x, t0.y + t1.y + f2.y);
      const float2 blast = make_float2(t0.x + t1.x + t2.x + t3.x, t0.y + t1.y + t2.y + t3.y);
      const float ccx = fast_exp2(blast.x - bmid.x), ccy = fast_exp2(blast.y - bmid.y);
      uint32_t kux[8], kuy[8];
      float pkx = 0.f, pky = 0.f;
      float2 run = make_float2(pre.x - bmid.x, pre.y - bmid.y);
#pragma unroll
      for (int e = 0; e < 16; ++e) {
        const float lgx = h2f_lo(lgv[e]), lgy = h2f_hi(lgv[e]);
        run.x += lgx; run.y += lgy;
        const float rx = run.x, ry = run.y;
        const float e1x = fast_exp2(rx), e1y = fast_exp2(ry), e2x = fast_exp2(-rx), e2y = fast_exp2(-ry);
        const float gx = 1.f - fast_exp2(lgx), gy = 1.f - fast_exp2(lgy);
        const float qx = __uint_as_float(qv[e] << 16), qy = __uint_as_float(qv[e] & 0xffff0000u);
        const float kmx = gx * e2x, kmy = gy * e2y;
        const int t = 16 * w + e;
        *(uint32_t*)(QM + t * HQP + pk0) = pack2(qx * e1x, qy * e1y);
        *(uint32_t*)(KM + t * HQP + pk0) = pack2(kmx, kmy);
        if (e & 1) { kux[e >> 1] = pack2(pkx, kmx * ccx); kuy[e >> 1] = pack2(pky, kmy * ccy); }
        else { pkx = kmx * ccx; pky = kmy * ccy; }
      }
      u32x4* d0 = (u32x4*)(KUT + (2 * kp) * HSP + 16 * w);
      u32x4* d1 = (u32x4*)(KUT + (2 * kp + 1) * HSP + 16 * w);
      u32x4 v;
      v.x = kux[0]; v.y = kux[1]; v.z = kux[2]; v.w = kux[3]; d0[0] = v;
      v.x = kux[4]; v.y = kux[5]; v.z = kux[6]; v.w = kux[7]; d0[1] = v;
      v.x = kuy[0]; v.y = kuy[1]; v.z = kuy[2]; v.w = kuy[3]; d1[0] = v;
      v.x = kuy[4]; v.y = kuy[5]; v.z = kuy[6]; v.w = kuy[7]; d1[1] = v;
      if (w == 0) {
        *(float2*)(emid + 2 * kp) = make_float2(fast_exp2(bmid.x), fast_exp2(bmid.y));
        *(float2*)(dec + 2 * kp) = make_float2(fast_exp2(blast.x), fast_exp2(blast.y));
      }
    }
    {
      uint32_t* d = (uint32_t*)(IT + vc * HSP + 2 * tp);
#pragma unroll
      for (int j = 0; j < 4; ++j) {
        d[(2 * j) * (HSP / 2)] = (ia0[j] & 0xffffu) | (ib0[j] << 16);
        d[(2 * j + 1) * (HSP / 2)] = (ia0[j] >> 16) | (ib0[j] & 0xffff0000u);
        d[(8 + 2 * j) * (HSP / 2)] = (ia1[j] & 0xffffu) | (ib1[j] << 16);
        d[(8 + 2 * j + 1) * (HSP / 2)] = (ia1[j] >> 16) | (ib1[j] & 0xffff0000u);
      }
    }
    __syncthreads();
    if (c0 + 1 < 64 * (1 + PROBE_HG)) HG_LOAD((c + 1) & 63)
    {
      const int ti = w >> 1, si = w & 1;
      f32x16 d;
#pragma unroll
      for (int i = 0; i < 16; ++i) d[i] = 0.f;
      if (w != 1) {
#pragma unroll
        for (int ks = 0; ks < 8; ++ks) {
          const bf16x8 af = *(const bf16x8*)(KM + (si * 32 + r) * HQP + ks * 16 + h * 8);
          const bf16x8 bf = *(const bf16x8*)(QM + (ti * 32 + r) * HQP + ks * 16 + h * 8);
          d = MFMA32(af, bf, d);
        }
      }
      __syncthreads();
      const int t = ti * 32 + r;
#pragma unroll
      for (int g = 0; g < 4; ++g) {
        const int sb = si * 32 + 8 * g + 4 * h;
        u32x2 v;
        v.x = pack2(sb + 0 <= t ? d[4 * g + 0] : 0.f, sb + 1 <= t ? d[4 * g + 1] : 0.f);
        v.y = pack2(sb + 2 <= t ? d[4 * g + 2] : 0.f, sb + 3 <= t ? d[4 * g + 3] : 0.f);
        *(u32x2*)(AM + t * HSP + sb) = v;
      }
    }
    __syncthreads();
    {
      f32x16 oa0, oa1;
#pragma unroll
      for (int i = 0; i < 16; ++i) { oa0[i] = 0.f; oa1[i] = 0.f; }
#pragma unroll
      for (int s4 = 0; s4 < 4; ++s4) {
        const bf16x8 ifr = *(const bf16x8*)(IT + (w * 32 + r) * HSP + 16 * s4 + 8 * h);
        const bf16x8 am1 = *(const bf16x8*)(AM + (32 + r) * HSP + 16 * s4 + 8 * h);
        oa1 = MFMA32(am1, ifr, oa1);
        if (s4 < 2) {
          const bf16x8 am0 = *(const bf16x8*)(AM + r * HSP + 16 * s4 + 8 * h);
          oa0 = MFMA32(am0, ifr, oa0);
        }
      }
#pragma unroll
      for (int ks = 0; ks < 8; ++ks) {
        const int kt4 = ks >> 1, hf = ks & 1;
        const float4 ea = *(const float4*)(emid + kt4 * 32 + 16 * hf + 4 * h);
        const float4 eb = *(const float4*)(emid + kt4 * 32 + 16 * hf + 8 + 4 * h);
        u32x4 pk;
        pk.x = pack2(S[kt4][8 * hf + 0] * ea.x, S[kt4][8 * hf + 1] * ea.y);
        pk.y = pack2(S[kt4][8 * hf + 2] * ea.z, S[kt4][8 * hf + 3] * ea.w);
        pk.z = pack2(S[kt4][8 * hf + 4] * eb.x, S[kt4][8 * hf + 5] * eb.y);
        pk.w = pack2(S[kt4][8 * hf + 6] * eb.z, S[kt4][8 * hf + 7] * eb.w);
        const bf16x8 sp = __builtin_bit_cast(bf16x8, pk);
        const bf16x8 qf0 = *(const bf16x8*)(QM + r * HQP + ks * 16 + 8 * h);
        const bf16x8 qf1 = *(const bf16x8*)(QM + (32 + r) * HQP + ks * 16 + 8 * h);
        oa0 = MFMA32(qf0, sp, oa0);
        oa1 = MFMA32(qf1, sp, oa1);
      }
      char* ogb = (char*)og + olane;
#pragma unroll
      for (int i = 0; i < 16; ++i) {
        const int ci = (i & 3) + 8 * (i >> 2);
        const size_t r0 = dir ? tb + 59 - ci : tb + ci;
        const size_t r1 = dir ? tb + 27 - ci : tb + 32 + ci;
        *(u16*)(ogb + r0 * 1024) = f2bf(oa0[i]);
        *(u16*)(ogb + r1 * 1024) = f2bf(oa1[i]);
      }
    }
#pragma unroll
    for (int kt4 = 0; kt4 < 4; ++kt4) {
#pragma unroll
      for (int g = 0; g < 4; ++g) {
        const float4 dd = *(const float4*)(dec + kt4 * 32 + 8 * g + 4 * h);
        S[kt4][4 * g + 0] *= dd.x; S[kt4][4 * g + 1] *= dd.y; S[kt4][4 * g + 2] *= dd.z; S[kt4][4 * g + 3] *= dd.w;
      }
    }
#pragma unroll
    for (int s4 = 0; s4 < 4; ++s4) {
      const bf16x8 ifr = *(const bf16x8*)(IT + (w * 32 + r) * HSP + 16 * s4 + 8 * h);
#pragma unroll
      for (int kt4 = 0; kt4 < 4; ++kt4) {
        const bf16x8 kf = *(const bf16x8*)(KUT + (kt4 * 32 + r) * HSP + 16 * s4 + 8 * h);
        S[kt4] = MFMA32(kf, ifr, S[kt4]);
      }
    }
    __syncthreads();
  }
#undef HG_LOAD
}

__global__ __launch_bounds__(256) void naive_attn(Params p) {
  const int gid = blockIdx.x * 256 + threadIdx.x;
  const int s = gid & 4095, bh = gid >> 12, head = bh & 7, bi = bh >> 3, kvh = head >> 2;
  float qv[64], acc[64];
  const u16* qp = p.q + ((size_t)(bi * 8 + head) * SEQ + s) * 64;
#pragma unroll
  for (int d = 0; d < 64; ++d) { qv[d] = bf2f(qp[d]); acc[d] = 0.f; }
  float mx = -INFINITY, l = 0.f;
  const u16* kp = p.k + (size_t)(bi * 2 + kvh) * SEQ * 64;
  const u16* vp = p.vT + (size_t)(bi * 2 + kvh) * 64 * SEQ;
  for (int key = 0; key < SEQ; ++key) {
    float sc = 0.f;
#pragma unroll
    for (int d = 0; d < 64; ++d) sc += qv[d] * bf2f(kp[(size_t)key * 64 + d]);
    const float mn = fmaxf(mx, sc);
    const float al = exp2f(mx - mn), pp = exp2f(sc - mn);
    l = l * al + pp;
#pragma unroll
    for (int d = 0; d < 64; ++d) acc[d] = acc[d] * al + pp * bf2f(vp[(size_t)d * SEQ + key]);
    mx = mn;
  }
  const float il = 1.f / l;
  u16* op = p.attn + ((size_t)bi * SEQ + s) * 512 + head * 64;
#pragma unroll
  for (int d = 0; d < 64; ++d) op[d] = f2bf(acc[d] * il);
}

__global__ __launch_bounds__(1024) void naive_hgrn(Params p) {
  __shared__ float red[8][128];
  const int dir = blockIdx.x & 1, hh = (blockIdx.x >> 1) & 3, bi = blockIdx.x >> 3;
  const int v = threadIdx.x & 127, kq = threadIdx.x >> 7;
  float S[16];
#pragma unroll
  for (int i = 0; i < 16; ++i) S[i] = 0.f;
  const u16* lf = dir ? p.lfb : p.lff;
  u16* o = dir ? p.ob : p.of;
  for (int step = 0; step < SEQ; ++step) {
    const int s = dir ? SEQ - 1 - step : step;
    const size_t base = ((size_t)bi * SEQ + s) * 512 + hh * 128;
    const float iv = bf2f(p.hi[base + v]);
    float part = 0.f;
#pragma unroll
    for (int kk = 0; kk < 16; ++kk) {
      const int k = kq * 16 + kk;
      const float lg = (float)__builtin_bit_cast(_Float16, lf[base + k]);
      const float f = exp2f(lg), g = 1.f - f;
      const float qk = bf2f(p.hq[base + k]);
      S[kk] = f * S[kk] + g * iv;
      part += S[kk] * qk;
    }
    red[kq][v] = part;
    __syncthreads();
    if (kq == 0) {
      float t = 0.f;
#pragma unroll
      for (int j = 0; j < 8; ++j) t += red[j][v];
      o[base + v] = f2bf(t);
    }
    __syncthreads();
  }
}

DI void unpack8(const uint4 u, float (&v)[8]) {
  v[0] = __uint_as_float(u.x << 16); v[1] = __uint_as_float(u.x & 0xffff0000u);
  v[2] = __uint_as_float(u.y << 16); v[3] = __uint_as_float(u.y & 0xffff0000u);
  v[4] = __uint_as_float(u.z << 16); v[5] = __uint_as_float(u.z & 0xffff0000u);
  v[6] = __uint_as_float(u.w << 16); v[7] = __uint_as_float(u.w & 0xffff0000u);
}
__device__ void phase_mix(const Params& p, int bid, int nblk) {
  const int lane = threadIdx.x & 63, w = threadIdx.x >> 6;
  u16* mix = p.mix;
  float wa[8], wh[8];
#pragma unroll
  for (int e = 0; e < 8; ++e) { wa[e] = p.attn_norm_w[lane * 8 + e]; wh[e] = p.hg_norm_w[(lane & 15) * 8 + e]; }
  const int stride = nblk * 4;
  for (int m0 = bid * 4 + w; m0 < MTOK; m0 += 4 * stride) {
    uint4 ua[4], ug[4], u1[4], u2[4], uh[4];
#pragma unroll
    for (int u = 0; u < 4; ++u) {
      const int m = m0 + u * stride;
      if (m < MTOK) {
        const size_t rb = (size_t)m * 512 + lane * 8;
        ua[u] = *(const uint4*)(p.attn + rb); ug[u] = *(const uint4*)(p.ga + rb);
        u1[u] = *(const uint4*)(p.of + rb); u2[u] = *(const uint4*)(p.ob + rb); uh[u] = *(const uint4*)(p.gh + rb);
      }
    }
#pragma unroll
    for (int u = 0; u < 4; ++u) {
      const int m = m0 + u * stride;
      if (m < MTOK) {
        float a[8], g[8], f1[8], f2[8];
        unpack8(ua[u], a); unpack8(ug[u], g);
        float ss = 0.f;
#pragma unroll
        for (int e = 0; e < 8; ++e) ss += a[e] * a[e];
#pragma unroll
        for (int o = 32; o >= 1; o >>= 1) ss += __shfl_xor(ss, o);
        float rstd = rsqrtf(ss * (1.f / 512.f) + 1e-6f);
        float r[8];
#pragma unroll
        for (int e = 0; e < 8; ++e) r[e] = a[e] * rstd * wa[e] * g[e];
        uint4 o1; o1.x = pack2(r[0], r[1]); o1.y = pack2(r[2], r[3]); o1.z = pack2(r[4], r[5]); o1.w = pack2(r[6], r[7]);
        *(uint4*)(mix + (size_t)m * 1024 + lane * 8) = o1;
        unpack8(u1[u], f1); unpack8(u2[u], f2); unpack8(uh[u], g);
        ss = 0.f;
#pragma unroll
        for (int e = 0; e < 8; ++e) { a[e] = f1[e] + f2[e]; ss += a[e] * a[e]; }
#pragma unroll
        for (int o = 8; o >= 1; o >>= 1) ss += __shfl_xor(ss, o);
        rstd = rsqrtf(ss * (1.f / 128.f) + 1e-6f);
#pragma unroll
        for (int e = 0; e < 8; ++e) r[e] = a[e] * rstd * wh[e] * g[e];
        o1.x = pack2(r[0], r[1]); o1.y = pack2(r[2], r[3]); o1.z = pack2(r[4], r[5]); o1.w = pack2(r[6], r[7]);
        *(uint4*)(mix + (size_t)m * 1024 + 512 + lane * 8) = o1;
      }
    }
  }
}

__device__ void phase3(const Params& p, char* smem, int bid, int nblk, const XMap xm) {
  const int lane = threadIdx.x & 63, w = threadIdx.x >> 6;
  const int wn = w & 1, wm = w >> 1;
  const int r0 = lane & 31, h0 = lane >> 5;
  const int ntiles = xm.xcc >= 0 ? 256 : (MTOK / 128) * 8;
  const int tstep = xm.xcc >= 0 ? xm.nloc : nblk;
  const int tend = ntiles * (1 + PROBE_P3);
  auto coords = [&](int tile0, int& mt, int& nt) {
    const int tile = tile0 >= ntiles ? tile0 - ntiles : tile0;
    if (xm.xcc >= 0) { const int c = tile >> 6, q = tile & 63; mt = xm.xcc * 32 + c * 8 + (q >> 3); nt = q & 7; }
    else { mt = tile >> 3; nt = tile & 7; }
  };
  int tile0 = xm.xcc >= 0 ? xm.rank : bid;
  while (tile0 < tend) {
    int mt_c, nt_c;
    coords(tile0, mt_c, nt_c);
    f32x16 acc[2][2];
    {
      u32x4 ra0[4], rb0[4], ra1[4], rb1[4];
      gemm_issue(p.woutT, p.mix, nt_c * 128, mt_c * 128, ra0, rb0, ra1, rb1);
      gemm_run(p.woutT, p.mix, nt_c * 128, mt_c * 128, smem, acc, ra0, rb0, ra1, rb1);
    }
    tile0 += tstep;
    {
    const int mt = mt_c, nt = nt_c;
    int r = r0, h = h0;
    asm volatile("" : "+v"(r), "+v"(h));
    float* T = (float*)smem;
#pragma unroll
    for (int b = 0; b < 2; ++b) {
      float* trow = T + (wm * 64 + b * 32 + r) * EPF + wn * 64 + 4 * h;
#pragma unroll
      for (int a = 0; a < 2; ++a)
#pragma unroll
        for (int g = 0; g < 4; ++g) {
          float4 o;
          o.x = acc[a][b][4 * g + 0]; o.y = acc[a][b][4 * g + 1]; o.z = acc[a][b][4 * g + 2]; o.w = acc[a][b][4 * g + 3];
          *(float4*)(trow + a * 32 + 8 * g) = o;
        }
    }
    __syncthreads();
    {
      const int tid = threadIdx.x;
      const int ch = tid & 31, rw = tid >> 5;
      const size_t gofs = (size_t)(mt * 128) * 1024 + nt * 128 + ch * 4;
#pragma unroll
      for (int j0 = 0; j0 < 16; j0 += 4) {
        float4 xv[4];
#pragma unroll
        for (int u = 0; u < 4; ++u) xv[u] = *(const float4*)(p.x + gofs + (size_t)((j0 + u) * 8 + rw) * 1024);
#pragma unroll
        for (int u = 0; u < 4; ++u) {
          const int row = (j0 + u) * 8 + rw;
          const float4 y = *(const float4*)(T + row * EPF + ch * 4);
          float4 o;
          o.x = DN_ALPHA * xv[u].x + y.x; o.y = DN_ALPHA * xv[u].y + y.y; o.z = DN_ALPHA * xv[u].z + y.z; o.w = DN_ALPHA * xv[u].w + y.w;
          *(float4*)(p.z + gofs + (size_t)row * 1024) = o;
        }
      }
    }
    }
  }
}

__device__ void phase4(const Params& p, int bid, int nblk) {
  const int lane = threadIdx.x & 63, w = threadIdx.x >> 6;
  const int stride = nblk * 4;
  for (int m0 = bid * 4 + w; m0 < MTOK; m0 += 4 * stride) {
    float4 v[4][4];
#pragma unroll
    for (int u = 0; u < 4; ++u) {
      const int m = m0 + u * stride;
      if (m < MTOK) {
        const float4* row = (const float4*)(p.z + (size_t)m * 1024);
#pragma unroll
        for (int j = 0; j < 4; ++j) v[u][j] = row[lane + 64 * j];
      }
    }
#pragma unroll
    for (int u = 0; u < 4; ++u) {
      const int m = m0 + u * stride;
      if (m < MTOK) {
        float4* row = (float4*)(p.out + (size_t)m * 1024);
        float s = 0.f;
#pragma unroll
        for (int j = 0; j < 4; ++j) s += v[u][j].x + v[u][j].y + v[u][j].z + v[u][j].w;
#pragma unroll
        for (int o = 32; o >= 1; o >>= 1) s += __shfl_xor(s, o);
        const float mu = s * (1.f / 1024.f);
        float q = 0.f;
#pragma unroll
        for (int j = 0; j < 4; ++j) {
          v[u][j].x -= mu; v[u][j].y -= mu; v[u][j].z -= mu; v[u][j].w -= mu;
          q += v[u][j].x * v[u][j].x + v[u][j].y * v[u][j].y + v[u][j].z * v[u][j].z + v[u][j].w * v[u][j].w;
        }
#pragma unroll
        for (int o = 32; o >= 1; o >>= 1) q += __shfl_xor(q, o);
        const float rstd = rsqrtf(q * (1.f / 1024.f) + 1e-5f);
#pragma unroll
        for (int j = 0; j < 4; ++j) {
          const float4 wv = ((const float4*)p.ln_w)[lane + 64 * j], bv = ((const float4*)p.ln_b)[lane + 64 * j];
          float4 o;
          o.x = v[u][j].x * rstd * wv.x + bv.x; o.y = v[u][j].y * rstd * wv.y + bv.y;
          o.z = v[u][j].z * rstd * wv.z + bv.z; o.w = v[u][j].w * rstd * wv.w + bv.w;
          row[lane + 64 * j] = o;
        }
      }
    }
  }
}


#define XB_TMO      128
#define XB_XCNT(j)  (256  + 64 * (j))
#define XB_XSUB(j)  (1280 + 64 * (j))
#define XB_XGEN(j)  (2304 + 64 * (j))
#define XB_TOP      3328
#define XB_TOPGEN   3392
#define XCD_BAR_WORDS 3456
#define XB_SPIN_CAP (1u << 18)
#define LAS __attribute__((address_space(3)))
DI unsigned xb_ld(unsigned* p) { return __hip_atomic_load(p, __ATOMIC_RELAXED, __HIP_MEMORY_SCOPE_AGENT); }
DI unsigned xb_add(unsigned* p, unsigned v) { return __hip_atomic_fetch_add(p, v, __ATOMIC_RELAXED, __HIP_MEMORY_SCOPE_AGENT); }
DI unsigned xb_xcc_id() { return (unsigned)__builtin_amdgcn_s_getreg((3 << 11) | 20) & 0xFu; }
#define XB_SPIN(cond, bar) do { unsigned _sp = 0; while (cond) { __builtin_amdgcn_s_sleep(1); \
    if ((++_sp & 255u) == 0u) { if (xb_ld(&(bar)[XB_TMO])) break; if (_sp > XB_SPIN_CAP) { atomicAdd(&(bar)[XB_TMO], 1u); break; } } } } while (0)
struct XcdBarrier { unsigned* bar; unsigned x; volatile LAS unsigned* st; };
DI XcdBarrier xcd_barrier_post(unsigned* bar, volatile LAS unsigned* st, unsigned& rank) {
  XcdBarrier b; b.bar = bar; b.x = xb_xcc_id(); b.st = st;
  rank = 0u;
  if (threadIdx.x == 0) rank = xb_add(&bar[XB_XCNT(b.x)], 1u);
  return b;
}
DI void xcd_barrier_complete(unsigned* bar, unsigned x, unsigned& nloc, unsigned& nx) {
  const unsigned G = gridDim.x * gridDim.y * gridDim.z;
  unsigned sum, cnt, mine, sp = 0u;
  for (;;) {
    sum = 0u; cnt = 0u; mine = 0u;
#pragma unroll
    for (unsigned j = 0; j < 16; ++j) { const unsigned c = xb_ld(&bar[XB_XCNT(j)]); sum += c; cnt += (c > 0u) ? 1u : 0u; mine = (j == x) ? c : mine; }
    if (sum == G) break;
    __builtin_amdgcn_s_sleep(1);
    if ((++sp & 255u) == 0u) { if (xb_ld(&bar[XB_TMO])) break; if (sp > XB_SPIN_CAP) { atomicAdd(&bar[XB_TMO], 1u); break; } }
  }
  nloc = mine > 0u ? mine : 1u; nx = cnt > 0u ? cnt : 1u;
}
DI void xcd_barrier(const XcdBarrier& b) {
  asm volatile("s_waitcnt vmcnt(0)" ::: "memory");
  __syncthreads();
  if (threadIdx.x == 0) {
    unsigned* bar = b.bar;
    __builtin_amdgcn_s_waitcnt(0);
    unsigned nloc = b.st[0], nx = b.st[1];
    if (nloc == 0u) { xcd_barrier_complete(bar, b.x, nloc, nx); b.st[0] = nloc; b.st[1] = nx; }
    const unsigned old = xb_add(&bar[XB_XSUB(b.x)], 1u);
    const unsigned gen = old / nloc;
    if (old + 1u == (gen + 1u) * nloc) {
      __builtin_amdgcn_fence(__ATOMIC_RELEASE, "agent");
      asm volatile("s_waitcnt vmcnt(0)" ::: "memory");
      const unsigned og = xb_add(&bar[XB_TOP], 1u);
      const unsigned tg = og / nx;
      if (og + 1u == (tg + 1u) * nx) xb_add(&bar[XB_TOPGEN], 1u);
      else XB_SPIN(xb_ld(&bar[XB_TOPGEN]) == tg, bar);
      __builtin_amdgcn_fence(__ATOMIC_ACQUIRE, "agent");
      xb_add(&bar[XB_XGEN(b.x)], 1u);
      asm volatile("s_waitcnt vmcnt(0)" ::: "memory");
    } else {
      XB_SPIN(xb_ld(&bar[XB_XGEN(b.x)]) == gen, bar);
      __builtin_amdgcn_fence(__ATOMIC_ACQUIRE, "agent");
      asm volatile("s_waitcnt vmcnt(0)" ::: "memory");
    }
  }
  __syncthreads();
}

constexpr int MEGA_LDS = HG_LDS > GEMM_LDS ? HG_LDS : GEMM_LDS;
__global__ void __launch_bounds__(256, 2) mega_kernel(Params p) {
  __shared__ __attribute__((aligned(16))) char smem[MEGA_LDS];
  __shared__ uint4 xb_words;
  __shared__ int s_item;
  __shared__ int s_xm[4];
  cg::grid_group grid = cg::this_grid();
  const int bid = blockIdx.x, nblk = gridDim.x;
  if (threadIdx.x == 0) xb_words = make_uint4(0u, 0u, 0u, 0u);
  __syncthreads();
  unsigned my_rank;
  XcdBarrier xb = xcd_barrier_post(p.bar, (volatile LAS unsigned*)&xb_words, my_rank);
  if (p.out == nullptr) grid.sync();
  phase0(p, smem, bid, nblk);
#if PROBE_P0
  phase0(p, smem, bid, nblk);
#endif
  xcd_barrier(xb);
  if (threadIdx.x == 0) {
    unsigned sum = 0;
#pragma unroll
    for (int j = 0; j < 8; ++j) sum += xb_ld(&p.bar[XB_XCNT(j)]);
    const bool ok = sum == (unsigned)nblk && xb.x < 8u && xb_words.y == 8u;
    s_xm[0] = ok ? (int)xb.x : -1; s_xm[1] = (int)my_rank; s_xm[2] = (int)xb_words.x;
  }
  __syncthreads();
  XMap xm; xm.xcc = s_xm[0]; xm.rank = s_xm[1]; xm.nloc = s_xm[2];
  phase1(p, smem, bid, nblk, xm);
  xcd_barrier(xb);
  for (int it = bid; it < 64; it += nblk) hgrn_item(p, smem, it);
  for (;;) {
    __syncthreads();
    if (threadIdx.x == 0) s_item = atomicAdd(p.ctr, 1);
    __syncthreads();
    const int it = __builtin_amdgcn_readfirstlane(s_item);
    if (it >= 1024 + 2048) break;
    if (it < 1024) attn_item(p, smem, it);
    else { const int g = it - 1024, jj = g & 7; p1_tile(p, smem, g >> 3, jj < 4 ? 6 + jj : 22 + jj); }
  }
  xcd_barrier(xb);
  phase_mix(p, bid, nblk);
#if PROBE_MIX
  phase_mix(p, bid, nblk);
#endif
  xcd_barrier(xb);
  phase3(p, smem, bid, nblk, xm);
  xcd_barrier(xb);
  phase4(p, bid, nblk);
}

__global__ __launch_bounds__(256) void k_phase0(Params p) { __shared__ __attribute__((aligned(16))) char smem[64 * 65 * 4]; phase0(p, smem, blockIdx.x, gridDim.x); }
__global__ __launch_bounds__(256) void k_phase1(Params p) { __shared__ __attribute__((aligned(16))) char smem[GEMM_LDS]; XMap xm; xm.xcc = -1; xm.rank = 0; xm.nloc = 1; phase1(p, smem, blockIdx.x, gridDim.x, xm); }
__global__ __launch_bounds__(256) void k_attn(Params p) { __shared__ __attribute__((aligned(16))) char smem[GEMM_LDS]; for (int it = blockIdx.x; it < 3072; it += gridDim.x) { if (it < 1024) attn_item(p, smem, it); else { const int g = it - 1024, jj = g & 7; p1_tile(p, smem, g >> 3, jj < 4 ? 6 + jj : 22 + jj); } } }
__global__ __launch_bounds__(256) void k_hgrn(Params p) { __shared__ __attribute__((aligned(16))) char smem[HG_LDS]; for (int it = blockIdx.x; it < 64; it += gridDim.x) hgrn_item(p, smem, it); }
__global__ __launch_bounds__(256) void k_mix(Params p) { phase_mix(p, blockIdx.x, gridDim.x); }
__global__ __launch_bounds__(256) void k_phase3(Params p) { __shared__ __attribute__((aligned(16))) char smem[GEMM_LDS]; XMap xm; xm.xcc = -1; xm.rank = 0; xm.nloc = 1; phase3(p, smem, blockIdx.x, gridDim.x, xm); }
__global__ __launch_bounds__(256) void k_phase4(Params p) { phase4(p, blockIdx.x, gridDim.x); }

extern "C" void kernel_launch(void* const* d_in, const int* in_sizes, int n_in, void* d_out, int out_size, void* d_ws, size_t ws_size,
                              hipStream_t stream) {
  Params p{};
  p.x = (const float*)d_in[0]; p.w_in = (const float*)d_in[1]; p.q_norm_w = (const float*)d_in[2]; p.k_norm_w = (const float*)d_in[3];
  p.attn_norm_w = (const float*)d_in[4]; p.lb_logits = (const float*)d_in[5]; p.hg_norm_w = (const float*)d_in[6];
  p.w_out = (const float*)d_in[7]; p.ln_w = (const float*)d_in[8]; p.ln_b = (const float*)d_in[9];
  p.out = (float*)d_out;
  char* ws = (char*)d_ws;
  size_t off = 0;
  auto take = [&](size_t bytes) { char* r = ws + off; off += (bytes + 255) & ~(size_t)255; return r; };
  p.xb = (u16*)take((size_t)MTOK * 1024 * 2);
  p.winT = (u16*)take((size_t)INW * 1024 * 2);
  p.woutT = (u16*)take((size_t)1024 * 1024 * 2);
  p.rope = (float2*)take(1024 * 8);
  p.lbv = (float*)take(1024 * 4);
  p.q = (u16*)take((size_t)MTOK * 512 * 2);
  p.k = (u16*)take((size_t)MTOK * 128 * 2);
  p.vT = (u16*)take((size_t)MTOK * 128 * 2);
  p.ga = (u16*)take((size_t)MTOK * 512 * 2);
  p.hq = (u16*)take((size_t)MTOK * 512 * 2);
  p.hi = (u16*)take((size_t)MTOK * 512 * 2);
  p.lff = (u16*)take((size_t)MTOK * 512 * 4);
  p.lfb = (u16*)take((size_t)MTOK * 512 * 4);
  p.gh = (u16*)take((size_t)MTOK * 512 * 2);
  p.attn = (u16*)take((size_t)MTOK * 512 * 2);
  p.of = (u16*)take((size_t)MTOK * 512 * 2);
  p.ob = (u16*)take((size_t)MTOK * 512 * 2);
  p.ctr = (int*)take(256);
  p.bar = (unsigned*)take(XCD_BAR_WORDS * 4);
  p.mix = p.hq;
  p.z = (float*)p.lff;
  if (off > ws_size) { fprintf(stderr, "workspace too small: need %zu have %zu\n", off, ws_size); return; }
#if ONE_LAUNCH
  static int grid_blocks = 0;
  if (!grid_blocks) {
    int dev = 0, cus = 0, per_cu = 0;
    hipGetDevice(&dev);
    hipDeviceGetAttribute(&cus, hipDeviceAttributeMultiprocessorCount, dev);
    hipOccupancyMaxActiveBlocksPerMultiprocessor(&per_cu, mega_kernel, 256, 0);
    if (per_cu > 2) per_cu = 2;
    grid_blocks = cus * per_cu;
    if (grid_blocks < 64) fprintf(stderr, "grid too small: %d\n", grid_blocks);
  }
  hipMemsetAsync(p.ctr, 0, 256 + ((XCD_BAR_WORDS * 4 + 255) & ~255), stream);
  void* args[] = {&p};
  hipError_t e = hipLaunchCooperativeKernel((void*)mega_kernel, dim3(grid_blocks), dim3(256), args, 0, stream);
  if (e != hipSuccess) fprintf(stderr, "cooperative launch failed: %s (grid %d)\n", hipGetErrorString(e), grid_blocks);
#else
  k_phase0<<<1024, 256, 0, stream>>>(p);
  k_phase1<<<512, 256, 0, stream>>>(p);
  k_attn<<<2048, 256, 0, stream>>>(p);
  k_hgrn<<<64, 256, 0, stream>>>(p);
  k_mix<<<2048, 256, 0, stream>>>(p);
  k_phase3<<<512, 256, 0, stream>>>(p);
  k_phase4<<<2048, 256, 0, stream>>>(p);
#endif
}
```

```cpp
#include <hip/hip_runtime.h>
#include <hip/hip_cooperative_groups.h>
#include <stdint.h>
#include <stdio.h>

namespace cg = cooperative_groups;

#ifndef ONE_LAUNCH
#define ONE_LAUNCH 1
#endif
#ifndef PROBE_P0
#define PROBE_P0 0
#endif
#ifndef PROBE_MIX
#define PROBE_MIX 0
#endif
#ifndef PROBE_P1
#define PROBE_P1 0
#endif
#ifndef PROBE_HG
#define PROBE_HG 0
#endif
#ifndef PROBE_AT
#define PROBE_AT 0
#endif
#ifndef PROBE_P3
#define PROBE_P3 0
#endif

typedef __attribute__((ext_vector_type(8))) short bf16x8;
typedef __attribute__((ext_vector_type(4))) short s16x4;
typedef __attribute__((ext_vector_type(16))) float f32x16;
typedef unsigned short u16;
typedef __attribute__((ext_vector_type(4))) unsigned u32x4;
typedef __attribute__((ext_vector_type(2))) unsigned u32x2;

#define DI __device__ __forceinline__
#define MFMA32(a, b, c) __builtin_amdgcn_mfma_f32_32x32x16_bf16((a), (b), (c), 0, 0, 0)

constexpr int MTOK = 32768;
constexpr int SEQ = 4096;
constexpr int DM = 1024;
constexpr int INW = 3840;
constexpr float Q_PRESCALE = 0.125f * 1.4426950408889634f;
constexpr float HQ_SCALE = 0.08838834764831845f;
constexpr float DN_ALPHA = 1.189207115002721f;

struct Params {
  const float* x; const float* w_in; const float* q_norm_w; const float* k_norm_w;
  const float* attn_norm_w; const float* lb_logits; const float* hg_norm_w; const float* w_out;
  const float* ln_w; const float* ln_b;
  float* out;
  u16* xb;
  u16* winT;
  u16* woutT;
  float2* rope;
  float* lbv;
  u16* q;
  u16* k;
  u16* vT;
  u16* ga;
  u16* hq;
  u16* hi;
  u16* lff;
  u16* lfb;
  u16* gh;
  u16* attn;
  u16* of;
  u16* ob;
  int* ctr;
  unsigned* bar;
  u16* mix;
  float* z;
};

DI u16 f2bf(float x) { uint32_t u = __float_as_uint(x); u += 0x7fffu + ((u >> 16) & 1u); return (u16)(u >> 16); }
DI float bf2f(u16 v) { return __uint_as_float(((uint32_t)v) << 16); }
typedef __attribute__((ext_vector_type(2))) float f32x2_t;
typedef __attribute__((ext_vector_type(2))) __bf16 bf16x2_t;
DI uint32_t pack2(float a, float b) { f32x2_t v = {a, b}; bf16x2_t r = __builtin_convertvector(v, bf16x2_t); return __builtin_bit_cast(uint32_t, r); }
typedef __attribute__((ext_vector_type(2))) _Float16 f16x2_t;
DI uint32_t pack2h(float a, float b) { f16x2_t r = {(_Float16)a, (_Float16)b}; return __builtin_bit_cast(uint32_t, r); }
DI float h2f_lo(uint32_t u) { return (float)__builtin_bit_cast(f16x2_t, u)[0]; }
DI float h2f_hi(uint32_t u) { return (float)__builtin_bit_cast(f16x2_t, u)[1]; }
DI int crow(int i, int h) { return (i & 3) + 8 * (i >> 2) + 4 * h; }
DI float silu_f(float v) { return v * __builtin_amdgcn_rcpf(1.f + __expf(-v)); }

__device__ void phase0(const Params& p, char* smem, int bid, int nblk) {
  const int tid = threadIdx.x;
  {
    const size_t nvec = (size_t)MTOK * DM / 8;
    const size_t T = (size_t)nblk * 256;
    for (size_t i = (size_t)bid * 256 + tid; i < nvec; i += 4 * T) {
      float4 a[4], b[4];
#pragma unroll
      for (int u = 0; u < 4; ++u) {
        const size_t ii = i + u * T;
        if (ii < nvec) { a[u] = ((const float4*)p.x)[2 * ii]; b[u] = ((const float4*)p.x)[2 * ii + 1]; }
      }
#pragma unroll
      for (int u = 0; u < 4; ++u) {
        const size_t ii = i + u * T;
        if (ii < nvec) {
          uint4 o; o.x = pack2(a[u].x, a[u].y); o.y = pack2(a[u].z, a[u].w); o.z = pack2(b[u].x, b[u].y); o.w = pack2(b[u].z, b[u].w);
          ((uint4*)p.xb)[ii] = o;
        }
      }
    }
  }
  {
    float* t = (float*)smem;
    const int ntile_in = 16 * 60, ntile_all = ntile_in + 16 * 16;
    for (int tile = bid; tile < ntile_all; tile += nblk) {
      const float* src; u16* dst; int N, kt, nt;
      if (tile < ntile_in) { src = p.w_in; dst = p.winT; N = INW; kt = tile / 60; nt = tile % 60; }
      else { int tt = tile - ntile_in; src = p.w_out; dst = p.woutT; N = DM; kt = tt / 16; nt = tt % 16; }
      __syncthreads();
#pragma unroll
      for (int j = 0; j < 4; ++j) {
        const int kk = (tid >> 4) + 16 * j, nn = (tid & 15) * 4;
        const float4 v = *(const float4*)(src + (size_t)(kt * 64 + kk) * N + nt * 64 + nn);
        t[kk * 65 + nn] = v.x; t[kk * 65 + nn + 1] = v.y; t[kk * 65 + nn + 2] = v.z; t[kk * 65 + nn + 3] = v.w;
      }
      __syncthreads();
      const int n = tid >> 2, kc = (tid & 3) * 16;
      uint32_t o[8];
#pragma unroll
      for (int j = 0; j < 8; ++j) o[j] = pack2(t[(kc + 2 * j) * 65 + n], t[(kc + 2 * j + 1) * 65 + n]);
      uint4* d = (uint4*)(dst + (size_t)(nt * 64 + n) * 1024 + kt * 64 + kc);
      d[0] = make_uint4(o[0], o[1], o[2], o[3]);
      d[1] = make_uint4(o[4], o[5], o[6], o[7]);
    }
  }
  for (int i = bid * 256 + tid; i < 2048; i += nblk * 256) {
    if (i < 1024) {
      const int pos = i >> 4, j = i & 15;
      const float inv = powf(10000.f, -(float)(2 * j) / 32.f);
      const float ang = (float)pos * inv;
      p.rope[i] = make_float2(cosf(ang), sinf(ang));
    } else {
      const int ii = i - 1024, dir = ii >> 9, wcol = ii & 511;
      const float l0 = p.lb_logits[(dir * 2 + 0) * 512 + wcol], l1 = p.lb_logits[(dir * 2 + 1) * 512 + wcol];
      const float mx = fmaxf(l0, l1);
      const float e0 = expf(l0 - mx), e1 = expf(l1 - mx);
      p.lbv[ii] = e0 / (e0 + e1);
    }
  }
}

constexpr int GP = 72;
constexpr int EP = 136;
constexpr int EPF = 132;
constexpr int GEMM_LDS = 2 * 2 * 128 * GP * 2;

DI void gemm_issue(const u16* __restrict__ A, const u16* __restrict__ B, int n0, int m0,
                   u32x4 (&ra0)[4], u32x4 (&rb0)[4], u32x4 (&ra1)[4], u32x4 (&rb1)[4]) {
  const int tid = threadIdx.x;
  const int lc = tid & 7, lr = tid >> 3;
  const u16* gA = A + (size_t)(n0 + lr) * 1024 + lc * 8;
  const u16* gB = B + (size_t)(m0 + lr) * 1024 + lc * 8;
#pragma unroll
  for (int j = 0; j < 4; ++j) { ra0[j] = *(const u32x4*)(gA + (size_t)j * 32 * 1024); rb0[j] = *(const u32x4*)(gB + (size_t)j * 32 * 1024); }
#pragma unroll
  for (int j = 0; j < 4; ++j) { ra1[j] = *(const u32x4*)(gA + (size_t)j * 32 * 1024 + 64); rb1[j] = *(const u32x4*)(gB + (size_t)j * 32 * 1024 + 64); }
}
DI void gemm_run(const u16* __restrict__ A, const u16* __restrict__ B, int n0, int m0, char* smem, f32x16 (&acc)[2][2],
                 u32x4 (&ra0)[4], u32x4 (&rb0)[4], u32x4 (&ra1)[4], u32x4 (&rb1)[4]) {
  const int tid = threadIdx.x, lane = tid & 63, w = __builtin_amdgcn_readfirstlane(tid >> 6);
  const int wn = w & 1, wm = w >> 1;
  const int lc = tid & 7, lr = tid >> 3;
  u16* sm = (u16*)smem;
  const u16* gA = A + (size_t)(n0 + lr) * 1024 + lc * 8;
  const u16* gB = B + (size_t)(m0 + lr) * 1024 + lc * 8;
#pragma unroll
  for (int a = 0; a < 2; ++a)
#pragma unroll
    for (int b = 0; b < 2; ++b)
#pragma unroll
      for (int i = 0; i < 16; ++i) acc[a][b][i] = 0.f;
  u32x4 ra2[4], rb2[4];
#define GEMM_LOAD(RA, RB, KT) _Pragma("unroll") for (int j = 0; j < 4; ++j) { \
    RA[j] = *(const u32x4*)(gA + (size_t)j * 32 * 1024 + (KT) * 64); RB[j] = *(const u32x4*)(gB + (size_t)j * 32 * 1024 + (KT) * 64); }
#define GEMM_STORE(RA, RB, ST) _Pragma("unroll") for (int j = 0; j < 4; ++j) { \
    *(u32x4*)(sm + (((ST) * 2 + 0) * 128 + lr + 32 * j) * GP + lc * 8) = RA[j]; *(u32x4*)(sm + (((ST) * 2 + 1) * 128 + lr + 32 * j) * GP + lc * 8) = RB[j]; }
  GEMM_LOAD(ra2, rb2, 2)
  __syncthreads();
  GEMM_STORE(ra0, rb0, 0)
  __syncthreads();
  const int fr = lane & 31, fh = lane >> 5;
  const u16* fa = sm + (wn * 64 + fr) * GP + fh * 8;
  const u16* fb = sm + (128 + wm * 64 + fr) * GP + fh * 8;
#define GEMM_COMPUTE(ST)                                                                          \
  _Pragma("unroll") for (int ks = 0; ks < 4; ++ks) {                                              \
    bf16x8 af[2], bfr[2];                                                                         \
    _Pragma("unroll") for (int a = 0; a < 2; ++a) af[a] = *(const bf16x8*)(fa + ((ST) * 256 + a * 32) * GP + ks * 16);   \
    _Pragma("unroll") for (int b = 0; b < 2; ++b) bfr[b] = *(const bf16x8*)(fb + ((ST) * 256 + b * 32) * GP + ks * 16);  \
    _Pragma("unroll") for (int a = 0; a < 2; ++a)                                                 \
      _Pragma("unroll") for (int b = 0; b < 2; ++b) acc[a][b] = MFMA32(af[a], bfr[b], acc[a][b]); \
  }
#define GEMM_SUB(K, RAL, RBL, RAW, RBW)                                   \
  {                                                                       \
    if ((K) + 3 < 16) { GEMM_LOAD(RAL, RBL, (K) + 3) }                    \
    GEMM_COMPUTE((K) & 1)                                                 \
    if ((K) + 1 < 16) { GEMM_STORE(RAW, RBW, ((K) + 1) & 1) }             \
    __syncthreads();                                                      \
  }
  GEMM_SUB(0, ra0, rb0, ra1, rb1)
  GEMM_SUB(1, ra1, rb1, ra2, rb2)
  GEMM_SUB(2, ra2, rb2, ra0, rb0)
  GEMM_SUB(3, ra0, rb0, ra1, rb1)
  GEMM_SUB(4, ra1, rb1, ra2, rb2)
  GEMM_SUB(5, ra2, rb2, ra0, rb0)
  GEMM_SUB(6, ra0, rb0, ra1, rb1)
  GEMM_SUB(7, ra1, rb1, ra2, rb2)
  GEMM_SUB(8, ra2, rb2, ra0, rb0)
  GEMM_SUB(9, ra0, rb0, ra1, rb1)
  GEMM_SUB(10, ra1, rb1, ra2, rb2)
  GEMM_SUB(11, ra2, rb2, ra0, rb0)
  GEMM_SUB(12, ra0, rb0, ra1, rb1)
  GEMM_SUB(13, ra1, rb1, ra2, rb2)
  GEMM_SUB(14, ra2, rb2, ra0, rb0)
  GEMM_SUB(15, ra0, rb0, ra1, rb1)
#undef GEMM_SUB
#undef GEMM_COMPUTE
#undef GEMM_LOAD
#undef GEMM_STORE
}

struct XMap { int xcc, rank, nloc; };
__device__ __forceinline__ void p1_tile(const Params& p, char* smem, const int mt, const int nt) {
  const int lane = threadIdx.x & 63, w = threadIdx.x >> 6;
  const int wn = w & 1, wm = w >> 1;
  const int r0 = lane & 31, h0 = lane >> 5;
    f32x16 acc[2][2];
    {
      u32x4 ra0[4], rb0[4], ra1[4], rb1[4];
      gemm_issue(p.winT, p.xb, nt * 128, mt * 128, ra0, rb0, ra1, rb1);
      gemm_run(p.winT, p.xb, nt * 128, mt * 128, smem, acc, ra0, rb0, ra1, rb1);
    }
    {
    int r = r0, h = h0;
    asm volatile("" : "+v"(r), "+v"(h));
    u16* T = (u16*)smem;
    const int mbase = mt * 128 + wm * 64;
    if (nt <= 4) {
      const bool isq = nt < 4;
      const float* nw = isq ? p.q_norm_w : p.k_norm_w;
      const float sc = isq ? Q_PRESCALE : 1.0f;
#pragma unroll
      for (int b = 0; b < 2; ++b) {
        const int m = mbase + b * 32 + r;
        const int s = m & 4095;
        const int rp = s >> 6, cp = s & 63;
        float ss = 0.f;
#pragma unroll
        for (int a = 0; a < 2; ++a)
#pragma unroll
          for (int i = 0; i < 16; ++i) ss += acc[a][b][i] * acc[a][b][i];
        ss += __shfl_xor(ss, 32);
        const float rstd = rsqrtf(ss * (1.f / 64.f) + 1e-6f);
        u16* trow = T + (wm * 64 + b * 32 + r) * EP + wn * 64 + 4 * h;
#pragma unroll
        for (int a = 0; a < 2; ++a) {
          const int pos = a == 0 ? rp : cp;
          float y[16], o[16];
#pragma unroll
          for (int i = 0; i < 16; ++i) y[i] = acc[a][b][i] * rstd * nw[a * 32 + crow(i, h)];
#pragma unroll
          for (int i = 0; i < 8; ++i) {
            const float2 cs = p.rope[pos * 16 + crow(i, h)];
            o[i] = (y[i] * cs.x - y[i + 8] * cs.y) * sc;
            o[i + 8] = (y[i + 8] * cs.x + y[i] * cs.y) * sc;
          }
#pragma unroll
          for (int g = 0; g < 4; ++g) {
            u32x2 v; v.x = pack2(o[4 * g], o[4 * g + 1]); v.y = pack2(o[4 * g + 2], o[4 * g + 3]);
            *(u32x2*)(trow + a * 32 + 8 * g) = v;
          }
        }
      }
    } else if (nt == 5) {
#pragma unroll
      for (int b = 0; b < 2; ++b)
#pragma unroll
        for (int a = 0; a < 2; ++a)
#pragma unroll
          for (int i = 0; i < 16; ++i) T[(wn * 64 + a * 32 + crow(i, h)) * EP + wm * 64 + b * 32 + r] = f2bf(acc[a][b][i]);
    } else {
      const int gi = (nt - 6) >> 2;
      const int cb = ((nt - 6) & 3) * 128 + wn * 64;
#pragma unroll
      for (int b = 0; b < 2; ++b) {
        u16* trow = T + (wm * 64 + b * 32 + r) * EP + wn * 64 + 4 * h;
#pragma unroll
        for (int a = 0; a < 2; ++a)
#pragma unroll
          for (int g = 0; g < 4; ++g) {
            float v[4];
#pragma unroll
            for (int e = 0; e < 4; ++e) v[e] = acc[a][b][4 * g + e];
            u32x2 o;
            if (gi == 3 || gi == 4) {
              const float4 lb = *(const float4*)(p.lbv + (gi - 3) * 512 + cb + a * 32 + 8 * g + 4 * h);
              const float ox = __builtin_amdgcn_logf(lb.x + (1.f - lb.x) * __builtin_amdgcn_rcpf(1.f + __expf(-v[0])));
              const float oy = __builtin_amdgcn_logf(lb.y + (1.f - lb.y) * __builtin_amdgcn_rcpf(1.f + __expf(-v[1])));
              const float oz = __builtin_amdgcn_logf(lb.z + (1.f - lb.z) * __builtin_amdgcn_rcpf(1.f + __expf(-v[2])));
              const float ow = __builtin_amdgcn_logf(lb.w + (1.f - lb.w) * __builtin_amdgcn_rcpf(1.f + __expf(-v[3])));
              o.x = pack2h(ox, oy); o.y = pack2h(oz, ow);
            } else {
              if (gi == 0 || gi == 5) {
#pragma unroll
                for (int e = 0; e < 4; ++e) v[e] = silu_f(v[e]);
              } else if (gi == 1) {
#pragma unroll
                for (int e = 0; e < 4; ++e) v[e] = silu_f(v[e]) * HQ_SCALE;
              }
              o.x = pack2(v[0], v[1]); o.y = pack2(v[2], v[3]);
            }
            *(u32x2*)(trow + a * 32 + 8 * g) = o;
          }
      }
    }
    __syncthreads();
    {
      const int tid = threadIdx.x;
      const int ch = tid & 15, rw = tid >> 4;
      const int bi = (mt * 128) >> 12, s0 = (mt * 128) & 4095;
      u16* dbase; size_t rstride;
      if (nt < 4)       { dbase = p.q + ((size_t)(bi * 8 + nt * 2 + (ch >> 3)) * SEQ + s0) * 64 + (ch & 7) * 8; rstride = 64; }
      else if (nt == 4) { dbase = p.k + ((size_t)(bi * 2 + (ch >> 3)) * SEQ + s0) * 64 + (ch & 7) * 8; rstride = 64; }
      else if (nt == 5) { dbase = p.vT + (size_t)(bi * 2) * 64 * SEQ + s0 + ch * 8; rstride = SEQ; }
      else {
        const int gi = (nt - 6) >> 2;
        u16* gb = gi == 0 ? p.ga : gi == 1 ? p.hq : gi == 2 ? p.hi : gi == 3 ? p.lff : gi == 4 ? p.lfb : p.gh;
        dbase = gb + (size_t)(mt * 128) * 512 + ((nt - 6) & 3) * 128 + ch * 8; rstride = 512;
      }
#pragma unroll
      for (int j = 0; j < 8; ++j) {
        const int row = j * 16 + rw;
        const u32x4 v = *(const u32x4*)(T + row * EP + ch * 8);
        *(u32x4*)(dbase + (size_t)row * rstride) = v;
      }
    }
    }
}

__device__ void phase1(const Params& p, char* smem, int bid, int nblk, const XMap xm) {
  const int ntiles = xm.xcc >= 0 ? 704 : (MTOK / 128) * 22;
  const int tstep = xm.xcc >= 0 ? xm.nloc : nblk;
  for (int tile = xm.xcc >= 0 ? xm.rank : bid; tile < ntiles; tile += tstep) {
    int mt, j;
    if (xm.xcc >= 0) {
      int ml;
      if (tile < 512) { const int g = tile >> 8, rem = tile & 255, c = rem >> 6, q = rem & 63; ml = c * 8 + (q >> 3); j = g * 8 + (q & 7); }
      else { const int t2 = tile - 512, c = t2 / 48, q = t2 % 48; ml = c * 8 + q / 6; j = 16 + q % 6; }
      mt = xm.xcc * 32 + ml;
    } else { mt = tile / 22; j = tile % 22; }
    const int nt = j < 6 ? j : j + 4;
    p1_tile(p, smem, mt, nt);
  }
}

constexpr int AP = 72;
constexpr int ATT_LDS = 2 * 2 * 64 * AP * 2;
DI float fast_exp2(float x) { return __builtin_amdgcn_exp2f(x); }

__device__ void attn_item(const Params& p, char* smem, int item) {
  const int tid = threadIdx.x, lane = tid & 63, w = __builtin_amdgcn_readfirstlane(tid >> 6), r = lane & 31, h = lane >> 5;
  const int qb = item & 31, pair = (item >> 5) & 3, bi = item >> 7;
  const int kvh = pair >> 1;
  const int q0 = qb * 128 + w * 32;
  u16* sm = (u16*)smem;
  bf16x8 qf[2][4];
#pragma unroll
  for (int hd = 0; hd < 2; ++hd) {
    const u16* qp = p.q + ((size_t)(bi * 8 + pair * 2 + hd) * SEQ + q0 + r) * 64 + h * 8;
#pragma unroll
    for (int ks = 0; ks < 4; ++ks) qf[hd][ks] = *(const bf16x8*)(qp + ks * 16);
  }
  const int lc = tid & 7, lr = tid >> 3;
  const u16* kg = p.k + (size_t)(bi * 2 + kvh) * SEQ * 64 + (size_t)lr * 64 + lc * 8;
  const u16* vg = p.vT + (size_t)(bi * 2 + kvh) * 64 * SEQ + (size_t)lr * SEQ + lc * 8;
  const int kw = lr * AP + lc * 8;
  const int vw = lr * AP + (lc >> 1) * 16 + (lc & 1) * 4;
  u32x4 rk[2], rv[2];
#pragma unroll
  for (int j = 0; j < 2; ++j) { rk[j] = *(const u32x4*)(kg + (size_t)j * 32 * 64); rv[j] = *(const u32x4*)(vg + (size_t)j * 32 * SEQ); }
  __syncthreads();
#pragma unroll
  for (int j = 0; j < 2; ++j) {
    *(u32x4*)(sm + kw + j * 32 * AP) = rk[j];
    u16* vd = sm + 64 * AP + vw + j * 32 * AP;
    *(u32x2*)(vd) = rv[j].xy; *(u32x2*)(vd + 8) = rv[j].zw;
  }
  __syncthreads();
  f32x16 o[2][2];
#pragma unroll
  for (int hd = 0; hd < 2; ++hd)
#pragma unroll
    for (int dt = 0; dt < 2; ++dt)
#pragma unroll
      for (int i = 0; i < 16; ++i) o[hd][dt][i] = 0.f;
  float mrun[2] = {-INFINITY, -INFINITY}, lsum[2] = {0.f, 0.f};
  for (int t = 0; t < 64; ++t) {
    const int st = t & 1;
    if (t + 1 < 64) {
#pragma unroll
      for (int j = 0; j < 2; ++j) {
        rk[j] = *(const u32x4*)(kg + (size_t)((t + 1) * 64 + j * 32) * 64);
        rv[j] = *(const u32x4*)(vg + (size_t)j * 32 * SEQ + (t + 1) * 64);
      }
    }
    const u16* sK = sm + (st * 2 + 0) * 64 * AP;
    const u16* sV = sm + (st * 2 + 1) * 64 * AP;
    f32x16 sc[2][2];
#pragma unroll
    for (int kt2 = 0; kt2 < 2; ++kt2) {
#pragma unroll
      for (int hd = 0; hd < 2; ++hd)
#pragma unroll
        for (int i = 0; i < 16; ++i) sc[hd][kt2][i] = 0.f;
#pragma unroll
      for (int ks = 0; ks < 4; ++ks) {
        const bf16x8 kf = *(const bf16x8*)(sK + (kt2 * 32 + r) * AP + ks * 16 + h * 8);
        sc[0][kt2] = MFMA32(kf, qf[0][ks], sc[0][kt2]);
        sc[1][kt2] = MFMA32(kf, qf[1][ks], sc[1][kt2]);
      }
    }
#pragma unroll
    for (int hd = 0; hd < 2; ++hd) {
      float mx = sc[hd][0][0];
#pragma unroll
      for (int i = 1; i < 16; ++i) mx = fmaxf(mx, sc[hd][0][i]);
#pragma unroll
      for (int i = 0; i < 16; ++i) mx = fmaxf(mx, sc[hd][1][i]);
      mx = fmaxf(mx, __shfl_xor(mx, 32));
      if (__any(mx > mrun[hd])) {
        const float mn = fmaxf(mrun[hd], mx);
        const float al = fast_exp2(mrun[hd] - mn);
        lsum[hd] *= al;
#pragma unroll
        for (int dt = 0; dt < 2; ++dt)
#pragma unroll
          for (int i = 0; i < 16; ++i) o[hd][dt][i] *= al;
        mrun[hd] = mn;
      }
#pragma unroll
      for (int kt2 = 0; kt2 < 2; ++kt2)
#pragma unroll
        for (int i = 0; i < 16; ++i) { const float e = fast_exp2(sc[hd][kt2][i] - mrun[hd]); sc[hd][kt2][i] = e; lsum[hd] += e; }
    }
#pragma unroll
    for (int s2 = 0; s2 < 4; ++s2) {
      bf16x8 pf[2];
#pragma unroll
      for (int hd = 0; hd < 2; ++hd) {
        u32x4 pk;
        pk.x = pack2(sc[hd][s2 >> 1][8 * (s2 & 1) + 0], sc[hd][s2 >> 1][8 * (s2 & 1) + 1]);
        pk.y = pack2(sc[hd][s2 >> 1][8 * (s2 & 1) + 2], sc[hd][s2 >> 1][8 * (s2 & 1) + 3]);
        pk.z = pack2(sc[hd][s2 >> 1][8 * (s2 & 1) + 4], sc[hd][s2 >> 1][8 * (s2 & 1) + 5]);
        pk.w = pack2(sc[hd][s2 >> 1][8 * (s2 & 1) + 6], sc[hd][s2 >> 1][8 * (s2 & 1) + 7]);
        pf[hd] = __builtin_bit_cast(bf16x8, pk);
      }
#pragma unroll
      for (int dt = 0; dt < 2; ++dt) {
        const bf16x8 vf = *(const bf16x8*)(sV + (dt * 32 + r) * AP + s2 * 16 + h * 8);
        o[0][dt] = MFMA32(vf, pf[0], o[0][dt]);
        o[1][dt] = MFMA32(vf, pf[1], o[1][dt]);
      }
    }
    if (t + 1 < 64) {
      const int ns = st ^ 1;
#pragma unroll
      for (int j = 0; j < 2; ++j) {
        *(u32x4*)(sm + (ns * 2 + 0) * 64 * AP + kw + j * 32 * AP) = rk[j];
        u16* vd = sm + (ns * 2 + 1) * 64 * AP + vw + j * 32 * AP;
        *(u32x2*)(vd) = rv[j].xy; *(u32x2*)(vd + 8) = rv[j].zw;
      }
    }
    __syncthreads();
  }
#pragma unroll
  for (int hd = 0; hd < 2; ++hd) {
    const float l = lsum[hd] + __shfl_xor(lsum[hd], 32);
    const float il = 1.f / l;
    u16* op = p.attn + ((size_t)bi * SEQ + q0 + r) * 512 + (pair * 2 + hd) * 64 + 4 * h;
#pragma unroll
    for (int dt = 0; dt < 2; ++dt)
#pragma unroll
      for (int g = 0; g < 4; ++g) {
        u32x2 v; v.x = pack2(o[hd][dt][4 * g] * il, o[hd][dt][4 * g + 1] * il); v.y = pack2(o[hd][dt][4 * g + 2] * il, o[hd][dt][4 * g + 3] * il);
        *(u32x2*)(op + dt * 32 + 8 * g) = v;
      }
  }
}

constexpr int HQP = 136;
constexpr int HSP = 72;
constexpr int H_QM = 0;
constexpr int H_KM = H_QM + 64 * HQP * 2;
constexpr int H_KUT = H_KM + 64 * HQP * 2;
constexpr int H_IT = H_KUT + 128 * HSP * 2;
constexpr int H_F32 = H_IT + 128 * HSP * 2;
constexpr int HG_LDS = H_F32 + 7 * 128 * 4;

__device__ void hgrn_item(const Params& p, char* smem, int item) {
  const int tid = threadIdx.x, lane = tid & 63, w = __builtin_amdgcn_readfirstlane(tid >> 6), r = lane & 31, h = lane >> 5;
  const int dir = item & 1, hh = (item >> 1) & 3, bi = item >> 3;
  u16* QM = (u16*)(smem + H_QM);
  u16* KM = (u16*)(smem + H_KM);
  u16* AM = (u16*)(smem + H_KM);
  u16* KUT = (u16*)(smem + H_KUT);
  u16* IT = (u16*)(smem + H_IT);
  float* tot = (float*)(smem + H_F32);
  float* first2 = tot + 512;
  float* emid = tot + 640;
  float* dec = tot + 768;
  const u16* lf = dir ? p.lfb : p.lff;
  u16* og = dir ? p.ob : p.of;
  const int kp = lane;
  const int k16 = (2 * kp) & 15, grp = k16 >> 2;
  const int pk0 = ((2 * kp) & ~15) | ((grp == 1 ? 2 : grp == 2 ? 1 : grp) << 2) | ((2 * kp) & 3);
  const int tp = tid & 31, vc = (tid >> 5) * 16;
  f32x16 S[4];
#pragma unroll
  for (int a = 0; a < 4; ++a)
#pragma unroll
    for (int i = 0; i < 16; ++i) S[a][i] = 0.f;
  const size_t colb = (size_t)hh * 128;
  const unsigned olane = (unsigned)((dir ? 4 - 4 * h : 4 * h) * 1024 + (hh * 128 + w * 32 + r) * 2);
  uint32_t lgv[16], qv[16];
#define HG_LOAD(C)                                                                                   \
  {                                                                                                  \
    const int s0_ = dir ? SEQ - 64 * ((C) + 1) : 64 * (C);                                           \
    const size_t tb_ = (size_t)bi * SEQ + s0_;                                                       \
    _Pragma("unroll") for (int e = 0; e < 16; ++e) {                                                 \
      const int tau = 16 * w + e;                                                                    \
      const size_t tok = tb_ + (dir ? 63 - tau : tau);                                               \
      lgv[e] = *(const uint32_t*)((const char*)(lf + tok * 512 + colb) + (unsigned)(kp * 4));        \
      qv[e] = *(const uint32_t*)((const char*)(p.hq + tok * 512 + colb) + (unsigned)(kp * 4));       \
    }                                                                                                \
  }
  HG_LOAD(0)
  __syncthreads();
  for (int c0 = 0; c0 < 64 * (1 + PROBE_HG); ++c0) {
    const int c = c0 & 63;
#if PROBE_HG
    if (c0 == 64) {
#pragma unroll
      for (int a = 0; a < 4; ++a)
#pragma unroll
        for (int i = 0; i < 16; ++i) S[a][i] = 0.f;
    }
#endif
    const int s0 = dir ? SEQ - 64 * (c + 1) : 64 * c;
    const size_t tb = (size_t)bi * SEQ + s0;
    const size_t tok0 = tb + (dir ? 63 - 2 * tp : 2 * tp), tok1 = tb + (dir ? 62 - 2 * tp : 2 * tp + 1);
    const u32x4 ia0 = *(const u32x4*)(p.hi + tok0 * 512 + colb + vc), ia1 = *(const u32x4*)(p.hi + tok0 * 512 + colb + vc + 8);
    const u32x4 ib0 = *(const u32x4*)(p.hi + tok1 * 512 + colb + vc), ib1 = *(const u32x4*)(p.hi + tok1 * 512 + colb + vc + 8);
    {
      float2 run = make_float2(0.f, 0.f);
#pragma unroll
      for (int e = 0; e < 16; ++e) { run.x += h2f_lo(lgv[e]); run.y += h2f_hi(lgv[e]); }
      *(float2*)(tot + w * 128 + 2 * kp) = run;
      if (w == 2) *(float2*)(first2 + 2 * kp) = make_float2(h2f_lo(lgv[0]), h2f_hi(lgv[0]));
    }
    __syncthreads();
    {
      const float2 t0 = *(const float2*)(tot + 2 * kp), t1 = *(const float2*)(tot + 128 + 2 * kp);
      const float2 t2 = *(const float2*)(tot + 256 + 2 * kp), t3 = *(const float2*)(tot + 384 + 2 * kp);
      const float2 f2 = *(const float2*)(first2 + 2 * kp);
      float2 pre = make_float2(0.f, 0.f);
      if (w > 0) { pre.x += t0.x; pre.y += t0.y; }
      if (w > 1) { pre.x += t1.x; pre.y += t1.y; }
      if (w > 2) { pre.x += t2.x; pre.y += t2.y; }
      const float2 bmid = make_float2(t0.x + t1.x + f2.x, t0.y + t1.y + f2.y);
      const float2 blast = make_float2(t0.x + t1.x + t2.x + t3.x, t0.y + t1.y + t2.y + t3.y);
      const float ccx = fast_exp2(blast.x - bmid.x), ccy = fast_exp2(blast.y - bmid.y);
      uint32_t kux[8], kuy[8];
      float pkx = 0.f, pky = 0.f;
      float2 run = make_float2(pre.x - bmid.x, pre.y - bmid.y);
#pragma unroll
      for (int e = 0; e < 16; ++e) {
        const float lgx = h2f_lo(lgv[e]), lgy = h2f_hi(lgv[e]);
        run.x += lgx; run.y += lgy;
        const float rx = run.x, ry = run.y;
        const float e1x = fast_exp2(rx), e1y = fast_exp2(ry), e2x = fast_exp2(-rx), e2y = fast_exp2(-ry);
        const float gx = 1.f - fast_exp2(lgx), gy = 1.f - fast_exp2(lgy);
        const float qx = __uint_as_float(qv[e] << 16), qy = __uint_as_float(qv[e] & 0xffff0000u);
        const float kmx = gx * e2x, kmy = gy * e2y;
        const int t = 16 * w + e;
        *(uint32_t*)(QM + t * HQP + pk0) = pack2(qx * e1x, qy * e1y);
        *(uint32_t*)(KM + t * HQP + pk0) = pack2(kmx, kmy);
        if (e & 1) { kux[e >> 1] = pack2(pkx, kmx * ccx); kuy[e >> 1] = pack2(pky, kmy * ccy); }
        else { pkx = kmx * ccx; pky = kmy * ccy; }
      }
      u32x4* d0 = (u32x4*)(KUT + (2 * kp) * HSP + 16 * w);
      u32x4* d1 = (u32x4*)(KUT + (2 * kp + 1) * HSP + 16 * w);
      u32x4 v;
      v.x = kux[0]; v.y = kux[1]; v.z = kux[2]; v.w = kux[3]; d0[0] = v;
      v.x = kux[4]; v.y = kux[5]; v.z = kux[6]; v.w = kux[7]; d0[1] = v;
      v.x = kuy[0]; v.y = kuy[1]; v.z = kuy[2]; v.w = kuy[3]; d1[0] = v;
      v.x = kuy[4]; v.y = kuy[5]; v.z = kuy[6]; v.w = kuy[7]; d1[1] = v;
      if (w == 0) {
        *(float2*)(emid + 2 * kp) = make_float2(fast_exp2(bmid.x), fast_exp2(bmid.y));
        *(float2*)(dec + 2 * kp) = make_float2(fast_exp2(blast.x), fast_exp2(blast.y));
      }
    }
    {
      uint32_t* d = (uint32_t*)(IT + vc * HSP + 2 * tp);
#pragma unroll
      for (int j = 0; j < 4; ++j) {
        d[(2 * j) * (HSP / 2)] = (ia0[j] & 0xffffu) | (ib0[j] << 16);
        d[(2 * j + 1) * (HSP / 2)] = (ia0[j] >> 16) | (ib0[j] & 0xffff0000u);
        d[(8 + 2 * j) * (HSP / 2)] = (ia1[j] & 0xffffu) | (ib1[j] << 16);
        d[(8 + 2 * j + 1) * (HSP / 2)] = (ia1[j] >> 16) | (ib1[j] & 0xffff0000u);
      }
    }
    __syncthreads();
    if (c0 + 1 < 64 * (1 + PROBE_HG)) HG_LOAD((c + 1) & 63)
    {
      const int ti = w >> 1, si = w & 1;
      f32x16 d;
#pragma unroll
      for (int i = 0; i < 16; ++i) d[i] = 0.f;
      if (w != 1) {
#pragma unroll
        for (int ks = 0; ks < 8; ++ks) {
          const bf16x8 af = *(const bf16x8*)(KM + (si * 32 + r) * HQP + ks * 16 + h * 8);
          const bf16x8 bf = *(const bf16x8*)(QM + (ti * 32 + r) * HQP + ks * 16 + h * 8);
          d = MFMA32(af, bf, d);
        }
      }
      __syncthreads();
      const int t = ti * 32 + r;
#pragma unroll
      for (int g = 0; g < 4; ++g) {
        const int sb = si * 32 + 8 * g + 4 * h;
        u32x2 v;
        v.x = pack2(sb + 0 <= t ? d[4 * g + 0] : 0.f, sb + 1 <= t ? d[4 * g + 1] : 0.f);
        v.y = pack2(sb + 2 <= t ? d[4 * g + 2] : 0.f, sb + 3 <= t ? d[4 * g + 3] : 0.f);
        *(u32x2*)(AM + t * HSP + sb) = v;
      }
    }
    __syncthreads();
    {
      f32x16 oa0, oa1;
#pragma unroll
      for (int i = 0; i < 16; ++i) { oa0[i] = 0.f; oa1[i] = 0.f; }
#pragma unroll
      for (int s4 = 0; s4 < 4; ++s4) {
        const bf16x8 ifr = *(const bf16x8*)(IT + (w * 32 + r) * HSP + 16 * s4 + 8 * h);
        const bf16x8 am1 = *(const bf16x8*)(AM + (32 + r) * HSP + 16 * s4 + 8 * h);
        oa1 = MFMA32(am1, ifr, oa1);
        if (s4 < 2) {
          const bf16x8 am0 = *(const bf16x8*)(AM + r * HSP + 16 * s4 + 8 * h);
          oa0 = MFMA32(am0, ifr, oa0);
        }
      }
#pragma unroll
      for (int ks = 0; ks < 8; ++ks) {
        const int kt4 = ks >> 1, hf = ks & 1;
        const float4 ea = *(const float4*)(emid + kt4 * 32 + 16 * hf + 4 * h);
        const float4 eb = *(const float4*)(emid + kt4 * 32 + 16 * hf + 8 + 4 * h);
        u32x4 pk;
        pk.x = pack2(S[kt4][8 * hf + 0] * ea.x, S[kt4][8 * hf + 1] * ea.y);
        pk.y = pack2(S[kt4][8 * hf + 2] * ea.z, S[kt4][8 * hf + 3] * ea.w);
        pk.z = pack2(S[kt4][8 * hf + 4] * eb.x, S[kt4][8 * hf + 5] * eb.y);
        pk.w = pack2(S[kt4][8 * hf + 6] * eb.z, S[kt4][8 * hf + 7] * eb.w);
        const bf16x8 sp = __builtin_bit_cast(bf16x8, pk);
        const bf16x8 qf0 = *(const bf16x8*)(QM + r * HQP + ks * 16 + 8 * h);
        const bf16x8 qf1 = *(const bf16x8*)(QM + (32 + r) * HQP + ks * 16 + 8 * h);
        oa0 = MFMA32(qf0, sp, oa0);
        oa1 = MFMA32(qf1, sp, oa1);
      }
      char* ogb = (char*)og + olane;
#pragma unroll
      for (int i = 0; i < 16; ++i) {
        const int ci = (i & 3) + 8 * (i >> 2);
        const size_t r0 = dir ? tb + 59 - ci : tb + ci;
        const size_t r1 = dir ? tb + 27 - ci : tb + 32 + ci;
        *(u16*)(ogb + r0 * 1024) = f2bf(oa0[i]);
        *(u16*)(ogb + r1 * 1024) = f2bf(oa1[i]);
      }
    }
#pragma unroll
    for (int kt4 = 0; kt4 < 4; ++kt4) {
#pragma unroll
      for (int g = 0; g < 4; ++g) {
        const float4 dd = *(const float4*)(dec + kt4 * 32 + 8 * g + 4 * h);
        S[kt4][4 * g + 0] *= dd.x; S[kt4][4 * g + 1] *= dd.y; S[kt4][4 * g + 2] *= dd.z; S[kt4][4 * g + 3] *= dd.w;
      }
    }
#pragma unroll
    for (int s4 = 0; s4 < 4; ++s4) {
      const bf16x8 ifr = *(const bf16x8*)(IT + (w * 32 + r) * HSP + 16 * s4 + 8 * h);
#pragma unroll
      for (int kt4 = 0; kt4 < 4; ++kt4) {
        const bf16x8 kf = *(const bf16x8*)(KUT + (kt4 * 32 + r) * HSP + 16 * s4 + 8 * h);
        S[kt4] = MFMA32(kf, ifr, S[kt4]);
      }
    }
    __syncthreads();
  }
#undef HG_LOAD
}

__global__ __launch_bounds__(256) void naive_attn(Params p) {
  const int gid = blockIdx.x * 256 + threadIdx.x;
  const int s = gid & 4095, bh = gid >> 12, head = bh & 7, bi = bh >> 3, kvh = head >> 2;
  float qv[64], acc[64];
  const u16* qp = p.q + ((size_t)(bi * 8 + head) * SEQ + s) * 64;
#pragma unroll
  for (int d = 0; d < 64; ++d) { qv[d] = bf2f(qp[d]); acc[d] = 0.f; }
  float mx = -INFINITY, l = 0.f;
  const u16* kp = p.k + (size_t)(bi * 2 + kvh) * SEQ * 64;
  const u16* vp = p.vT + (size_t)(bi * 2 + kvh) * 64 * SEQ;
  for (int key = 0; key < SEQ; ++key) {
    float sc = 0.f;
#pragma unroll
    for (int d = 0; d < 64; ++d) sc += qv[d] * bf2f(kp[(size_t)key * 64 + d]);
    const float mn = fmaxf(mx, sc);
    const float al = exp2f(mx - mn), pp = exp2f(sc - mn);
    l = l * al + pp;
#pragma unroll
    for (int d = 0; d < 64; ++d) acc[d] = acc[d] * al + pp * bf2f(vp[(size_t)d * SEQ + key]);
    mx = mn;
  }
  const float il = 1.f / l;
  u16* op = p.attn + ((size_t)bi * SEQ + s) * 512 + head * 64;
#pragma unroll
  for (int d = 0; d < 64; ++d) op[d] = f2bf(acc[d] * il);
}

__global__ __launch_bounds__(1024) void naive_hgrn(Params p) {
  __shared__ float red[8][128];
  const int dir = blockIdx.x & 1, hh = (blockIdx.x >> 1) & 3, bi = blockIdx.x >> 3;
  const int v = threadIdx.x & 127, kq = threadIdx.x >> 7;
  float S[16];
#pragma unroll
  for (int i = 0; i < 16; ++i) S[i] = 0.f;
  const u16* lf = dir ? p.lfb : p.lff;
  u16* o = dir ? p.ob : p.of;
  for (int step = 0; step < SEQ; ++step) {
    const int s = dir ? SEQ - 1 - step : step;
    const size_t base = ((size_t)bi * SEQ + s) * 512 + hh * 128;
    const float iv = bf2f(p.hi[base + v]);
    float part = 0.f;
#pragma unroll
    for (int kk = 0; kk < 16; ++kk) {
      const int k = kq * 16 + kk;
      const float lg = (float)__builtin_bit_cast(_Float16, lf[base + k]);
      const float f = exp2f(lg), g = 1.f - f;
      const float qk = bf2f(p.hq[base + k]);
      S[kk] = f * S[kk] + g * iv;
      part += S[kk] * qk;
    }
    red[kq][v] = part;
    __syncthreads();
    if (kq == 0) {
      float t = 0.f;
#pragma unroll
      for (int j = 0; j < 8; ++j) t += red[j][v];
      o[base + v] = f2bf(t);
    }
    __syncthreads();
  }
}

DI void unpack8(const uint4 u, float (&v)[8]) {
  v[0] = __uint_as_float(u.x << 16); v[1] = __uint_as_float(u.x & 0xffff0000u);
  v[2] = __uint_as_float(u.y << 16); v[3] = __uint_as_float(u.y & 0xffff0000u);
  v[4] = __uint_as_float(u.z << 16); v[5] = __uint_as_float(u.z & 0xffff0000u);
  v[6] = __uint_as_float(u.w << 16); v[7] = __uint_as_float(u.w & 0xffff0000u);
}
__device__ void phase_mix(const Params& p, int bid, int nblk) {
  const int lane = threadIdx.x & 63, w = threadIdx.x >> 6;
  u16* mix = p.mix;
  float wa[8], wh[8];
#pragma unroll
  for (int e = 0; e < 8; ++e) { wa[e] = p.attn_norm_w[lane * 8 + e]; wh[e] = p.hg_norm_w[(lane & 15) * 8 + e]; }
  const int stride = nblk * 4;
  for (int m0 = bid * 4 + w; m0 < MTOK; m0 += 4 * stride) {
    uint4 ua[4], ug[4], u1[4], u2[4], uh[4];
#pragma unroll
    for (int u = 0; u < 4; ++u) {
      const int m = m0 + u * stride;
      if (m < MTOK) {
        const size_t rb = (size_t)m * 512 + lane * 8;
        ua[u] = *(const uint4*)(p.attn + rb); ug[u] = *(const uint4*)(p.ga + rb);
        u1[u] = *(const uint4*)(p.of + rb); u2[u] = *(const uint4*)(p.ob + rb); uh[u] = *(const uint4*)(p.gh + rb);
      }
    }
#pragma unroll
    for (int u = 0; u < 4; ++u) {
      const int m = m0 + u * stride;
      if (m < MTOK) {
        float a[8], g[8], f1[8], f2[8];
        unpack8(ua[u], a); unpack8(ug[u], g);
        float ss = 0.f;
#pragma unroll
        for (int e = 0; e < 8; ++e) ss += a[e] * a[e];
#pragma unroll
        for (int o = 32; o >= 1; o >>= 1) ss += __shfl_xor(ss, o);
        float rstd = rsqrtf(ss * (1.f / 512.f) + 1e-6f);
        float r[8];
#pragma unroll
        for (int e = 0; e < 8; ++e) r[e] = a[e] * rstd * wa[e] * g[e];
        uint4 o1; o1.x = pack2(r[0], r[1]); o1.y = pack2(r[2], r[3]); o1.z = pack2(r[4], r[5]); o1.w = pack2(r[6], r[7]);
        *(uint4*)(mix + (size_t)m * 1024 + lane * 8) = o1;
        unpack8(u1[u], f1); unpack8(u2[u], f2); unpack8(uh[u], g);
        ss = 0.f;
#pragma unroll
        for (int e = 0; e < 8; ++e) { a[e] = f1[e] + f2[e]; ss += a[e] * a[e]; }
#pragma unroll
        for (int o = 8; o >= 1; o >>= 1) ss += __shfl_xor(ss, o);
        rstd = rsqrtf(ss * (1.f / 128.f) + 1e-6f);
#pragma unroll
        for (int e = 0; e < 8; ++e) r[e] = a[e] * rstd * wh[e] * g[e];
        o1.x = pack2(r[0], r[1]); o1.y = pack2(r[2], r[3]); o1.z = pack2(r[4], r[5]); o1.w = pack2(r[6], r[7]);
        *(uint4*)(mix + (size_t)m * 1024 + 512 + lane * 8) = o1;
      }
    }
  }
}

__device__ void phase3(const Params& p, char* smem, int bid, int nblk, const XMap xm) {
  const int lane = threadIdx.x & 63, w = threadIdx.x >> 6;
  const int wn = w & 1, wm = w >> 1;
  const int r0 = lane & 31, h0 = lane >> 5;
  const int ntiles = xm.xcc >= 0 ? 256 : (MTOK / 128) * 8;
  const int tstep = xm.xcc >= 0 ? xm.nloc : nblk;
  const int tend = ntiles * (1 + PROBE_P3);
  auto coords = [&](int tile0, int& mt, int& nt) {
    const int tile = tile0 >= ntiles ? tile0 - ntiles : tile0;
    if (xm.xcc >= 0) { const int c = tile >> 6, q = tile & 63; mt = xm.xcc * 32 + c * 8 + (q >> 3); nt = q & 7; }
    else { mt = tile >> 3; nt = tile & 7; }
  };
  int tile0 = xm.xcc >= 0 ? xm.rank : bid;
  while (tile0 < tend) {
    int mt_c, nt_c;
    coords(tile0, mt_c, nt_c);
    f32x16 acc[2][2];
    {
      u32x4 ra0[4], rb0[4], ra1[4], rb1[4];
      gemm_issue(p.woutT, p.mix, nt_c * 128, mt_c * 128, ra0, rb0, ra1, rb1);
      gemm_run(p.woutT, p.mix, nt_c * 128, mt_c * 128, smem, acc, ra0, rb0, ra1, rb1);
    }
    tile0 += tstep;
    {
    const int mt = mt_c, nt = nt_c;
    int r = r0, h = h0;
    asm volatile("" : "+v"(r), "+v"(h));
    float* T = (float*)smem;
#pragma unroll
    for (int b = 0; b < 2; ++b) {
      float* trow = T + (wm * 64 + b * 32 + r) * EPF + wn * 64 + 4 * h;
#pragma unroll
      for (int a = 0; a < 2; ++a)
#pragma unroll
        for (int g = 0; g < 4; ++g) {
          float4 o;
          o.x = acc[a][b][4 * g + 0]; o.y = acc[a][b][4 * g + 1]; o.z = acc[a][b][4 * g + 2]; o.w = acc[a][b][4 * g + 3];
          *(float4*)(trow + a * 32 + 8 * g) = o;
        }
    }
    __syncthreads();
    {
      const int tid = threadIdx.x;
      const int ch = tid & 31, rw = tid >> 5;
      const size_t gofs = (size_t)(mt * 128) * 1024 + nt * 128 + ch * 4;
#pragma unroll
      for (int j0 = 0; j0 < 16; j0 += 4) {
        float4 xv[4];
#pragma unroll
        for (int u = 0; u < 4; ++u) xv[u] = *(const float4*)(p.x + gofs + (size_t)((j0 + u) * 8 + rw) * 1024);
#pragma unroll
        for (int u = 0; u < 4; ++u) {
          const int row = (j0 + u) * 8 + rw;
          const float4 y = *(const float4*)(T + row * EPF + ch * 4);
          float4 o;
          o.x = DN_ALPHA * xv[u].x + y.x; o.y = DN_ALPHA * xv[u].y + y.y; o.z = DN_ALPHA * xv[u].z + y.z; o.w = DN_ALPHA * xv[u].w + y.w;
          *(float4*)(p.z + gofs + (size_t)row * 1024) = o;
        }
      }
    }
    }
  }
}

__device__ void phase4(const Params& p, int bid, int nblk) {
  const int lane = threadIdx.x & 63, w = threadIdx.x >> 6;
  const int stride = nblk * 4;
  for (int m0 = bid * 4 + w; m0 < MTOK; m0 += 4 * stride) {
    float4 v[4][4];
#pragma unroll
    for (int u = 0; u < 4; ++u) {
      const int m = m0 + u * stride;
      if (m < MTOK) {
        const float4* row = (const float4*)(p.z + (size_t)m * 1024);
#pragma unroll
        for (int j = 0; j < 4; ++j) v[u][j] = row[lane + 64 * j];
      }
    }
#pragma unroll
    for (int u = 0; u < 4; ++u) {
      const int m = m0 + u * stride;
      if (m < MTOK) {
        float4* row = (float4*)(p.out + (size_t)m * 1024);
        float s = 0.f;
#pragma unroll
        for (int j = 0; j < 4; ++j) s += v[u][j].x + v[u][j].y + v[u][j].z + v[u][j].w;
#pragma unroll
        for (int o = 32; o >= 1; o >>= 1) s += __shfl_xor(s, o);
        const float mu = s * (1.f / 1024.f);
        float q = 0.f;
#pragma unroll
        for (int j = 0; j < 4; ++j) {
          v[u][j].x -= mu; v[u][j].y -= mu; v[u][j].z -= mu; v[u][j].w -= mu;
          q += v[u][j].x * v[u][j].x + v[u][j].y * v[u][j].y + v[u][j].z * v[u][j].z + v[u][j].w * v[u][j].w;
        }
#pragma unroll
        for (int o = 32; o >= 1; o >>= 1) q += __shfl_xor(q, o);
        const float rstd = rsqrtf(q * (1.f / 1024.f) + 1e-5f);
#pragma unroll
        for (int j = 0; j < 4; ++j) {
          const float4 wv = ((const float4*)p.ln_w)[lane + 64 * j], bv = ((const float4*)p.ln_b)[lane + 64 * j];
          float4 o;
          o.x = v[u][j].x * rstd * wv.x + bv.x; o.y = v[u][j].y * rstd * wv.y + bv.y;
          o.z = v[u][j].z * rstd * wv.z + bv.z; o.w = v[u][j].w * rstd * wv.w + bv.w;
          row[lane + 64 * j] = o;
        }
      }
    }
  }
}


#define XB_TMO      128
#define XB_XCNT(j)  (256  + 64 * (j))
#define XB_XSUB(j)  (1280 + 64 * (j))
#define XB_XGEN(j)  (2304 + 64 * (j))
#define XB_TOP      3328
#define XB_TOPGEN   3392
#define XCD_BAR_WORDS 3456
#define XB_SPIN_CAP (1u << 18)
#define LAS __attribute__((address_space(3)))
DI unsigned xb_ld(unsigned* p) { return __hip_atomic_load(p, __ATOMIC_RELAXED, __HIP_MEMORY_SCOPE_AGENT); }
DI unsigned xb_add(unsigned* p, unsigned v) { return __hip_atomic_fetch_add(p, v, __ATOMIC_RELAXED, __HIP_MEMORY_SCOPE_AGENT); }
DI unsigned xb_xcc_id() { return (unsigned)__builtin_amdgcn_s_getreg((3 << 11) | 20) & 0xFu; }
#define XB_SPIN(cond, bar) do { unsigned _sp = 0; while (cond) { __builtin_amdgcn_s_sleep(1); \
    if ((++_sp & 255u) == 0u) { if (xb_ld(&(bar)[XB_TMO])) break; if (_sp > XB_SPIN_CAP) { atomicAdd(&(bar)[XB_TMO], 1u); break; } } } } while (0)
struct XcdBarrier { unsigned* bar; unsigned x; volatile LAS unsigned* st; };
DI XcdBarrier xcd_barrier_post(unsigned* bar, volatile LAS unsigned* st, unsigned& rank) {
  XcdBarrier b; b.bar = bar; b.x = xb_xcc_id(); b.st = st;
  rank = 0u;
  if (threadIdx.x == 0) rank = xb_add(&bar[XB_XCNT(b.x)], 1u);
  return b;
}
DI void xcd_barrier_complete(unsigned* bar, unsigned x, unsigned& nloc, unsigned& nx) {
  const unsigned G = gridDim.x * gridDim.y * gridDim.z;
  unsigned sum, cnt, mine, sp = 0u;
  for (;;) {
    sum = 0u; cnt = 0u; mine = 0u;
#pragma unroll
    for (unsigned j = 0; j < 16; ++j) { const unsigned c = xb_ld(&bar[XB_XCNT(j)]); sum += c; cnt += (c > 0u) ? 1u : 0u; mine = (j == x) ? c : mine; }
    if (sum == G) break;
    __builtin_amdgcn_s_sleep(1);
    if ((++sp & 255u) == 0u) { if (xb_ld(&bar[XB_TMO])) break; if (sp > XB_SPIN_CAP) { atomicAdd(&bar[XB_TMO], 1u); break; } }
  }
  nloc = mine > 0u ? mine : 1u; nx = cnt > 0u ? cnt : 1u;
}
DI void xcd_barrier(const XcdBarrier& b) {
  asm volatile("s_waitcnt vmcnt(0)" ::: "memory");
  __syncthreads();
  if (threadIdx.x == 0) {
    unsigned* bar = b.bar;
    __builtin_amdgcn_s_waitcnt(0);
    unsigned nloc = b.st[0], nx = b.st[1];
    if (nloc == 0u) { xcd_barrier_complete(bar, b.x, nloc, nx); b.st[0] = nloc; b.st[1] = nx; }
    const unsigned old = xb_add(&bar[XB_XSUB(b.x)], 1u);
    const unsigned gen = old / nloc;
    if (old + 1u == (gen + 1u) * nloc) {
      __builtin_amdgcn_fence(__ATOMIC_RELEASE, "agent");
      asm volatile("s_waitcnt vmcnt(0)" ::: "memory");
      const unsigned og = xb_add(&bar[XB_TOP], 1u);
      const unsigned tg = og / nx;
      if (og + 1u == (tg + 1u) * nx) xb_add(&bar[XB_TOPGEN], 1u);
      else XB_SPIN(xb_ld(&bar[XB_TOPGEN]) == tg, bar);
      __builtin_amdgcn_fence(__ATOMIC_ACQUIRE, "agent");
      xb_add(&bar[XB_XGEN(b.x)], 1u);
      asm volatile("s_waitcnt vmcnt(0)" ::: "memory");
    } else {
      XB_SPIN(xb_ld(&bar[XB_XGEN(b.x)]) == gen, bar);
      __builtin_amdgcn_fence(__ATOMIC_ACQUIRE, "agent");
      asm volatile("s_waitcnt vmcnt(0)" ::: "memory");
    }
  }
  __syncthreads();
}

constexpr int MEGA_LDS = HG_LDS > GEMM_LDS ? HG_LDS : GEMM_LDS;
__global__ void __launch_bounds__(256, 2) mega_kernel(Params p) {
  __shared__ __attribute__((aligned(16))) char smem[MEGA_LDS];
  __shared__ uint4 xb_words;
  __shared__ int s_item;
  __shared__ int s_xm[4];
  const int bid = blockIdx.x, nblk = gridDim.x;
  if (threadIdx.x == 0) xb_words = make_uint4(0u, 0u, 0u, 0u);
  __syncthreads();
  unsigned my_rank;
  XcdBarrier xb = xcd_barrier_post(p.bar, (volatile LAS unsigned*)&xb_words, my_rank);
  phase0(p, smem, bid, nblk);
#if PROBE_P0
  phase0(p, smem, bid, nblk);
#endif
  xcd_barrier(xb);
  if (threadIdx.x == 0) {
    unsigned sum = 0;
#pragma unroll
    for (int j = 0; j < 8; ++j) sum += xb_ld(&p.bar[XB_XCNT(j)]);
    const bool ok = sum == (unsigned)nblk && xb.x < 8u && xb_words.y == 8u;
    s_xm[0] = ok ? (int)xb.x : -1; s_xm[1] = (int)my_rank; s_xm[2] = (int)xb_words.x;
  }
  __syncthreads();
  XMap xm; xm.xcc = s_xm[0]; xm.rank = s_xm[1]; xm.nloc = s_xm[2];
  phase1(p, smem, bid, nblk, xm);
  xcd_barrier(xb);
  for (int it = bid; it < 64; it += nblk) hgrn_item(p, smem, it);
  for (;;) {
    __syncthreads();
    if (threadIdx.x == 0) s_item = atomicAdd(p.ctr, 1);
    __syncthreads();
    const int it = __builtin_amdgcn_readfirstlane(s_item);
    if (it >= 1024 + 2048) break;
    if (it < 1024) attn_item(p, smem, it);
    else { const int g = it - 1024, jj = g & 7; p1_tile(p, smem, g >> 3, jj < 4 ? 6 + jj : 22 + jj); }
  }
  xcd_barrier(xb);
  phase_mix(p, bid, nblk);
#if PROBE_MIX
  phase_mix(p, bid, nblk);
#endif
  xcd_barrier(xb);
  phase3(p, smem, bid, nblk, xm);
  xcd_barrier(xb);
  phase4(p, bid, nblk);
}

__global__ __launch_bounds__(256) void k_phase0(Params p) { __shared__ __attribute__((aligned(16))) char smem[64 * 65 * 4]; phase0(p, smem, blockIdx.x, gridDim.x); }
__global__ __launch_bounds__(256) void k_phase1(Params p) { __shared__ __attribute__((aligned(16))) char smem[GEMM_LDS]; XMap xm; xm.xcc = -1; xm.rank = 0; xm.nloc = 1; phase1(p, smem, blockIdx.x, gridDim.x, xm); }
__global__ __launch_bounds__(256) void k_attn(Params p) { __shared__ __attribute__((aligned(16))) char smem[GEMM_LDS]; for (int it = blockIdx.x; it < 3072; it += gridDim.x) { if (it < 1024) attn_item(p, smem, it); else { const int g = it - 1024, jj = g & 7; p1_tile(p, smem, g >> 3, jj < 4 ? 6 + jj : 22 + jj); } } }
__global__ __launch_bounds__(256) void k_hgrn(Params p) { __shared__ __attribute__((aligned(16))) char smem[HG_LDS]; for (int it = blockIdx.x; it < 64; it += gridDim.x) hgrn_item(p, smem, it); }
__global__ __launch_bounds__(256) void k_mix(Params p) { phase_mix(p, blockIdx.x, gridDim.x); }
__global__ __launch_bounds__(256) void k_phase3(Params p) { __shared__ __attribute__((aligned(16))) char smem[GEMM_LDS]; XMap xm; xm.xcc = -1; xm.rank = 0; xm.nloc = 1; phase3(p, smem, blockIdx.x, gridDim.x, xm); }
__global__ __launch_bounds__(256) void k_phase4(Params p) { phase4(p, blockIdx.x, gridDim.x); }

extern "C" void kernel_launch(void* const* d_in, const int* in_sizes, int n_in, void* d_out, int out_size, void* d_ws, size_t ws_size,
                              hipStream_t stream) {
  Params p{};
  p.x = (const float*)d_in[0]; p.w_in = (const float*)d_in[1]; p.q_norm_w = (const float*)d_in[2]; p.k_norm_w = (const float*)d_in[3];
  p.attn_norm_w = (const float*)d_in[4]; p.lb_logits = (const float*)d_in[5]; p.hg_norm_w = (const float*)d_in[6];
  p.w_out = (const float*)d_in[7]; p.ln_w = (const float*)d_in[8]; p.ln_b = (const float*)d_in[9];
  p.out = (float*)d_out;
  char* ws = (char*)d_ws;
  size_t off = 0;
  auto take = [&](size_t bytes) { char* r = ws + off; off += (bytes + 255) & ~(size_t)255; return r; };
  p.xb = (u16*)take((size_t)MTOK * 1024 * 2);
  p.winT = (u16*)take((size_t)INW * 1024 * 2);
  p.woutT = (u16*)take((size_t)1024 * 1024 * 2);
  p.rope = (float2*)take(1024 * 8);
  p.lbv = (float*)take(1024 * 4);
  p.q = (u16*)take((size_t)MTOK * 512 * 2);
  p.k = (u16*)take((size_t)MTOK * 128 * 2);
  p.vT = (u16*)take((size_t)MTOK * 128 * 2);
  p.ga = (u16*)take((size_t)MTOK * 512 * 2);
  p.hq = (u16*)take((size_t)MTOK * 512 * 2);
  p.hi = (u16*)take((size_t)MTOK * 512 * 2);
  p.lff = (u16*)take((size_t)MTOK * 512 * 4);
  p.lfb = (u16*)take((size_t)MTOK * 512 * 4);
  p.gh = (u16*)take((size_t)MTOK * 512 * 2);
  p.attn = (u16*)take((size_t)MTOK * 512 * 2);
  p.of = (u16*)take((size_t)MTOK * 512 * 2);
  p.ob = (u16*)take((size_t)MTOK * 512 * 2);
  p.ctr = (int*)take(256);
  p.bar = (unsigned*)take(XCD_BAR_WORDS * 4);
  p.mix = p.hq;
  p.z = (float*)p.lff;
  if (off > ws_size) { fprintf(stderr, "workspace too small: need %zu have %zu\n", off, ws_size); return; }
#if ONE_LAUNCH
  static int grid_blocks = 0;
  if (!grid_blocks) {
    int dev = 0, cus = 0, per_cu = 0;
    hipGetDevice(&dev);
    hipDeviceGetAttribute(&cus, hipDeviceAttributeMultiprocessorCount, dev);
    hipOccupancyMaxActiveBlocksPerMultiprocessor(&per_cu, mega_kernel, 256, 0);
    if (per_cu > 2) per_cu = 2;
    grid_blocks = cus * per_cu;
    if (grid_blocks < 64) fprintf(stderr, "grid too small: %d\n", grid_blocks);
  }
  hipMemsetAsync(p.ctr, 0, 256 + ((XCD_BAR_WORDS * 4 + 255) & ~255), stream);
  void* args[] = {&p};
  hipError_t e = hipLaunchCooperativeKernel((void*)mega_kernel, dim3(grid_blocks), dim3(256), args, 0, stream);
  if (e != hipSuccess) fprintf(stderr, "cooperative launch failed: %s (grid %d)\n", hipGetErrorString(e), grid_blocks);
#else
  k_phase0<<<1024, 256, 0, stream>>>(p);
  k_phase1<<<512, 256, 0, stream>>>(p);
  k_attn<<<2048, 256, 0, stream>>>(p);
  k_hgrn<<<64, 256, 0, stream>>>(p);
  k_mix<<<2048, 256, 0, stream>>>(p);
  k_phase3<<<512, 256, 0, stream>>>(p);
  k_phase4<<<2048, 256, 0, stream>>>(p);
#endif
}
```

```cpp
#include <hip/hip_runtime.h>
#include <hip/hip_cooperative_groups.h>
#include <stdint.h>
#include <stdio.h>

namespace cg = cooperative_groups;

#ifndef ONE_LAUNCH
#define ONE_LAUNCH 1
#endif
#ifndef PROBE_P0
#define PROBE_P0 0
#endif
#ifndef PROBE_MIX
#define PROBE_MIX 0
#endif
#ifndef PROBE_P1
#define PROBE_P1 0
#endif
#ifndef PROBE_HG
#define PROBE_HG 0
#endif
#ifndef PROBE_AT
#define PROBE_AT 0
#endif
#ifndef PROBE_P3
#define PROBE_P3 0
#endif

typedef __attribute__((ext_vector_type(8))) short bf16x8;
typedef __attribute__((ext_vector_type(4))) short s16x4;
typedef __attribute__((ext_vector_type(16))) float f32x16;
typedef unsigned short u16;
typedef __attribute__((ext_vector_type(4))) unsigned u32x4;
typedef __attribute__((ext_vector_type(2))) unsigned u32x2;

#define DI __device__ __forceinline__
#define MFMA32(a, b, c) __builtin_amdgcn_mfma_f32_32x32x16_bf16((a), (b), (c), 0, 0, 0)

constexpr int MTOK = 32768;
constexpr int SEQ = 4096;
constexpr int DM = 1024;
constexpr int INW = 3840;
constexpr float Q_PRESCALE = 0.125f * 1.4426950408889634f;
constexpr float HQ_SCALE = 0.08838834764831845f;
constexpr float DN_ALPHA = 1.189207115002721f;

struct Params {
  const float* x; const float* w_in; const float* q_norm_w; const float* k_norm_w;
  const float* attn_norm_w; const float* lb_logits; const float* hg_norm_w; const float* w_out;
  const float* ln_w; const float* ln_b;
  float* out;
  u16* xb;
  u16* winT;
  u16* woutT;
  float2* rope;
  float* lbv;
  u16* q;
  u16* k;
  u16* vT;
  u16* ga;
  u16* hq;
  u16* hi;
  u16* lff;
  u16* lfb;
  u16* gh;
  u16* attn;
  u16* of;
  u16* ob;
  int* ctr;
  unsigned* bar;
  u16* mix;
  float* z;
};

DI u16 f2bf(float x) { uint32_t u = __float_as_uint(x); u += 0x7fffu + ((u >> 16) & 1u); return (u16)(u >> 16); }
DI float bf2f(u16 v) { return __uint_as_float(((uint32_t)v) << 16); }
typedef __attribute__((ext_vector_type(2))) float f32x2_t;
typedef __attribute__((ext_vector_type(2))) __bf16 bf16x2_t;
DI uint32_t pack2(float a, float b) { f32x2_t v = {a, b}; bf16x2_t r = __builtin_convertvector(v, bf16x2_t); return __builtin_bit_cast(uint32_t, r); }
typedef __attribute__((ext_vector_type(2))) _Float16 f16x2_t;
DI uint32_t pack2h(float a, float b) { f16x2_t r = {(_Float16)a, (_Float16)b}; return __builtin_bit_cast(uint32_t, r); }
DI float h2f_lo(uint32_t u) { return (float)__builtin_bit_cast(f16x2_t, u)[0]; }
DI float h2f_hi(uint32_t u) { return (float)__builtin_bit_cast(f16x2_t, u)[1]; }
DI int crow(int i, int h) { return (i & 3) + 8 * (i >> 2) + 4 * h; }
DI float silu_f(float v) { return v * __builtin_amdgcn_rcpf(1.f + __expf(-v)); }

__device__ void phase0(const Params& p, char* smem, int bid, int nblk) {
  const int tid = threadIdx.x;
  {
    const size_t nvec = (size_t)MTOK * DM / 8;
    const size_t T = (size_t)nblk * 256;
    for (size_t i = (size_t)bid * 256 + tid; i < nvec; i += 4 * T) {
      float4 a[4], b[4];
#pragma unroll
      for (int u = 0; u < 4; ++u) {
        const size_t ii = i + u * T;
        if (ii < nvec) { a[u] = ((const float4*)p.x)[2 * ii]; b[u] = ((const float4*)p.x)[2 * ii + 1]; }
      }
#pragma unroll
      for (int u = 0; u < 4; ++u) {
        const size_t ii = i + u * T;
        if (ii < nvec) {
          uint4 o; o.x = pack2(a[u].x, a[u].y); o.y = pack2(a[u].z, a[u].w); o.z = pack2(b[u].x, b[u].y); o.w = pack2(b[u].z, b[u].w);
          ((uint4*)p.xb)[ii] = o;
        }
      }
    }
  }
  {
    float* t = (float*)smem;
    const int ntile_in = 16 * 60, ntile_all = ntile_in + 16 * 16;
    for (int tile = bid; tile < ntile_all; tile += nblk) {
      const float* src; u16* dst; int N, kt, nt;
      if (tile < ntile_in) { src = p.w_in; dst = p.winT; N = INW; kt = tile / 60; nt = tile % 60; }
      else { int tt = tile - ntile_in; src = p.w_out; dst = p.woutT; N = DM; kt = tt / 16; nt = tt % 16; }
      __syncthreads();
#pragma unroll
      for (int j = 0; j < 4; ++j) {
        const int kk = (tid >> 4) + 16 * j, nn = (tid & 15) * 4;
        const float4 v = *(const float4*)(src + (size_t)(kt * 64 + kk) * N + nt * 64 + nn);
        t[kk * 65 + nn] = v.x; t[kk * 65 + nn + 1] = v.y; t[kk * 65 + nn + 2] = v.z; t[kk * 65 + nn + 3] = v.w;
      }
      __syncthreads();
      const int n = tid >> 2, kc = (tid & 3) * 16;
      uint32_t o[8];
#pragma unroll
      for (int j = 0; j < 8; ++j) o[j] = pack2(t[(kc + 2 * j) * 65 + n], t[(kc + 2 * j + 1) * 65 + n]);
      uint4* d = (uint4*)(dst + (size_t)(nt * 64 + n) * 1024 + kt * 64 + kc);
      d[0] = make_uint4(o[0], o[1], o[2], o[3]);
      d[1] = make_uint4(o[4], o[5], o[6], o[7]);
    }
  }
  for (int i = bid * 256 + tid; i < 2048; i += nblk * 256) {
    if (i < 1024) {
      const int pos = i >> 4, j = i & 15;
      const float inv = powf(10000.f, -(float)(2 * j) / 32.f);
      const float ang = (float)pos * inv;
      p.rope[i] = make_float2(cosf(ang), sinf(ang));
    } else {
      const int ii = i - 1024, dir = ii >> 9, wcol = ii & 511;
      const float l0 = p.lb_logits[(dir * 2 + 0) * 512 + wcol], l1 = p.lb_logits[(dir * 2 + 1) * 512 + wcol];
      const float mx = fmaxf(l0, l1);
      const float e0 = expf(l0 - mx), e1 = expf(l1 - mx);
      p.lbv[ii] = e0 / (e0 + e1);
    }
  }
}

constexpr int GP = 72;
constexpr int EP = 136;
constexpr int EPF = 132;
constexpr int GEMM_LDS = 2 * 2 * 128 * GP * 2;

DI void gemm_issue(const u16* __restrict__ A, const u16* __restrict__ B, int n0, int m0,
                   u32x4 (&ra0)[4], u32x4 (&rb0)[4], u32x4 (&ra1)[4], u32x4 (&rb1)[4]) {
  const int tid = threadIdx.x;
  const int lc = tid & 7, lr = tid >> 3;
  const u16* gA = A + (size_t)(n0 + lr) * 1024 + lc * 8;
  const u16* gB = B + (size_t)(m0 + lr) * 1024 + lc * 8;
#pragma unroll
  for (int j = 0; j < 4; ++j) { ra0[j] = *(const u32x4*)(gA + (size_t)j * 32 * 1024); rb0[j] = *(const u32x4*)(gB + (size_t)j * 32 * 1024); }
#pragma unroll
  for (int j = 0; j < 4; ++j) { ra1[j] = *(const u32x4*)(gA + (size_t)j * 32 * 1024 + 64); rb1[j] = *(const u32x4*)(gB + (size_t)j * 32 * 1024 + 64); }
}
DI void gemm_run(const u16* __restrict__ A, const u16* __restrict__ B, int n0, int m0, char* smem, f32x16 (&acc)[2][2],
                 u32x4 (&ra0)[4], u32x4 (&rb0)[4], u32x4 (&ra1)[4], u32x4 (&rb1)[4]) {
  const int tid = threadIdx.x, lane = tid & 63, w = __builtin_amdgcn_readfirstlane(tid >> 6);
  const int wn = w & 1, wm = w >> 1;
  const int lc = tid & 7, lr = tid >> 3;
  u16* sm = (u16*)smem;
  const u16* gA = A + (size_t)(n0 + lr) * 1024 + lc * 8;
  const u16* gB = B + (size_t)(m0 + lr) * 1024 + lc * 8;
#pragma unroll
  for (int a = 0; a < 2; ++a)
#pragma unroll
    for (int b = 0; b < 2; ++b)
#pragma unroll
      for (int i = 0; i < 16; ++i) acc[a][b][i] = 0.f;
  u32x4 ra2[4], rb2[4];
#define GEMM_LOAD(RA, RB, KT) _Pragma("unroll") for (int j = 0; j < 4; ++j) { \
    RA[j] = *(const u32x4*)(gA + (size_t)j * 32 * 1024 + (KT) * 64); RB[j] = *(const u32x4*)(gB + (size_t)j * 32 * 1024 + (KT) * 64); }
#define GEMM_STORE(RA, RB, ST) _Pragma("unroll") for (int j = 0; j < 4; ++j) { \
    *(u32x4*)(sm + (((ST) * 2 + 0) * 128 + lr + 32 * j) * GP + lc * 8) = RA[j]; *(u32x4*)(sm + (((ST) * 2 + 1) * 128 + lr + 32 * j) * GP + lc * 8) = RB[j]; }
  GEMM_LOAD(ra2, rb2, 2)
  __syncthreads();
  GEMM_STORE(ra0, rb0, 0)
  __syncthreads();
  const int fr = lane & 31, fh = lane >> 5;
  const u16* fa = sm + (wn * 64 + fr) * GP + fh * 8;
  const u16* fb = sm + (128 + wm * 64 + fr) * GP + fh * 8;
#define GEMM_COMPUTE(ST)                                                                          \
  _Pragma("unroll") for (int ks = 0; ks < 4; ++ks) {                                              \
    bf16x8 af[2], bfr[2];                                                                         \
    _Pragma("unroll") for (int a = 0; a < 2; ++a) af[a] = *(const bf16x8*)(fa + ((ST) * 256 + a * 32) * GP + ks * 16);   \
    _Pragma("unroll") for (int b = 0; b < 2; ++b) bfr[b] = *(const bf16x8*)(fb + ((ST) * 256 + b * 32) * GP + ks * 16);  \
    _Pragma("unroll") for (int a = 0; a < 2; ++a)                                                 \
      _Pragma("unroll") for (int b = 0; b < 2; ++b) acc[a][b] = MFMA32(af[a], bfr[b], acc[a][b]); \
  }
#define GEMM_SUB(K, RAL, RBL, RAW, RBW)                                   \
  {                                                                       \
    if ((K) + 3 < 16) { GEMM_LOAD(RAL, RBL, (K) + 3) }                    \
    GEMM_COMPUTE((K) & 1)                                                 \
    if ((K) + 1 < 16) { GEMM_STORE(RAW, RBW, ((K) + 1) & 1) }             \
    __syncthreads();                                                      \
  }
  GEMM_SUB(0, ra0, rb0, ra1, rb1)
  GEMM_SUB(1, ra1, rb1, ra2, rb2)
  GEMM_SUB(2, ra2, rb2, ra0, rb0)
  GEMM_SUB(3, ra0, rb0, ra1, rb1)
  GEMM_SUB(4, ra1, rb1, ra2, rb2)
  GEMM_SUB(5, ra2, rb2, ra0, rb0)
  GEMM_SUB(6, ra0, rb0, ra1, rb1)
  GEMM_SUB(7, ra1, rb1, ra2, rb2)
  GEMM_SUB(8, ra2, rb2, ra0, rb0)
  GEMM_SUB(9, ra0, rb0, ra1, rb1)
  GEMM_SUB(10, ra1, rb1, ra2, rb2)
  GEMM_SUB(11, ra2, rb2, ra0, rb0)
  GEMM_SUB(12, ra0, rb0, ra1, rb1)
  GEMM_SUB(13, ra1, rb1, ra2, rb2)
  GEMM_SUB(14, ra2, rb2, ra0, rb0)
  GEMM_SUB(15, ra0, rb0, ra1, rb1)
#undef GEMM_SUB
#undef GEMM_COMPUTE
#undef GEMM_LOAD
#undef GEMM_STORE
}

struct XMap { int xcc, rank, nloc; };
__device__ __forceinline__ void p1_tile(const Params& p, char* smem, const int mt, const int nt) {
  const int lane = threadIdx.x & 63, w = threadIdx.x >> 6;
  const int wn = w & 1, wm = w >> 1;
  const int r0 = lane & 31, h0 = lane >> 5;
    f32x16 acc[2][2];
    {
      u32x4 ra0[4], rb0[4], ra1[4], rb1[4];
      gemm_issue(p.winT, p.xb, nt * 128, mt * 128, ra0, rb0, ra1, rb1);
      gemm_run(p.winT, p.xb, nt * 128, mt * 128, smem, acc, ra0, rb0, ra1, rb1);
    }
    {
    int r = r0, h = h0;
    asm volatile("" : "+v"(r), "+v"(h));
    u16* T = (u16*)smem;
    const int mbase = mt * 128 + wm * 64;
    if (nt <= 4) {
      const bool isq = nt < 4;
      const float* nw = isq ? p.q_norm_w : p.k_norm_w;
      const float sc = isq ? Q_PRESCALE : 1.0f;
#pragma unroll
      for (int b = 0; b < 2; ++b) {
        const int m = mbase + b * 32 + r;
        const int s = m & 4095;
        const int rp = s >> 6, cp = s & 63;
        float ss = 0.f;
#pragma unroll
        for (int a = 0; a < 2; ++a)
#pragma unroll
          for (int i = 0; i < 16; ++i) ss += acc[a][b][i] * acc[a][b][i];
        ss += __shfl_xor(ss, 32);
        const float rstd = rsqrtf(ss * (1.f / 64.f) + 1e-6f);
        u16* trow = T + (wm * 64 + b * 32 + r) * EP + wn * 64 + 4 * h;
#pragma unroll
        for (int a = 0; a < 2; ++a) {
          const int pos = a == 0 ? rp : cp;
          float y[16], o[16];
#pragma unroll
          for (int i = 0; i < 16; ++i) y[i] = acc[a][b][i] * rstd * nw[a * 32 + crow(i, h)];
#pragma unroll
          for (int i = 0; i < 8; ++i) {
            const float2 cs = p.rope[pos * 16 + crow(i, h)];
            o[i] = (y[i] * cs.x - y[i + 8] * cs.y) * sc;
            o[i + 8] = (y[i + 8] * cs.x + y[i] * cs.y) * sc;
          }
#pragma unroll
          for (int g = 0; g < 4; ++g) {
            u32x2 v; v.x = pack2(o[4 * g], o[4 * g + 1]); v.y = pack2(o[4 * g + 2], o[4 * g + 3]);
            *(u32x2*)(trow + a * 32 + 8 * g) = v;
          }
        }
      }
    } else if (nt == 5) {
#pragma unroll
      for (int b = 0; b < 2; ++b)
#pragma unroll
        for (int a = 0; a < 2; ++a)
#pragma unroll
          for (int i = 0; i < 16; ++i) T[(wn * 64 + a * 32 + crow(i, h)) * EP + wm * 64 + b * 32 + r] = f2bf(acc[a][b][i]);
    } else {
      const int gi = (nt - 6) >> 2;
      const int cb = ((nt - 6) & 3) * 128 + wn * 64;
#pragma unroll
      for (int b = 0; b < 2; ++b) {
        u16* trow = T + (wm * 64 + b * 32 + r) * EP + wn * 64 + 4 * h;
#pragma unroll
        for (int a = 0; a < 2; ++a)
#pragma unroll
          for (int g = 0; g < 4; ++g) {
            float v[4];
#pragma unroll
            for (int e = 0; e < 4; ++e) v[e] = acc[a][b][4 * g + e];
            u32x2 o;
            if (gi == 3 || gi == 4) {
              const float4 lb = *(const float4*)(p.lbv + (gi - 3) * 512 + cb + a * 32 + 8 * g + 4 * h);
              const float ox = __builtin_amdgcn_logf(lb.x + (1.f - lb.x) * __builtin_amdgcn_rcpf(1.f + __expf(-v[0])));
              const float oy = __builtin_amdgcn_logf(lb.y + (1.f - lb.y) * __builtin_amdgcn_rcpf(1.f + __expf(-v[1])));
              const float oz = __builtin_amdgcn_logf(lb.z + (1.f - lb.z) * __builtin_amdgcn_rcpf(1.f + __expf(-v[2])));
              const float ow = __builtin_amdgcn_logf(lb.w + (1.f - lb.w) * __builtin_amdgcn_rcpf(1.f + __expf(-v[3])));
              o.x = pack2h(ox, oy); o.y = pack2h(oz, ow);
            } else {
              if (gi == 0 || gi == 5) {
#pragma unroll
                for (int e = 0; e < 4; ++e) v[e] = silu_f(v[e]);
              } else if (gi == 1) {
#pragma unroll
                for (int e = 0; e < 4; ++e) v[e] = silu_f(v[e]) * HQ_SCALE;
              }
              o.x = pack2(v[0], v[1]); o.y = pack2(v[2], v[3]);
            }
            *(u32x2*)(trow + a * 32 + 8 * g) = o;
          }
      }
    }
    __syncthreads();
    {
      const int tid = threadIdx.x;
      const int ch = tid & 15, rw = tid >> 4;
      const int bi = (mt * 128) >> 12, s0 = (mt * 128) & 4095;
      u16* dbase; size_t rstride;
      if (nt < 4)       { dbase = p.q + ((size_t)(bi * 8 + nt * 2 + (ch >> 3)) * SEQ + s0) * 64 + (ch & 7) * 8; rstride = 64; }
      else if (nt == 4) { dbase = p.k + ((size_t)(bi * 2 + (ch >> 3)) * SEQ + s0) * 64 + (ch & 7) * 8; rstride = 64; }
      else if (nt == 5) { dbase = p.vT + (size_t)(bi * 2) * 64 * SEQ + s0 + ch * 8; rstride = SEQ; }
      else {
        const int gi = (nt - 6) >> 2;
        u16* gb = gi == 0 ? p.ga : gi == 1 ? p.hq : gi == 2 ? p.hi : gi == 3 ? p.lff : gi == 4 ? p.lfb : p.gh;
        dbase = gb + (size_t)(mt * 128) * 512 + ((nt - 6) & 3) * 128 + ch * 8; rstride = 512;
      }
#pragma unroll
      for (int j = 0; j < 8; ++j) {
        const int row = j * 16 + rw;
        const u32x4 v = *(const u32x4*)(T + row * EP + ch * 8);
        *(u32x4*)(dbase + (size_t)row * rstride) = v;
      }
    }
    }
}

__device__ void phase1(const Params& p, char* smem, int bid, int nblk, const XMap xm) {
  const int ntiles = xm.xcc >= 0 ? 704 : (MTOK / 128) * 22;
  const int tstep = xm.xcc >= 0 ? xm.nloc : nblk;
  __shared__ int s_tile;
  int tile = xm.xcc >= 0 ? xm.rank : bid;
  for (;;) {
    if (tile >= ntiles) break;
    int mt, j;
    if (xm.xcc >= 0) {
      int ml;
      if (tile < 512) { const int g = tile >> 8, rem = tile & 255, c = rem >> 6, q = rem & 63; ml = c * 8 + (q >> 3); j = g * 8 + (q & 7); }
      else { const int t2 = tile - 512, c = t2 / 48, q = t2 % 48; ml = c * 8 + q / 6; j = 16 + q % 6; }
      mt = xm.xcc * 32 + ml;
    } else { mt = tile / 22; j = tile % 22; }
    const int nt = j < 6 ? j : j + 4;
    p1_tile(p, smem, mt, nt);
    if (xm.xcc >= 0) {
      __syncthreads();
      if (threadIdx.x == 0) s_tile = xm.nloc + atomicAdd(p.ctr + 48 + xm.xcc, 1);
      __syncthreads();
      tile = __builtin_amdgcn_readfirstlane(s_tile);
    } else tile += tstep;
  }
}

constexpr int AP = 72;
constexpr int ATT_LDS = 2 * 2 * 64 * AP * 2;
DI float fast_exp2(float x) { return __builtin_amdgcn_exp2f(x); }

__device__ void attn_item(const Params& p, char* smem, int item) {
  const int tid = threadIdx.x, lane = tid & 63, w = __builtin_amdgcn_readfirstlane(tid >> 6), r = lane & 31, h = lane >> 5;
  const int qb = item & 31, pair = (item >> 5) & 3, bi = item >> 7;
  const int kvh = pair >> 1;
  const int q0 = qb * 128 + w * 32;
  u16* sm = (u16*)smem;
  bf16x8 qf[2][4];
#pragma unroll
  for (int hd = 0; hd < 2; ++hd) {
    const u16* qp = p.q + ((size_t)(bi * 8 + pair * 2 + hd) * SEQ + q0 + r) * 64 + h * 8;
#pragma unroll
    for (int ks = 0; ks < 4; ++ks) qf[hd][ks] = *(const bf16x8*)(qp + ks * 16);
  }
  const int lc = tid & 7, lr = tid >> 3;
  const u16* kg = p.k + (size_t)(bi * 2 + kvh) * SEQ * 64 + (size_t)lr * 64 + lc * 8;
  const u16* vg = p.vT + (size_t)(bi * 2 + kvh) * 64 * SEQ + (size_t)lr * SEQ + lc * 8;
  const int kw = lr * AP + lc * 8;
  const int vw = lr * AP + (lc >> 1) * 16 + (lc & 1) * 4;
  u32x4 rk[2], rv[2];
#pragma unroll
  for (int j = 0; j < 2; ++j) { rk[j] = *(const u32x4*)(kg + (size_t)j * 32 * 64); rv[j] = *(const u32x4*)(vg + (size_t)j * 32 * SEQ); }
  __syncthreads();
#pragma unroll
  for (int j = 0; j < 2; ++j) {
    *(u32x4*)(sm + kw + j * 32 * AP) = rk[j];
    u16* vd = sm + 64 * AP + vw + j * 32 * AP;
    *(u32x2*)(vd) = rv[j].xy; *(u32x2*)(vd + 8) = rv[j].zw;
  }
  __syncthreads();
  f32x16 o[2][2];
#pragma unroll
  for (int hd = 0; hd < 2; ++hd)
#pragma unroll
    for (int dt = 0; dt < 2; ++dt)
#pragma unroll
      for (int i = 0; i < 16; ++i) o[hd][dt][i] = 0.f;
  float mrun[2] = {-INFINITY, -INFINITY}, lsum[2] = {0.f, 0.f};
  for (int t = 0; t < 64; ++t) {
    const int st = t & 1;
    if (t + 1 < 64) {
#pragma unroll
      for (int j = 0; j < 2; ++j) {
        rk[j] = *(const u32x4*)(kg + (size_t)((t + 1) * 64 + j * 32) * 64);
        rv[j] = *(const u32x4*)(vg + (size_t)j * 32 * SEQ + (t + 1) * 64);
      }
    }
    const u16* sK = sm + (st * 2 + 0) * 64 * AP;
    const u16* sV = sm + (st * 2 + 1) * 64 * AP;
    f32x16 sc[2][2];
#pragma unroll
    for (int kt2 = 0; kt2 < 2; ++kt2) {
#pragma unroll
      for (int hd = 0; hd < 2; ++hd)
#pragma unroll
        for (int i = 0; i < 16; ++i) sc[hd][kt2][i] = 0.f;
#pragma unroll
      for (int ks = 0; ks < 4; ++ks) {
        const bf16x8 kf = *(const bf16x8*)(sK + (kt2 * 32 + r) * AP + ks * 16 + h * 8);
        sc[0][kt2] = MFMA32(kf, qf[0][ks], sc[0][kt2]);
        sc[1][kt2] = MFMA32(kf, qf[1][ks], sc[1][kt2]);
      }
    }
#pragma unroll
    for (int hd = 0; hd < 2; ++hd) {
      float mx = sc[hd][0][0];
#pragma unroll
      for (int i = 1; i < 16; ++i) mx = fmaxf(mx, sc[hd][0][i]);
#pragma unroll
      for (int i = 0; i < 16; ++i) mx = fmaxf(mx, sc[hd][1][i]);
      mx = fmaxf(mx, __shfl_xor(mx, 32));
      if (__any(mx > mrun[hd])) {
        const float mn = fmaxf(mrun[hd], mx);
        const float al = fast_exp2(mrun[hd] - mn);
        lsum[hd] *= al;
#pragma unroll
        for (int dt = 0; dt < 2; ++dt)
#pragma unroll
          for (int i = 0; i < 16; ++i) o[hd][dt][i] *= al;
        mrun[hd] = mn;
      }
#pragma unroll
      for (int kt2 = 0; kt2 < 2; ++kt2)
#pragma unroll
        for (int i = 0; i < 16; ++i) { const float e = fast_exp2(sc[hd][kt2][i] - mrun[hd]); sc[hd][kt2][i] = e; lsum[hd] += e; }
    }
#pragma unroll
    for (int s2 = 0; s2 < 4; ++s2) {
      bf16x8 pf[2];
#pragma unroll
      for (int hd = 0; hd < 2; ++hd) {
        u32x4 pk;
        pk.x = pack2(sc[hd][s2 >> 1][8 * (s2 & 1) + 0], sc[hd][s2 >> 1][8 * (s2 & 1) + 1]);
        pk.y = pack2(sc[hd][s2 >> 1][8 * (s2 & 1) + 2], sc[hd][s2 >> 1][8 * (s2 & 1) + 3]);
        pk.z = pack2(sc[hd][s2 >> 1][8 * (s2 & 1) + 4], sc[hd][s2 >> 1][8 * (s2 & 1) + 5]);
        pk.w = pack2(sc[hd][s2 >> 1][8 * (s2 & 1) + 6], sc[hd][s2 >> 1][8 * (s2 & 1) + 7]);
        pf[hd] = __builtin_bit_cast(bf16x8, pk);
      }
#pragma unroll
      for (int dt = 0; dt < 2; ++dt) {
        const bf16x8 vf = *(const bf16x8*)(sV + (dt * 32 + r) * AP + s2 * 16 + h * 8);
        o[0][dt] = MFMA32(vf, pf[0], o[0][dt]);
        o[1][dt] = MFMA32(vf, pf[1], o[1][dt]);
      }
    }
    if (t + 1 < 64) {
      const int ns = st ^ 1;
#pragma unroll
      for (int j = 0; j < 2; ++j) {
        *(u32x4*)(sm + (ns * 2 + 0) * 64 * AP + kw + j * 32 * AP) = rk[j];
        u16* vd = sm + (ns * 2 + 1) * 64 * AP + vw + j * 32 * AP;
        *(u32x2*)(vd) = rv[j].xy; *(u32x2*)(vd + 8) = rv[j].zw;
      }
    }
    __syncthreads();
  }
#pragma unroll
  for (int hd = 0; hd < 2; ++hd) {
    const float l = lsum[hd] + __shfl_xor(lsum[hd], 32);
    const float il = 1.f / l;
    u16* op = p.attn + ((size_t)bi * SEQ + q0 + r) * 512 + (pair * 2 + hd) * 64 + 4 * h;
#pragma unroll
    for (int dt = 0; dt < 2; ++dt)
#pragma unroll
      for (int g = 0; g < 4; ++g) {
        u32x2 v; v.x = pack2(o[hd][dt][4 * g] * il, o[hd][dt][4 * g + 1] * il); v.y = pack2(o[hd][dt][4 * g + 2] * il, o[hd][dt][4 * g + 3] * il);
        *(u32x2*)(op + dt * 32 + 8 * g) = v;
      }
  }
}

constexpr int HQP = 136;
constexpr int HSP = 72;
constexpr int H_QM = 0;
constexpr int H_KM = H_QM + 64 * HQP * 2;
constexpr int H_KUT = H_KM + 64 * HQP * 2;
constexpr int H_IT = H_KUT + 128 * HSP * 2;
constexpr int H_F32 = H_IT + 128 * HSP * 2;
constexpr int HG_LDS = H_F32 + 7 * 128 * 4;

__device__ void hgrn_item(const Params& p, char* smem, int item) {
  const int tid = threadIdx.x, lane = tid & 63, w = __builtin_amdgcn_readfirstlane(tid >> 6), r = lane & 31, h = lane >> 5;
  const int dir = item & 1, hh = (item >> 1) & 3, bi = item >> 3;
  u16* QM = (u16*)(smem + H_QM);
  u16* KM = (u16*)(smem + H_KM);
  u16* AM = (u16*)(smem + H_KM);
  u16* KUT = (u16*)(smem + H_KUT);
  u16* IT = (u16*)(smem + H_IT);
  float* tot = (float*)(smem + H_F32);
  float* first2 = tot + 512;
  float* emid = tot + 640;
  float* dec = tot + 768;
  const u16* lf = dir ? p.lfb : p.lff;
  u16* og = dir ? p.ob : p.of;
  const int kp = lane;
  const int k16 = (2 * kp) & 15, grp = k16 >> 2;
  const int pk0 = ((2 * kp) & ~15) | ((grp == 1 ? 2 : grp == 2 ? 1 : grp) << 2) | ((2 * kp) & 3);
  const int tp = tid & 31, vc = (tid >> 5) * 16;
  f32x16 S[4];
#pragma unroll
  for (int a = 0; a < 4; ++a)
#pragma unroll
    for (int i = 0; i < 16; ++i) S[a][i] = 0.f;
  const size_t colb = (size_t)hh * 128;
  const unsigned olane = (unsigned)((dir ? 4 - 4 * h : 4 * h) * 1024 + (hh * 128 + w * 32 + r) * 2);
  uint32_t lgv[16], qv[16];
#define HG_LOAD(C)                                                                                   \
  {                                                                                                  \
    const int s0_ = dir ? SEQ - 64 * ((C) + 1) : 64 * (C);                                           \
    const size_t tb_ = (size_t)bi * SEQ + s0_;                                                       \
    _Pragma("unroll") for (int e = 0; e < 16; ++e) {                                                 \
      const int tau = 16 * w + e;                                                                    \
      const size_t tok = tb_ + (dir ? 63 - tau : tau);                                               \
      lgv[e] = *(const uint32_t*)((const char*)(lf + tok * 512 + colb) + (unsigned)(kp * 4));        \
      qv[e] = *(const uint32_t*)((const char*)(p.hq + tok * 512 + colb) + (unsigned)(kp * 4));       \
    }                                                                                                \
  }
  HG_LOAD(0)
  __syncthreads();
  for (int c0 = 0; c0 < 64 * (1 + PROBE_HG); ++c0) {
    const int c = c0 & 63;
#if PROBE_HG
    if (c0 == 64) {
#pragma unroll
      for (int a = 0; a < 4; ++a)
#pragma unroll
        for (int i = 0; i < 16; ++i) S[a][i] = 0.f;
    }
#endif
    const int s0 = dir ? SEQ - 64 * (c + 1) : 64 * c;
    const size_t tb = (size_t)bi * SEQ + s0;
    const size_t tok0 = tb + (dir ? 63 - 2 * tp : 2 * tp), tok1 = tb + (dir ? 62 - 2 * tp : 2 * tp + 1);
    const u32x4 ia0 = *(const u32x4*)(p.hi + tok0 * 512 + colb + vc), ia1 = *(const u32x4*)(p.hi + tok0 * 512 + colb + vc + 8);
    const u32x4 ib0 = *(const u32x4*)(p.hi + tok1 * 512 + colb + vc), ib1 = *(const u32x4*)(p.hi + tok1 * 512 + colb + vc + 8);
    {
      float2 run = make_float2(0.f, 0.f);
#pragma unroll
      for (int e = 0; e < 16; ++e) { run.x += h2f_lo(lgv[e]); run.y += h2f_hi(lgv[e]); }
      *(float2*)(tot + w * 128 + 2 * kp) = run;
      if (w == 2) *(float2*)(first2 + 2 * kp) = make_float2(h2f_lo(lgv[0]), h2f_hi(lgv[0]));
    }
    __syncthreads();
    {
      const float2 t0 = *(const float2*)(tot + 2 * kp), t1 = *(const float2*)(tot + 128 + 2 * kp);
      const float2 t2 = *(const float2*)(tot + 256 + 2 * kp), t3 = *(const float2*)(tot + 384 + 2 * kp);
      const float2 f2 = *(const float2*)(first2 + 2 * kp);
      float2 pre = make_float2(0.f, 0.f);
      if (w > 0) { pre.x += t0.x; pre.y += t0.y; }
      if (w > 1) { pre.x += t1.x; pre.y += t1.y; }
      if (w > 2) { pre.x += t2.x; pre.y += t2.y; }
      const float2 bmid = make_float2(t0.x + t1.x + f2.x, t0.y + t1.y + f2.y);
      const float2 blast = make_float2(t0.x + t1.x + t2.x + t3.x, t0.y + t1.y + t2.y + t3.y);
      const float ccx = fast_exp2(blast.x - bmid.x), ccy = fast_exp2(blast.y - bmid.y);
      uint32_t kux[8], kuy[8];
      float pkx = 0.f, pky = 0.f;
      float2 run = make_float2(pre.x - bmid.x, pre.y - bmid.y);
#pragma unroll
      for (int e = 0; e < 16; ++e) {
        const float lgx = h2f_lo(lgv[e]), lgy = h2f_hi(lgv[e]);
        run.x += lgx; run.y += lgy;
        const float rx = run.x, ry = run.y;
        const float e1x = fast_exp2(rx), e1y = fast_exp2(ry), e2x = fast_exp2(-rx), e2y = fast_exp2(-ry);
        const float gx = 1.f - fast_exp2(lgx), gy = 1.f - fast_exp2(lgy);
        const float qx = __uint_as_float(qv[e] << 16), qy = __uint_as_float(qv[e] & 0xffff0000u);
        const float kmx = gx * e2x, kmy = gy * e2y;
        const int t = 16 * w + e;
        *(uint32_t*)(QM + t * HQP + pk0) = pack2(qx * e1x, qy * e1y);
        *(uint32_t*)(KM + t * HQP + pk0) = pack2(kmx, kmy);
        if (e & 1) { kux[e >> 1] = pack2(pkx, kmx * ccx); kuy[e >> 1] = pack2(pky, kmy * ccy); }
        else { pkx = kmx * ccx; pky = kmy * ccy; }
      }
      u32x4* d0 = (u32x4*)(KUT + (2 * kp) * HSP + 16 * w);
      u32x4* d1 = (u32x4*)(KUT + (2 * kp + 1) * HSP + 16 * w);
      u32x4 v;
      v.x = kux[0]; v.y = kux[1]; v.z = kux[2]; v.w = kux[3]; d0[0] = v;
      v.x = kux[4]; v.y = kux[5]; v.z = kux[6]; v.w = kux[7]; d0[1] = v;
      v.x = kuy[0]; v.y = kuy[1]; v.z = kuy[2]; v.w = kuy[3]; d1[0] = v;
      v.x = kuy[4]; v.y = kuy[5]; v.z = kuy[6]; v.w = kuy[7]; d1[1] = v;
      if (w == 0) {
        *(float2*)(emid + 2 * kp) = make_float2(fast_exp2(bmid.x), fast_exp2(bmid.y));
        *(float2*)(dec + 2 * kp) = make_float2(fast_exp2(blast.x), fast_exp2(blast.y));
      }
    }
    {
      uint32_t* d = (uint32_t*)(IT + vc * HSP + 2 * tp);
#pragma unroll
      for (int j = 0; j < 4; ++j) {
        d[(2 * j) * (HSP / 2)] = (ia0[j] & 0xffffu) | (ib0[j] << 16);
        d[(2 * j + 1) * (HSP / 2)] = (ia0[j] >> 16) | (ib0[j] & 0xffff0000u);
        d[(8 + 2 * j) * (HSP / 2)] = (ia1[j] & 0xffffu) | (ib1[j] << 16);
        d[(8 + 2 * j + 1) * (HSP / 2)] = (ia1[j] >> 16) | (ib1[j] & 0xffff0000u);
      }
    }
    __syncthreads();
    if (c0 + 1 < 64 * (1 + PROBE_HG)) HG_LOAD((c + 1) & 63)
    {
      const int ti = w >> 1, si = w & 1;
      f32x16 d;
#pragma unroll
      for (int i = 0; i < 16; ++i) d[i] = 0.f;
      if (w != 1) {
#pragma unroll
        for (int ks = 0; ks < 8; ++ks) {
          const bf16x8 af = *(const bf16x8*)(KM + (si * 32 + r) * HQP + ks * 16 + h * 8);
          const bf16x8 bf = *(const bf16x8*)(QM + (ti * 32 + r) * HQP + ks * 16 + h * 8);
          d = MFMA32(af, bf, d);
        }
      }
      __syncthreads();
      const int t = ti * 32 + r;
#pragma unroll
      for (int g = 0; g < 4; ++g) {
        const int sb = si * 32 + 8 * g + 4 * h;
        u32x2 v;
        v.x = pack2(sb + 0 <= t ? d[4 * g + 0] : 0.f, sb + 1 <= t ? d[4 * g + 1] : 0.f);
        v.y = pack2(sb + 2 <= t ? d[4 * g + 2] : 0.f, sb + 3 <= t ? d[4 * g + 3] : 0.f);
        *(u32x2*)(AM + t * HSP + sb) = v;
      }
    }
    __syncthreads();
    {
      f32x16 oa0, oa1;
#pragma unroll
      for (int i = 0; i < 16; ++i) { oa0[i] = 0.f; oa1[i] = 0.f; }
#pragma unroll
      for (int s4 = 0; s4 < 4; ++s4) {
        const bf16x8 ifr = *(const bf16x8*)(IT + (w * 32 + r) * HSP + 16 * s4 + 8 * h);
        const bf16x8 am1 = *(const bf16x8*)(AM + (32 + r) * HSP + 16 * s4 + 8 * h);
        oa1 = MFMA32(am1, ifr, oa1);
        if (s4 < 2) {
          const bf16x8 am0 = *(const bf16x8*)(AM + r * HSP + 16 * s4 + 8 * h);
          oa0 = MFMA32(am0, ifr, oa0);
        }
      }
#pragma unroll
      for (int ks = 0; ks < 8; ++ks) {
        const int kt4 = ks >> 1, hf = ks & 1;
        const float4 ea = *(const float4*)(emid + kt4 * 32 + 16 * hf + 4 * h);
        const float4 eb = *(const float4*)(emid + kt4 * 32 + 16 * hf + 8 + 4 * h);
        u32x4 pk;
        pk.x = pack2(S[kt4][8 * hf + 0] * ea.x, S[kt4][8 * hf + 1] * ea.y);
        pk.y = pack2(S[kt4][8 * hf + 2] * ea.z, S[kt4][8 * hf + 3] * ea.w);
        pk.z = pack2(S[kt4][8 * hf + 4] * eb.x, S[kt4][8 * hf + 5] * eb.y);
        pk.w = pack2(S[kt4][8 * hf + 6] * eb.z, S[kt4][8 * hf + 7] * eb.w);
        const bf16x8 sp = __builtin_bit_cast(bf16x8, pk);
        const bf16x8 qf0 = *(const bf16x8*)(QM + r * HQP + ks * 16 + 8 * h);
        const bf16x8 qf1 = *(const bf16x8*)(QM + (32 + r) * HQP + ks * 16 + 8 * h);
        oa0 = MFMA32(qf0, sp, oa0);
        oa1 = MFMA32(qf1, sp, oa1);
      }
      char* ogb = (char*)og + olane;
#pragma unroll
      for (int i = 0; i < 16; ++i) {
        const int ci = (i & 3) + 8 * (i >> 2);
        const size_t r0 = dir ? tb + 59 - ci : tb + ci;
        const size_t r1 = dir ? tb + 27 - ci : tb + 32 + ci;
        *(u16*)(ogb + r0 * 1024) = f2bf(oa0[i]);
        *(u16*)(ogb + r1 * 1024) = f2bf(oa1[i]);
      }
    }
#pragma unroll
    for (int kt4 = 0; kt4 < 4; ++kt4) {
#pragma unroll
      for (int g = 0; g < 4; ++g) {
        const float4 dd = *(const float4*)(dec + kt4 * 32 + 8 * g + 4 * h);
        S[kt4][4 * g + 0] *= dd.x; S[kt4][4 * g + 1] *= dd.y; S[kt4][4 * g + 2] *= dd.z; S[kt4][4 * g + 3] *= dd.w;
      }
    }
#pragma unroll
    for (int s4 = 0; s4 < 4; ++s4) {
      const bf16x8 ifr = *(const bf16x8*)(IT + (w * 32 + r) * HSP + 16 * s4 + 8 * h);
#pragma unroll
      for (int kt4 = 0; kt4 < 4; ++kt4) {
        const bf16x8 kf = *(const bf16x8*)(KUT + (kt4 * 32 + r) * HSP + 16 * s4 + 8 * h);
        S[kt4] = MFMA32(kf, ifr, S[kt4]);
      }
    }
    __syncthreads();
  }
#undef HG_LOAD
}

__global__ __launch_bounds__(256) void naive_attn(Params p) {
  const int gid = blockIdx.x * 256 + threadIdx.x;
  const int s = gid & 4095, bh = gid >> 12, head = bh & 7, bi = bh >> 3, kvh = head >> 2;
  float qv[64], acc[64];
  const u16* qp = p.q + ((size_t)(bi * 8 + head) * SEQ + s) * 64;
#pragma unroll
  for (int d = 0; d < 64; ++d) { qv[d] = bf2f(qp[d]); acc[d] = 0.f; }
  float mx = -INFINITY, l = 0.f;
  const u16* kp = p.k + (size_t)(bi * 2 + kvh) * SEQ * 64;
  const u16* vp = p.vT + (size_t)(bi * 2 + kvh) * 64 * SEQ;
  for (int key = 0; key < SEQ; ++key) {
    float sc = 0.f;
#pragma unroll
    for (int d = 0; d < 64; ++d) sc += qv[d] * bf2f(kp[(size_t)key * 64 + d]);
    const float mn = fmaxf(mx, sc);
    const float al = exp2f(mx - mn), pp = exp2f(sc - mn);
    l = l * al + pp;
#pragma unroll
    for (int d = 0; d < 64; ++d) acc[d] = acc[d] * al + pp * bf2f(vp[(size_t)d * SEQ + key]);
    mx = mn;
  }
  const float il = 1.f / l;
  u16* op = p.attn + ((size_t)bi * SEQ + s) * 512 + head * 64;
#pragma unroll
  for (int d = 0; d < 64; ++d) op[d] = f2bf(acc[d] * il);
}

__global__ __launch_bounds__(1024) void naive_hgrn(Params p) {
  __shared__ float red[8][128];
  const int dir = blockIdx.x & 1, hh = (blockIdx.x >> 1) & 3, bi = blockIdx.x >> 3;
  const int v = threadIdx.x & 127, kq = threadIdx.x >> 7;
  float S[16];
#pragma unroll
  for (int i = 0; i < 16; ++i) S[i] = 0.f;
  const u16* lf = dir ? p.lfb : p.lff;
  u16* o = dir ? p.ob : p.of;
  for (int step = 0; step < SEQ; ++step) {
    const int s = dir ? SEQ - 1 - step : step;
    const size_t base = ((size_t)bi * SEQ + s) * 512 + hh * 128;
    const float iv = bf2f(p.hi[base + v]);
    float part = 0.f;
#pragma unroll
    for (int kk = 0; kk < 16; ++kk) {
      const int k = kq * 16 + kk;
      const float lg = (float)__builtin_bit_cast(_Float16, lf[base + k]);
      const float f = exp2f(lg), g = 1.f - f;
      const float qk = bf2f(p.hq[base + k]);
      S[kk] = f * S[kk] + g * iv;
      part += S[kk] * qk;
    }
    red[kq][v] = part;
    __syncthreads();
    if (kq == 0) {
      float t = 0.f;
#pragma unroll
      for (int j = 0; j < 8; ++j) t += red[j][v];
      o[base + v] = f2bf(t);
    }
    __syncthreads();
  }
}

DI void unpack8(const uint4 u, float (&v)[8]) {
  v[0] = __uint_as_float(u.x << 16); v[1] = __uint_as_float(u.x & 0xffff0000u);
  v[2] = __uint_as_float(u.y << 16); v[3] = __uint_as_float(u.y & 0xffff0000u);
  v[4] = __uint_as_float(u.z << 16); v[5] = __uint_as_float(u.z & 0xffff0000u);
  v[6] = __uint_as_float(u.w << 16); v[7] = __uint_as_float(u.w & 0xffff0000u);
}
__device__ void phase_mix(const Params& p, int bid, int nblk) {
  const int lane = threadIdx.x & 63, w = threadIdx.x >> 6;
  u16* mix = p.mix;
  float wa[8], wh[8];
#pragma unroll
  for (int e = 0; e < 8; ++e) { wa[e] = p.attn_norm_w[lane * 8 + e]; wh[e] = p.hg_norm_w[(lane & 15) * 8 + e]; }
  const int stride = nblk * 4;
  for (int m0 = bid * 4 + w; m0 < MTOK; m0 += 4 * stride) {
    uint4 ua[4], ug[4], u1[4], u2[4], uh[4];
#pragma unroll
    for (int u = 0; u < 4; ++u) {
      const int m = m0 + u * stride;
      if (m < MTOK) {
        const size_t rb = (size_t)m * 512 + lane * 8;
        ua[u] = *(const uint4*)(p.attn + rb); ug[u] = *(const uint4*)(p.ga + rb);
        u1[u] = *(const uint4*)(p.of + rb); u2[u] = *(const uint4*)(p.ob + rb); uh[u] = *(const uint4*)(p.gh + rb);
      }
    }
#pragma unroll
    for (int u = 0; u < 4; ++u) {
      const int m = m0 + u * stride;
      if (m < MTOK) {
        float a[8], g[8], f1[8], f2[8];
        unpack8(ua[u], a); unpack8(ug[u], g);
        float ss = 0.f;
#pragma unroll
        for (int e = 0; e < 8; ++e) ss += a[e] * a[e];
#pragma unroll
        for (int o = 32; o >= 1; o >>= 1) ss += __shfl_xor(ss, o);
        float rstd = rsqrtf(ss * (1.f / 512.f) + 1e-6f);
        float r[8];
#pragma unroll
        for (int e = 0; e < 8; ++e) r[e] = a[e] * rstd * wa[e] * g[e];
        uint4 o1; o1.x = pack2(r[0], r[1]); o1.y = pack2(r[2], r[3]); o1.z = pack2(r[4], r[5]); o1.w = pack2(r[6], r[7]);
        *(uint4*)(mix + (size_t)m * 1024 + lane * 8) = o1;
        unpack8(u1[u], f1); unpack8(u2[u], f2); unpack8(uh[u], g);
        ss = 0.f;
#pragma unroll
        for (int e = 0; e < 8; ++e) { a[e] = f1[e] + f2[e]; ss += a[e] * a[e]; }
#pragma unroll
        for (int o = 8; o >= 1; o >>= 1) ss += __shfl_xor(ss, o);
        rstd = rsqrtf(ss * (1.f / 128.f) + 1e-6f);
#pragma unroll
        for (int e = 0; e < 8; ++e) r[e] = a[e] * rstd * wh[e] * g[e];
        o1.x = pack2(r[0], r[1]); o1.y = pack2(r[2], r[3]); o1.z = pack2(r[4], r[5]); o1.w = pack2(r[6], r[7]);
        *(uint4*)(mix + (size_t)m * 1024 + 512 + lane * 8) = o1;
      }
    }
  }
}

__device__ void phase3(const Params& p, char* smem, int bid, int nblk, const XMap xm) {
  const int lane = threadIdx.x & 63, w = threadIdx.x >> 6;
  const int wn = w & 1, wm = w >> 1;
  const int r0 = lane & 31, h0 = lane >> 5;
  const int ntiles = xm.xcc >= 0 ? 256 : (MTOK / 128) * 8;
  const int tstep = xm.xcc >= 0 ? xm.nloc : nblk;
  const int tend = ntiles * (1 + PROBE_P3);
  auto coords = [&](int tile0, int& mt, int& nt) {
    const int tile = tile0 >= ntiles ? tile0 - ntiles : tile0;
    if (xm.xcc >= 0) { const int c = tile >> 6, q = tile & 63; mt = xm.xcc * 32 + c * 8 + (q >> 3); nt = q & 7; }
    else { mt = tile >> 3; nt = tile & 7; }
  };
  int tile0 = xm.xcc >= 0 ? xm.rank : bid;
  while (tile0 < tend) {
    int mt_c, nt_c;
    coords(tile0, mt_c, nt_c);
    f32x16 acc[2][2];
    {
      u32x4 ra0[4], rb0[4], ra1[4], rb1[4];
      gemm_issue(p.woutT, p.mix, nt_c * 128, mt_c * 128, ra0, rb0, ra1, rb1);
      gemm_run(p.woutT, p.mix, nt_c * 128, mt_c * 128, smem, acc, ra0, rb0, ra1, rb1);
    }
    tile0 += tstep;
    {
    const int mt = mt_c, nt = nt_c;
    int r = r0, h = h0;
    asm volatile("" : "+v"(r), "+v"(h));
    float* T = (float*)smem;
#pragma unroll
    for (int b = 0; b < 2; ++b) {
      float* trow = T + (wm * 64 + b * 32 + r) * EPF + wn * 64 + 4 * h;
#pragma unroll
      for (int a = 0; a < 2; ++a)
#pragma unroll
        for (int g = 0; g < 4; ++g) {
          float4 o;
          o.x = acc[a][b][4 * g + 0]; o.y = acc[a][b][4 * g + 1]; o.z = acc[a][b][4 * g + 2]; o.w = acc[a][b][4 * g + 3];
          *(float4*)(trow + a * 32 + 8 * g) = o;
        }
    }
    __syncthreads();
    {
      const int tid = threadIdx.x;
      const int ch = tid & 31, rw = tid >> 5;
      const size_t gofs = (size_t)(mt * 128) * 1024 + nt * 128 + ch * 4;
#pragma unroll
      for (int j0 = 0; j0 < 16; j0 += 4) {
        float4 xv[4];
#pragma unroll
        for (int u = 0; u < 4; ++u) xv[u] = *(const float4*)(p.x + gofs + (size_t)((j0 + u) * 8 + rw) * 1024);
#pragma unroll
        for (int u = 0; u < 4; ++u) {
          const int row = (j0 + u) * 8 + rw;
          const float4 y = *(const float4*)(T + row * EPF + ch * 4);
          float4 o;
          o.x = DN_ALPHA * xv[u].x + y.x; o.y = DN_ALPHA * xv[u].y + y.y; o.z = DN_ALPHA * xv[u].z + y.z; o.w = DN_ALPHA * xv[u].w + y.w;
          *(float4*)(p.z + gofs + (size_t)row * 1024) = o;
        }
      }
    }
    }
  }
}

__device__ void phase4(const Params& p, int bid, int nblk) {
  const int lane = threadIdx.x & 63, w = threadIdx.x >> 6;
  const int stride = nblk * 4;
  for (int m0 = bid * 4 + w; m0 < MTOK; m0 += 4 * stride) {
    float4 v[4][4];
#pragma unroll
    for (int u = 0; u < 4; ++u) {
      const int m = m0 + u * stride;
      if (m < MTOK) {
        const float4* row = (const float4*)(p.z + (size_t)m * 1024);
#pragma unroll
        for (int j = 0; j < 4; ++j) v[u][j] = row[lane + 64 * j];
      }
    }
#pragma unroll
    for (int u = 0; u < 4; ++u) {
      const int m = m0 + u * stride;
      if (m < MTOK) {
        float4* row = (float4*)(p.out + (size_t)m * 1024);
        float s = 0.f;
#pragma unroll
        for (int j = 0; j < 4; ++j) s += v[u][j].x + v[u][j].y + v[u][j].z + v[u][j].w;
#pragma unroll
        for (int o = 32; o >= 1; o >>= 1) s += __shfl_xor(s, o);
        const float mu = s * (1.f / 1024.f);
        float q = 0.f;
#pragma unroll
        for (int j = 0; j < 4; ++j) {
          v[u][j].x -= mu; v[u][j].y -= mu; v[u][j].z -= mu; v[u][j].w -= mu;
          q += v[u][j].x * v[u][j].x + v[u][j].y * v[u][j].y + v[u][j].z * v[u][j].z + v[u][j].w * v[u][j].w;
        }
#pragma unroll
        for (int o = 32; o >= 1; o >>= 1) q += __shfl_xor(q, o);
        const float rstd = rsqrtf(q * (1.f / 1024.f) + 1e-5f);
#pragma unroll
        for (int j = 0; j < 4; ++j) {
          const float4 wv = ((const float4*)p.ln_w)[lane + 64 * j], bv = ((const float4*)p.ln_b)[lane + 64 * j];
          float4 o;
          o.x = v[u][j].x * rstd * wv.x + bv.x; o.y = v[u][j].y * rstd * wv.y + bv.y;
          o.z = v[u][j].z * rstd * wv.z + bv.z; o.w = v[u][j].w * rstd * wv.w + bv.w;
          row[lane + 64 * j] = o;
        }
      }
    }
  }
}


#define XB_TMO      128
#define XB_XCNT(j)  (256  + 64 * (j))
#define XB_XSUB(j)  (1280 + 64 * (j))
#define XB_XGEN(j)  (2304 + 64 * (j))
#define XB_TOP      3328
#define XB_TOPGEN   3392
#define XCD_BAR_WORDS 3456
#define XB_SPIN_CAP (1u << 18)
#define LAS __attribute__((address_space(3)))
DI unsigned xb_ld(unsigned* p) { return __hip_atomic_load(p, __ATOMIC_RELAXED, __HIP_MEMORY_SCOPE_AGENT); }
DI unsigned xb_add(unsigned* p, unsigned v) { return __hip_atomic_fetch_add(p, v, __ATOMIC_RELAXED, __HIP_MEMORY_SCOPE_AGENT); }
DI unsigned xb_xcc_id() { return (unsigned)__builtin_amdgcn_s_getreg((3 << 11) | 20) & 0xFu; }
#define XB_SPIN(cond, bar) do { unsigned _sp = 0; while (cond) { __builtin_amdgcn_s_sleep(1); \
    if ((++_sp & 255u) == 0u) { if (xb_ld(&(bar)[XB_TMO])) break; if (_sp > XB_SPIN_CAP) { atomicAdd(&(bar)[XB_TMO], 1u); break; } } } } while (0)
struct XcdBarrier { unsigned* bar; unsigned x; volatile LAS unsigned* st; };
DI XcdBarrier xcd_barrier_post(unsigned* bar, volatile LAS unsigned* st, unsigned& rank) {
  XcdBarrier b; b.bar = bar; b.x = xb_xcc_id(); b.st = st;
  rank = 0u;
  if (threadIdx.x == 0) rank = xb_add(&bar[XB_XCNT(b.x)], 1u);
  return b;
}
DI void xcd_barrier_complete(unsigned* bar, unsigned x, unsigned& nloc, unsigned& nx) {
  const unsigned G = gridDim.x * gridDim.y * gridDim.z;
  unsigned sum, cnt, mine, sp = 0u;
  for (;;) {
    sum = 0u; cnt = 0u; mine = 0u;
#pragma unroll
    for (unsigned j = 0; j < 16; ++j) { const unsigned c = xb_ld(&bar[XB_XCNT(j)]); sum += c; cnt += (c > 0u) ? 1u : 0u; mine = (j == x) ? c : mine; }
    if (sum == G) break;
    __builtin_amdgcn_s_sleep(1);
    if ((++sp & 255u) == 0u) { if (xb_ld(&bar[XB_TMO])) break; if (sp > XB_SPIN_CAP) { atomicAdd(&bar[XB_TMO], 1u); break; } }
  }
  nloc = mine > 0u ? mine : 1u; nx = cnt > 0u ? cnt : 1u;
}
DI void xcd_barrier(const XcdBarrier& b) {
  asm volatile("s_waitcnt vmcnt(0)" ::: "memory");
  __syncthreads();
  if (threadIdx.x == 0) {
    unsigned* bar = b.bar;
    __builtin_amdgcn_s_waitcnt(0);
    unsigned nloc = b.st[0], nx = b.st[1];
    if (nloc == 0u) { xcd_barrier_complete(bar, b.x, nloc, nx); b.st[0] = nloc; b.st[1] = nx; }
    const unsigned old = xb_add(&bar[XB_XSUB(b.x)], 1u);
    const unsigned gen = old / nloc;
    if (old + 1u == (gen + 1u) * nloc) {
      __builtin_amdgcn_fence(__ATOMIC_RELEASE, "agent");
      asm volatile("s_waitcnt vmcnt(0)" ::: "memory");
      const unsigned og = xb_add(&bar[XB_TOP], 1u);
      const unsigned tg = og / nx;
      if (og + 1u == (tg + 1u) * nx) xb_add(&bar[XB_TOPGEN], 1u);
      else XB_SPIN(xb_ld(&bar[XB_TOPGEN]) == tg, bar);
      __builtin_amdgcn_fence(__ATOMIC_ACQUIRE, "agent");
      xb_add(&bar[XB_XGEN(b.x)], 1u);
      asm volatile("s_waitcnt vmcnt(0)" ::: "memory");
    } else {
      XB_SPIN(xb_ld(&bar[XB_XGEN(b.x)]) == gen, bar);
      __builtin_amdgcn_fence(__ATOMIC_ACQUIRE, "agent");
      asm volatile("s_waitcnt vmcnt(0)" ::: "memory");
    }
  }
  __syncthreads();
}

constexpr int MEGA_LDS = HG_LDS > GEMM_LDS ? HG_LDS : GEMM_LDS;
__global__ void __launch_bounds__(256, 2) mega_kernel(Params p) {
  __shared__ __attribute__((aligned(16))) char smem[MEGA_LDS];
  __shared__ uint4 xb_words;
  __shared__ int s_item;
  __shared__ int s_xm[4];
  const int bid = blockIdx.x, nblk = gridDim.x;
  if (threadIdx.x == 0) xb_words = make_uint4(0u, 0u, 0u, 0u);
  __syncthreads();
  unsigned my_rank;
  XcdBarrier xb = xcd_barrier_post(p.bar, (volatile LAS unsigned*)&xb_words, my_rank);
  phase0(p, smem, bid, nblk);
#if PROBE_P0
  phase0(p, smem, bid, nblk);
#endif
  xcd_barrier(xb);
  if (threadIdx.x == 0) {
    unsigned sum = 0;
#pragma unroll
    for (int j = 0; j < 8; ++j) sum += xb_ld(&p.bar[XB_XCNT(j)]);
    const bool ok = sum == (unsigned)nblk && xb.x < 8u && xb_words.y == 8u;
    s_xm[0] = ok ? (int)xb.x : -1; s_xm[1] = (int)my_rank; s_xm[2] = (int)xb_words.x;
  }
  __syncthreads();
  XMap xm; xm.xcc = s_xm[0]; xm.rank = s_xm[1]; xm.nloc = s_xm[2];
  phase1(p, smem, bid, nblk, xm);
  xcd_barrier(xb);
  for (int it = bid; it < 64; it += nblk) hgrn_item(p, smem, it);
  for (;;) {
    __syncthreads();
    if (threadIdx.x == 0) s_item = atomicAdd(p.ctr, 1);
    __syncthreads();
    const int it = __builtin_amdgcn_readfirstlane(s_item);
    if (it >= 1024 + 2048) break;
    if (it < 1024) attn_item(p, smem, it);
    else { const int g = it - 1024, jj = g & 7; p1_tile(p, smem, g >> 3, jj < 4 ? 6 + jj : 22 + jj); }
  }
  xcd_barrier(xb);
  phase_mix(p, bid, nblk);
#if PROBE_MIX
  phase_mix(p, bid, nblk);
#endif
  xcd_barrier(xb);
  phase3(p, smem, bid, nblk, xm);
  xcd_barrier(xb);
  phase4(p, bid, nblk);
}

__global__ __launch_bounds__(256) void k_phase0(Params p) { __shared__ __attribute__((aligned(16))) char smem[64 * 65 * 4]; phase0(p, smem, blockIdx.x, gridDim.x); }
__global__ __launch_bounds__(256) void k_phase1(Params p) { __shared__ __attribute__((aligned(16))) char smem[GEMM_LDS]; XMap xm; xm.xcc = -1; xm.rank = 0; xm.nloc = 1; phase1(p, smem, blockIdx.x, gridDim.x, xm); }
__global__ __launch_bounds__(256) void k_attn(Params p) { __shared__ __attribute__((aligned(16))) char smem[GEMM_LDS]; for (int it = blockIdx.x; it < 3072; it += gridDim.x) { if (it < 1024) attn_item(p, smem, it); else { const int g = it - 1024, jj = g & 7; p1_tile(p, smem, g >> 3, jj < 4 ? 6 + jj : 22 + jj); } } }
__global__ __launch_bounds__(256) void k_hgrn(Params p) { __shared__ __attribute__((aligned(16))) char smem[HG_LDS]; for (int it = blockIdx.x; it < 64; it += gridDim.x) hgrn_item(p, smem, it); }
__global__ __launch_bounds__(256) void k_mix(Params p) { phase_mix(p, blockIdx.x, gridDim.x); }
__global__ __launch_bounds__(256) void k_phase3(Params p) { __shared__ __attribute__((aligned(16))) char smem[GEMM_LDS]; XMap xm; xm.xcc = -1; xm.rank = 0; xm.nloc = 1; phase3(p, smem, blockIdx.x, gridDim.x, xm); }
__global__ __launch_bounds__(256) void k_phase4(Params p) { phase4(p, blockIdx.x, gridDim.x); }

extern "C" void kernel_launch(void* const* d_in, const int* in_sizes, int n_in, void* d_out, int out_size, void* d_ws, size_t ws_size,
                              hipStream_t stream) {
  Params p{};
  p.x = (const float*)d_in[0]; p.w_in = (const float*)d_in[1]; p.q_norm_w = (const float*)d_in[2]; p.k_norm_w = (const float*)d_in[3];
  p.attn_norm_w = (const float*)d_in[4]; p.lb_logits = (const float*)d_in[5]; p.hg_norm_w = (const float*)d_in[6];
  p.w_out = (const float*)d_in[7]; p.ln_w = (const float*)d_in[8]; p.ln_b = (const float*)d_in[9];
  p.out = (float*)d_out;
  char* ws = (char*)d_ws;
  size_t off = 0;
  auto take = [&](size_t bytes) { char* r = ws + off; off += (bytes + 255) & ~(size_t)255; return r; };
  p.xb = (u16*)take((size_t)MTOK * 1024 * 2);
  p.winT = (u16*)take((size_t)INW * 1024 * 2);
  p.woutT = (u16*)take((size_t)1024 * 1024 * 2);
  p.rope = (float2*)take(1024 * 8);
  p.lbv = (float*)take(1024 * 4);
  p.q = (u16*)take((size_t)MTOK * 512 * 2);
  p.k = (u16*)take((size_t)MTOK * 128 * 2);
  p.vT = (u16*)take((size_t)MTOK * 128 * 2);
  p.ga = (u16*)take((size_t)MTOK * 512 * 2);
  p.hq = (u16*)take((size_t)MTOK * 512 * 2);
  p.hi = (u16*)take((size_t)MTOK * 512 * 2);
  p.lff = (u16*)take((size_t)MTOK * 512 * 4);
  p.lfb = (u16*)take((size_t)MTOK * 512 * 4);
  p.gh = (u16*)take((size_t)MTOK * 512 * 2);
  p.attn = (u16*)take((size_t)MTOK * 512 * 2);
  p.of = (u16*)take((size_t)MTOK * 512 * 2);
  p.ob = (u16*)take((size_t)MTOK * 512 * 2);
  p.ctr = (int*)take(256);
  p.bar = (unsigned*)take(XCD_BAR_WORDS * 4);
  p.mix = p.hq;
  p.z = (float*)p.lff;
  if (off > ws_size) { fprintf(stderr, "workspace too small: need %zu have %zu\n", off, ws_size); return; }
#if ONE_LAUNCH
  static int grid_blocks = 0;
  if (!grid_blocks) {
    int dev = 0, cus = 0, per_cu = 0;
    hipGetDevice(&dev);
    hipDeviceGetAttribute(&cus, hipDeviceAttributeMultiprocessorCount, dev);
    hipOccupancyMaxActiveBlocksPerMultiprocessor(&per_cu, mega_kernel, 256, 0);
    if (per_cu > 2) per_cu = 2;
    grid_blocks = cus * per_cu;
    if (grid_blocks < 64) fprintf(stderr, "grid too small: %d\n", grid_blocks);
  }
  hipMemsetAsync(p.ctr, 0, 256 + ((XCD_BAR_WORDS * 4 + 255) & ~255), stream);
  void* args[] = {&p};
  hipError_t e = hipLaunchCooperativeKernel((void*)mega_kernel, dim3(grid_blocks), dim3(256), args, 0, stream);
  if (e != hipSuccess) fprintf(stderr, "cooperative launch failed: %s (grid %d)\n", hipGetErrorString(e), grid_blocks);
#else
  k_phase0<<<1024, 256, 0, stream>>>(p);
  k_phase1<<<512, 256, 0, stream>>>(p);
  k_attn<<<2048, 256, 0, stream>>>(p);
  k_hgrn<<<64, 256, 0, stream>>>(p);
  k_mix<<<2048, 256, 0, stream>>>(p);
  k_phase3<<<512, 256, 0, stream>>>(p);
  k_phase4<<<2048, 256, 0, stream>>>(p);
#endif
}
```
